# Optimizing an MI355X kernel written in HIP

```python
import math
import jax, jax.numpy as jnp
from jax import lax
import numpy as np

D_MODEL = 2048
BATCH = 2
SEQ = 4096
DEPTH = 1

ATT_HEAD_DIM = 128
ATT_HEADS_PER_GROUP = 4
ATT_PATTERNS = ((128, 1), (512, 4), (2048, 16))
ATT_HEADS = ATT_HEADS_PER_GROUP * len(ATT_PATTERNS)
ATT_WIDTH = ATT_HEADS * ATT_HEAD_DIM
ATT_OUT_WIDTH = ATT_HEADS_PER_GROUP * ATT_HEAD_DIM
ATT_BLOCK = 128

M_HEADS = 4
M_QK_DIM = 128
M_V_DIM = 256
M_QK_WIDTH = M_HEADS * M_QK_DIM
M_V_WIDTH = M_HEADS * M_V_DIM
M_CONV = 4
M_CHUNK = 64

N_BRANCHES = 2
IN_PROJ_SPLITS = (ATT_WIDTH, ATT_WIDTH, ATT_WIDTH, 2 * M_QK_WIDTH, M_V_WIDTH, M_V_WIDTH, 2 * M_HEADS, N_BRANCHES * D_MODEL)
IN_PROJ_WIDTH = sum(IN_PROJ_SPLITS)

N_GROUPS = 4
EXPERTS_PER_GROUP = 8
N_EXPERTS = N_GROUPS * EXPERTS_PER_GROUP
TOP_K = 2
D_FF_EXPERT = 1408
MOE_BLOCK = 128

DEEPNORM_ALPHA = (2 * DEPTH) ** 0.25
DEEPNORM_BETA = (8 * DEPTH) ** -0.25
LN_EPS = 1e-5

kernel_name = 'hybrid_dilated_attn_mlstm_hmoe_deepnorm'


def alibi_slopes(n):
    def geometric(k):
        start = 2.0 ** (-8.0 / k)
        return [start ** (i + 1) for i in range(k)]
    c = 2 ** int(math.floor(math.log2(n)))
    s = geometric(c) if c == n else geometric(c) + geometric(2 * c)[0::2][: n - c]
    return np.array(sorted(s, reverse=True), dtype=np.float32)


def layer_norm(x, g, b):
    xf = x.astype(jnp.float32)
    mu = jnp.mean(xf, axis=-1, keepdims=True)
    var = jnp.mean(jnp.square(xf - mu), axis=-1, keepdims=True)
    y = (xf - mu) * lax.rsqrt(var + LN_EPS) * g.astype(jnp.float32) + b.astype(jnp.float32)
    return y.astype(x.dtype)


def dilated_window_attention(q, k, v, slopes, window, dilation):
    B, S, H, Dh = q.shape
    r = dilation
    n_win = window // r
    L = S // r
    nb = -(-L // ATT_BLOCK)
    Lp = nb * ATT_BLOCK

    def to_sub(t):
        t = t.reshape(B, L, r, H, Dh).transpose(0, 2, 3, 1, 4)
        return jnp.pad(t, ((0, 0), (0, 0), (0, 0), (0, Lp - L), (0, 0)))

    def band(t):
        prev = jnp.pad(t, ((0, 0), (0, 0), (0, 0), (ATT_BLOCK, 0), (0, 0)))[:, :, :, :Lp]
        return jnp.concatenate([prev.reshape(B, r, H, nb, ATT_BLOCK, Dh),
                                t.reshape(B, r, H, nb, ATT_BLOCK, Dh)], axis=4)

    qb = to_sub(q).reshape(B, r, H, nb, ATT_BLOCK, Dh)
    kb = band(to_sub(k))
    vb = band(to_sub(v))
    scores = jnp.einsum('bphnqd,bphnkd->bphnqk', qb, kb,
                        preferred_element_type=jnp.float32) * (Dh ** -0.5)
    qi = jnp.arange(ATT_BLOCK)[:, None]
    ki = jnp.arange(2 * ATT_BLOCK)[None, :]
    delta = ATT_BLOCK + qi - ki
    key_u = (jnp.arange(nb)[:, None, None] - 1) * ATT_BLOCK + ki[None]
    valid = (delta >= 0) & (delta <= n_win) & (key_u >= 0)
    alibi = -jnp.asarray(slopes, jnp.float32)[:, None, None, None] * (delta * r).astype(jnp.float32)
    scores = jnp.where(valid, scores + alibi, -jnp.inf)
    m = jnp.max(scores, axis=-1, keepdims=True)
    p = jnp.exp(scores - m)
    l = jnp.sum(p, axis=-1, keepdims=True)
    o = jnp.einsum('bphnqk,bphnkd->bphnqd', p, vb.astype(jnp.float32)) / l
    lse = (m + jnp.log(l))[..., 0]
    o = o.reshape(B, r, H, Lp, Dh)[:, :, :, :L].transpose(0, 3, 1, 2, 4).reshape(B, S, H, Dh)
    lse = lse.reshape(B, r, H, Lp)[..., :L].transpose(0, 3, 1, 2).reshape(B, S, H)
    return o, lse


def causal_depthwise_conv(x, w, b):
    K, C = w.shape
    y = lax.conv_general_dilated(x, w[:, None, :].astype(x.dtype), window_strides=(1,),
                                 padding=[(K - 1, 0)], dimension_numbers=('NWC', 'WIO', 'NWC'),
                                 feature_group_count=C)
    return y + b


def mlstm_chunkwise(q, k, v, i_pre, f_pre):
    B, NH, S, dqk = q.shape
    dv = v.shape[-1]
    nc = S // M_CHUNK
    f32 = jnp.float32

    def chunked(t):
        t = t.astype(f32).reshape(B, NH, nc, M_CHUNK, *t.shape[3:])
        return jnp.moveaxis(t, 2, 0)

    qc = chunked(q) * (dqk ** -0.5)
    kc = chunked(k)
    vc = chunked(v)
    ic = chunked(i_pre)
    bc = lax.cumsum(chunked(jax.nn.log_sigmoid(f_pre.astype(f32))), axis=3)
    causal = jnp.tril(jnp.ones((M_CHUNK, M_CHUNK), dtype=bool))

    def step(carry, xs):
        C, n, m = carry
        qj, kj, vj, ij, bj = xs
        dmat = jnp.where(causal, bj[..., :, None] - bj[..., None, :] + ij[..., None, :], -jnp.inf)
        inter = bj + m[..., None]
        m_t = jnp.maximum(inter, jnp.max(dmat, axis=-1))
        w_intra = jnp.exp(dmat - m_t[..., None])
        w_inter = jnp.exp(inter - m_t)
        qk = jnp.einsum('bhld,bhsd->bhls', qj, kj) * w_intra
        num = w_inter[..., None] * jnp.einsum('bhld,bhdv->bhlv', qj, C) + jnp.einsum('bhls,bhsv->bhlv', qk, vj)
        den = w_inter * jnp.einsum('bhld,bhd->bhl', qj, n) + jnp.sum(qk, axis=-1)
        h = num / jnp.maximum(jnp.abs(den), jnp.exp(-m_t))[..., None]
        b_last = bj[..., -1]
        w_log = b_last[..., None] - bj + ij
        m_new = jnp.maximum(b_last + m, jnp.max(w_log, axis=-1))
        wk = jnp.exp(w_log - m_new[..., None])
        decay = jnp.exp(b_last + m - m_new)
        C_new = decay[..., None, None] * C + jnp.einsum('bhs,bhsd,bhsv->bhdv', wk, kj, vj)
        n_new = decay[..., None] * n + jnp.einsum('bhs,bhsd->bhd', wk, kj)
        return (C_new, n_new, m_new), h

    init = (jnp.zeros((B, NH, dqk, dv), f32), jnp.zeros((B, NH, dqk), f32), jnp.zeros((B, NH), f32))
    _, hs = lax.scan(step, init, (qc, kc, vc, ic, bc))
    return jnp.moveaxis(hs, 0, 2).reshape(B, NH, S, dv)


def token_mixer(h, w_in, conv_w, conv_b, if_bias, norm_w, w_proj_att, w_proj_mlstm, w_out):
    B, S, _ = h.shape
    proj = h @ w_in
    cuts = [int(c) for c in np.cumsum(IN_PROJ_SPLITS)[:-1]]
    aq, ak, av, mqk, mv, mo, mif, gate_pre = jnp.split(proj, cuts, axis=-1)

    aq = aq.reshape(B, S, ATT_HEADS, ATT_HEAD_DIM)
    ak = ak.reshape(B, S, ATT_HEADS, ATT_HEAD_DIM)
    av = av.reshape(B, S, ATT_HEADS, ATT_HEAD_DIM)
    slopes = alibi_slopes(ATT_HEADS)
    outs, lses = [], []
    for g, (window, dilation) in enumerate(ATT_PATTERNS):
        hs = slice(g * ATT_HEADS_PER_GROUP, (g + 1) * ATT_HEADS_PER_GROUP)
        o, lse = dilated_window_attention(aq[:, :, hs], ak[:, :, hs], av[:, :, hs], slopes[hs], window, dilation)
        outs.append(o)
        lses.append(lse)
    mix_w = jax.nn.softmax(jnp.stack(lses, axis=0), axis=0)
    att = jnp.einsum('gbsh,gbshd->bshd', mix_w, jnp.stack(outs, axis=0))
    att = att.reshape(B, S, ATT_OUT_WIDTH).astype(h.dtype)

    mqk = jax.nn.silu(causal_depthwise_conv(mqk, conv_w, conv_b))
    mq, mk = jnp.split(mqk, 2, axis=-1)

    def heads(t, d):
        return t.reshape(B, S, M_HEADS, d).transpose(0, 2, 1, 3)

    mif = (mif + if_bias).reshape(B, S, 2, M_HEADS).transpose(2, 0, 3, 1)
    hm = mlstm_chunkwise(heads(mq, M_QK_DIM), heads(mk, M_QK_DIM), heads(mv, M_V_DIM), mif[0], mif[1])
    mu = jnp.mean(hm, axis=-1, keepdims=True)
    var = jnp.mean(jnp.square(hm - mu), axis=-1, keepdims=True)
    hm = ((hm - mu) * lax.rsqrt(var + LN_EPS)).transpose(0, 2, 1, 3) * norm_w
    hm = hm.reshape(B, S, M_V_WIDTH).astype(h.dtype) * jax.nn.sigmoid(mo)

    g_att, g_mlstm = jnp.split(jax.nn.sigmoid(gate_pre), 2, axis=-1)
    merged = g_att * (att @ w_proj_att) + g_mlstm * (hm @ w_proj_mlstm)
    return merged @ w_out


def hierarchical_moe(h, w_router_group, b_router_group, w_router_expert, b_router_expert, w_gate, w_up, w_down):
    B, S, D = h.shape
    T = B * S
    xf = h.reshape(T, D)
    g_logits = (xf @ w_router_group).astype(jnp.float32) + b_router_group.astype(jnp.float32)
    grp = jnp.argmax(g_logits, axis=-1)
    g_w = jnp.take_along_axis(jax.nn.softmax(g_logits, axis=-1), grp[:, None], axis=1)[:, 0]
    e_all = ((xf @ w_router_expert).astype(jnp.float32) + b_router_expert.astype(jnp.float32)).reshape(T, N_GROUPS, EXPERTS_PER_GROUP)
    e_logits = jnp.take_along_axis(e_all, grp[:, None, None], axis=1)[:, 0]
    top_v, top_i = lax.top_k(e_logits, TOP_K)
    weight = g_w[:, None] * jax.nn.softmax(top_v, axis=-1)
    expert = grp[:, None].astype(jnp.int32) * EXPERTS_PER_GROUP + top_i.astype(jnp.int32)

    M = T * TOP_K
    e_flat = expert.reshape(M)
    tok_flat = jnp.repeat(jnp.arange(T, dtype=jnp.int32), TOP_K)
    w_flat = weight.reshape(M)
    order = jnp.argsort(e_flat)
    e_sorted = e_flat[order]
    counts = jnp.bincount(e_flat, length=N_EXPERTS)
    padded = (counts + MOE_BLOCK - 1) // MOE_BLOCK * MOE_BLOCK
    start = jnp.cumsum(counts) - counts
    pstart = jnp.cumsum(padded) - padded
    pend = pstart + padded
    dest = pstart[e_sorted] + jnp.arange(M, dtype=jnp.int32) - start[e_sorted]
    NB = M // MOE_BLOCK + N_EXPERTS
    slot_tok = jnp.zeros((NB * MOE_BLOCK,), jnp.int32).at[dest].set(tok_flat[order])
    slot_w = jnp.zeros((NB * MOE_BLOCK,), jnp.float32).at[dest].set(w_flat[order])
    block_start = jnp.arange(NB, dtype=jnp.int32) * MOE_BLOCK
    block_expert = jnp.minimum(jnp.sum(pend[None, :] <= block_start[:, None], axis=-1), N_EXPERTS - 1)

    def expert_block(args):
        toks, e = args
        xb = xf[toks]
        hb = jax.nn.silu(xb @ w_gate[e]) * (xb @ w_up[e])
        return hb @ w_down[e]

    yb = lax.map(expert_block, (slot_tok.reshape(NB, MOE_BLOCK), block_expert))
    y = jax.ops.segment_sum(yb.reshape(NB * MOE_BLOCK, D) * slot_w[:, None].astype(yb.dtype),
                            slot_tok, num_segments=T)
    return y.reshape(B, S, D)


def setup_inputs(seed: int = 0) -> dict:
    key = jax.random.key(seed)
    ks = jax.random.split(key, 24)
    f32 = jnp.float32

    def nrm(k, shape, scale):
        return jax.random.normal(k, shape, f32) * scale

    Ld = DEPTH
    col_scale = jnp.concatenate([
        jnp.ones((2 * ATT_WIDTH,), f32),
        jnp.full((ATT_WIDTH,), DEEPNORM_BETA, f32),
        jnp.ones((2 * M_QK_WIDTH,), f32),
        jnp.full((M_V_WIDTH,), DEEPNORM_BETA, f32),
        jnp.ones((M_V_WIDTH + 2 * M_HEADS + N_BRANCHES * D_MODEL,), f32)])
    m_if_bias = jnp.concatenate([
        nrm(ks[6], (Ld, M_HEADS), 0.1),
        jnp.linspace(3.0, 6.0, M_HEADS, dtype=f32)[None, :] + nrm(ks[7], (Ld, M_HEADS), 0.1)], axis=-1)
    return {
        'x': nrm(ks[0], (BATCH, SEQ, D_MODEL), 1.0),
        'ln_in_g': 1.0 + nrm(ks[1], (D_MODEL,), 0.02),
        'ln_in_b': nrm(ks[2], (D_MODEL,), 0.02),
        'w_in': nrm(ks[3], (Ld, D_MODEL, IN_PROJ_WIDTH), D_MODEL ** -0.5) * col_scale,
        'm_conv_w': nrm(ks[4], (Ld, M_CONV, 2 * M_QK_WIDTH), M_CONV ** -0.5),
        'm_conv_b': nrm(ks[5], (Ld, 2 * M_QK_WIDTH), 0.02),
        'm_if_bias': m_if_bias,
        'm_norm_w': 1.0 + nrm(ks[8], (Ld, M_HEADS, M_V_DIM), 0.02),
        'w_proj_att': nrm(ks[9], (Ld, ATT_OUT_WIDTH, D_MODEL), ATT_OUT_WIDTH ** -0.5),
        'w_proj_mlstm': nrm(ks[10], (Ld, M_V_WIDTH, D_MODEL), M_V_WIDTH ** -0.5),
        'w_out': nrm(ks[11], (Ld, D_MODEL, D_MODEL), D_MODEL ** -0.5) * DEEPNORM_BETA,
        'ln1_g': 1.0 + nrm(ks[12], (Ld, D_MODEL), 0.02),
        'ln1_b': nrm(ks[13], (Ld, D_MODEL), 0.02),
        'w_router_group': nrm(ks[14], (Ld, D_MODEL, N_GROUPS), D_MODEL ** -0.5),
        'b_router_group': nrm(ks[15], (Ld, N_GROUPS), 0.01),
        'w_router_expert': nrm(ks[16], (Ld, D_MODEL, N_EXPERTS), D_MODEL ** -0.5),
        'b_router_expert': nrm(ks[17], (Ld, N_EXPERTS), 0.01),
        'w_gate': nrm(ks[18], (Ld, N_EXPERTS, D_MODEL, D_FF_EXPERT), D_MODEL ** -0.5),
        'w_up': nrm(ks[19], (Ld, N_EXPERTS, D_MODEL, D_FF_EXPERT), D_MODEL ** -0.5),
        'w_down': nrm(ks[20], (Ld, N_EXPERTS, D_FF_EXPERT, D_MODEL), D_FF_EXPERT ** -0.5) * DEEPNORM_BETA,
        'ln2_g': 1.0 + nrm(ks[21], (Ld, D_MODEL), 0.02),
        'ln2_b': nrm(ks[22], (Ld, D_MODEL), 0.02),
    }


def reference(x, ln_in_g, ln_in_b, w_in, m_conv_w, m_conv_b, m_if_bias, m_norm_w,
              w_proj_att, w_proj_mlstm, w_out, ln1_g, ln1_b,
              w_router_group, b_router_group, w_router_expert, b_router_expert,
              w_gate, w_up, w_down, ln2_g, ln2_b):
    h = layer_norm(x, ln_in_g, ln_in_b)
    for l in range(DEPTH):
        y = token_mixer(h, w_in[l], m_conv_w[l], m_conv_b[l], m_if_bias[l], m_norm_w[l],
                        w_proj_att[l], w_proj_mlstm[l], w_out[l])
        h = layer_norm(DEEPNORM_ALPHA * h + y, ln1_g[l], ln1_b[l])
        y = hierarchical_moe(h, w_router_group[l], b_router_group[l], w_router_expert[l],
                             b_router_expert[l], w_gate[l], w_up[l], w_down[l])
        h = layer_norm(DEEPNORM_ALPHA * h + y, ln2_g[l], ln2_b[l])
    return h
```

```cpp
#include <hip/hip_runtime.h>
#include <cstdio>
#include <cstdint>
namespace pg8 {
#define PG8_LAS __attribute__((address_space(3)))
typedef unsigned short bf16_t;
typedef short bf16x8 __attribute__((ext_vector_type(8)));
typedef float f32x4 __attribute__((ext_vector_type(4)));
typedef unsigned u32x4 __attribute__((ext_vector_type(4)));
constexpr int BM = 256, BK = 64, HALF = 128, HTB = HALF * BK * 2  , STAGE_BYTES = 8 * HTB, NXCD = 8, WGM = 8;

__host__ __device__ __forceinline__ int lds_byte(int r, int c) { const int st = (r >> 4) * 2 + (c >> 5), rr = r & 15, cc = c & 31, ob = rr * 64 + cc * 2; return st * 1024 + (ob ^ (((ob >> 9) & 1) << 5)); }
__host__ __device__ __forceinline__ void stage_rc(int b, int& R, int& C) { const int st = b / 1024, sb = b % 1024, swz = sb ^ (((sb >> 9) & 1) << 5); R = (st >> 1) * 16 + swz / 64; C = (st & 1) * 32 + (swz % 64) / 2; }
__host__ __device__ __forceinline__ int perm32(int rho) { const int n = rho >> 4, i = rho & 15; return 8 * (i >> 2) + 4 * n + (i & 3); }

struct Unit { int pm, pn, e, r0; };
struct Gemm { const bf16_t* A; const bf16_t* Bt; int M, N, K; };

struct StaticOrder {
    int nM, nN, nwg, G, c;
    __host__ __device__ void init(int M, int N, int G_, int c_) { nM = M / BM; nN = N / BM; nwg = nM * nN; G = G_; c = c_; }
    __host__ __device__ bool next(int i, Unit& u) const {
        const long L = (long)i * G + c; if (L >= nwg) return false;
        int wgid = (int)L; { const int q = nwg / NXCD, r = nwg % NXCD, xcd = wgid % NXCD, off = wgid / NXCD; wgid = (xcd < r ? xcd * (q + 1) : r * (q + 1) + (xcd - r) * q) + off; }
        const int nig = WGM * nN, gid = wgid / nig, fm = gid * WGM, gsz = (nM - fm) < WGM ? (nM - fm) : WGM;
        u.pm = fm + ((wgid % nig) % gsz); u.pn = (wgid % nig) / gsz; u.e = 0; u.r0 = 0; return true;
    }
    __device__ __forceinline__ int arow(const Unit& u, int r) const { return u.pm * BM + r; }
    __device__ __forceinline__ void a_ready(const Unit&) const {}
    __device__ __forceinline__ void done(const Unit&) const {}
};

__device__ __forceinline__ unsigned cvt_pk_bf16(float lo, float hi) { unsigned r; asm volatile("v_cvt_pk_bf16_f32 %0, %1, %2" : "=v"(r) : "v"(lo), "v"(hi)); return r; }
__device__ __forceinline__ float bf_lo(unsigned w) { return __uint_as_float(w << 16); }
__device__ __forceinline__ float bf_hi(unsigned w) { return __uint_as_float(w & 0xffff0000u); }
__device__ __forceinline__ float sigmoidf_(float x) { return 1.0f / (1.0f + __expf(-x)); }

struct EpiBf16 {
    static constexpr bool PERM = true, AFTER_DRAIN = false;
    bf16_t* O; int ldc;
    __device__ __forceinline__ void operator()(const f32x4 (&acc)[2][2][4][2], const Unit& u, int wr, int wc, int fr, int fq) const {
        const int row0 = u.pm * BM + wr * 64 + fr; const int col0 = u.pn * BM + wc * 32 + 8 * fq;
#pragma unroll
        for (int ai = 0; ai < 2; ++ai)
#pragma unroll
            for (int m = 0; m < 4; ++m) { bf16_t* rowp = O + (size_t)(row0 + ai * HALF + m * 16) * ldc + col0;
#pragma unroll
                for (int bj = 0; bj < 2; ++bj) { const f32x4 v0 = acc[ai][bj][m][0], v1 = acc[ai][bj][m][1];
                    u32x4 w; w.x = cvt_pk_bf16(v0[0], v0[1]); w.y = cvt_pk_bf16(v0[2], v0[3]); w.z = cvt_pk_bf16(v1[0], v1[1]); w.w = cvt_pk_bf16(v1[2], v1[3]);
                    *(u32x4*)(rowp + bj * HALF) = w; } }
    }
};
struct EpiBf16Grp {
    static constexpr bool PERM = true, AFTER_DRAIN = false;
    bf16_t* O; int ldc; int ntn;
    __device__ __forceinline__ void operator()(const f32x4 (&acc)[2][2][4][2], const Unit& u, int wr, int wc, int fr, int fq) const {
        const int row0 = u.pm * BM + wr * 64 + fr; const int col0 = (u.pn % ntn) * BM + wc * 32 + 8 * fq;
#pragma unroll
        for (int ai = 0; ai < 2; ++ai)
#pragma unroll
            for (int m = 0; m < 4; ++m) { bf16_t* rowp = O + (size_t)(row0 + ai * HALF + m * 16) * ldc + col0;
#pragma unroll
                for (int bj = 0; bj < 2; ++bj) { const f32x4 v0 = acc[ai][bj][m][0], v1 = acc[ai][bj][m][1];
                    u32x4 w; w.x = cvt_pk_bf16(v0[0], v0[1]); w.y = cvt_pk_bf16(v0[2], v0[3]); w.z = cvt_pk_bf16(v1[0], v1[1]); w.w = cvt_pk_bf16(v1[2], v1[3]);
                    *(u32x4*)(rowp + bj * HALF) = w; } }
    }
};
struct EpiGateA {
    static constexpr bool PERM = true, AFTER_DRAIN = false;
    float* T; int ldc; const bf16_t* G; int ldg;
    __device__ __forceinline__ void operator()(const f32x4 (&acc)[2][2][4][2], const Unit& u, int wr, int wc, int fr, int fq) const {
        const int row0 = u.pm * BM + wr * 64 + fr; const int col0 = u.pn * BM + wc * 32 + 8 * fq;
#pragma unroll
        for (int ai = 0; ai < 2; ++ai)
#pragma unroll
            for (int m = 0; m < 4; ++m) { const size_t r = (size_t)(row0 + ai * HALF + m * 16);
#pragma unroll
                for (int bj = 0; bj < 2; ++bj) { const u32x4 gw = *(const u32x4*)(G + r * ldg + col0 + bj * HALF);
                    const f32x4 v0 = acc[ai][bj][m][0], v1 = acc[ai][bj][m][1];
                    f32x4 o0, o1;
                    o0[0] = sigmoidf_(bf_lo(gw.x)) * v0[0]; o0[1] = sigmoidf_(bf_hi(gw.x)) * v0[1]; o0[2] = sigmoidf_(bf_lo(gw.y)) * v0[2]; o0[3] = sigmoidf_(bf_hi(gw.y)) * v0[3];
                    o1[0] = sigmoidf_(bf_lo(gw.z)) * v1[0]; o1[1] = sigmoidf_(bf_hi(gw.z)) * v1[1]; o1[2] = sigmoidf_(bf_lo(gw.w)) * v1[2]; o1[3] = sigmoidf_(bf_hi(gw.w)) * v1[3];
                    float* tp = T + r * ldc + col0 + bj * HALF; *(f32x4*)tp = o0; *(f32x4*)(tp + 4) = o1; } }
    }
};
struct EpiGateB {
    static constexpr bool PERM = true, AFTER_DRAIN = false;
    bf16_t* O; const float* T; int ldc; const bf16_t* G; int ldg;
    __device__ __forceinline__ void operator()(const f32x4 (&acc)[2][2][4][2], const Unit& u, int wr, int wc, int fr, int fq) const {
        const int row0 = u.pm * BM + wr * 64 + fr; const int col0 = u.pn * BM + wc * 32 + 8 * fq;
#pragma unroll
        for (int ai = 0; ai < 2; ++ai)
#pragma unroll
            for (int m = 0; m < 4; ++m) { const size_t r = (size_t)(row0 + ai * HALF + m * 16);
#pragma unroll
                for (int bj = 0; bj < 2; ++bj) { const u32x4 gw = *(const u32x4*)(G + r * ldg + col0 + bj * HALF);
                    const float* tp = T + r * ldc + col0 + bj * HALF; const f32x4 t0 = *(const f32x4*)tp, t1 = *(const f32x4*)(tp + 4);
                    const f32x4 v0 = acc[ai][bj][m][0], v1 = acc[ai][bj][m][1];
                    f32x4 o0, o1;
                    o0[0] = t0[0] + sigmoidf_(bf_lo(gw.x)) * v0[0]; o0[1] = t0[1] + sigmoidf_(bf_hi(gw.x)) * v0[1]; o0[2] = t0[2] + sigmoidf_(bf_lo(gw.y)) * v0[2]; o0[3] = t0[3] + sigmoidf_(bf_hi(gw.y)) * v0[3];
                    o1[0] = t1[0] + sigmoidf_(bf_lo(gw.z)) * v1[0]; o1[1] = t1[1] + sigmoidf_(bf_hi(gw.z)) * v1[1]; o1[2] = t1[2] + sigmoidf_(bf_lo(gw.w)) * v1[2]; o1[3] = t1[3] + sigmoidf_(bf_hi(gw.w)) * v1[3];
                    u32x4 w; w.x = cvt_pk_bf16(o0[0], o0[1]); w.y = cvt_pk_bf16(o0[2], o0[3]); w.z = cvt_pk_bf16(o1[0], o1[1]); w.w = cvt_pk_bf16(o1[2], o1[3]);
                    *(u32x4*)(O + r * ldc + col0 + bj * HALF) = w; } }
    }
};
struct EpiResid {
    static constexpr bool PERM = false, AFTER_DRAIN = false;
    float* P; int ldc; const float* X; const float* stats; const float* g; const float* b; float alpha;
    __device__ __forceinline__ void operator()(const f32x4 (&acc)[2][2][4][2], const Unit& u, int wr, int wc, int fr, int fq) const {
        const int row0 = u.pm * BM + wr * 64 + fr, col0 = u.pn * BM + wc * 32 + 4 * fq;
        f32x4 gv[2][2], bv[2][2];
#pragma unroll
        for (int bj = 0; bj < 2; ++bj)
#pragma unroll
            for (int n = 0; n < 2; ++n) { gv[bj][n] = *(const f32x4*)(g + col0 + bj * HALF + n * 16); bv[bj][n] = *(const f32x4*)(b + col0 + bj * HALF + n * 16); }
#pragma unroll
        for (int ai = 0; ai < 2; ++ai)
#pragma unroll
            for (int m = 0; m < 4; ++m) { const size_t r = (size_t)(row0 + ai * HALF + m * 16); const float mu = stats[2 * r], rs = stats[2 * r + 1];
#pragma unroll
                for (int bj = 0; bj < 2; ++bj)
#pragma unroll
                    for (int n = 0; n < 2; ++n) { const size_t off = r * ldc + col0 + bj * HALF + n * 16; const f32x4 xv = *(const f32x4*)(X + off);
                        *(f32x4*)(P + off) = ((xv - mu) * rs * gv[bj][n] + bv[bj][n]) * alpha + acc[ai][bj][m][n]; } }
    }
};
struct EpiSwiGlu {
    static constexpr bool PERM = true, AFTER_DRAIN = false;
    bf16_t* O; int ldc; int ntn;
    __device__ __forceinline__ void operator()(const f32x4 (&acc)[2][2][4][2], const Unit& u, int wr, int wc, int fr, int fq) const {
        const int row0 = u.pm * BM + wr * 64 + fr; const int col0 = (u.pn % ntn) * HALF + wc * 32 + 8 * fq;
#pragma unroll
        for (int ai = 0; ai < 2; ++ai)
#pragma unroll
            for (int m = 0; m < 4; ++m) { bf16_t* rowp = O + (size_t)(row0 + ai * HALF + m * 16) * ldc + col0;
                float o[8];
#pragma unroll
                for (int n = 0; n < 2; ++n)
#pragma unroll
                    for (int j = 0; j < 4; ++j) { const float gt = acc[ai][0][m][n][j], up = acc[ai][1][m][n][j]; o[4 * n + j] = gt * sigmoidf_(gt) * up; }
                u32x4 w; w.x = cvt_pk_bf16(o[0], o[1]); w.y = cvt_pk_bf16(o[2], o[3]); w.z = cvt_pk_bf16(o[4], o[5]); w.w = cvt_pk_bf16(o[6], o[7]);
                *(u32x4*)rowp = w; }
    }
};

template <class Epi, class Sched, bool ALIGN_EPI = false, bool SP2 = false>
__device__ __forceinline__ void gemm_phase(PG8_LAS unsigned char* lds, const Gemm g, const Sched& S, const Epi& E) {
    const int tid = threadIdx.x, wid = __builtin_amdgcn_readfirstlane(tid >> 6), lane = tid & 63, wr = wid >> 2, wc = wid & 3, fr = lane & 15, fq = lane >> 4;
    const int K = g.K, nt = K / BK;
    int Rs[2], Cs[2]; unsigned voffB[2];
#pragma unroll
    for (int i = 0; i < 2; ++i) { int R, C; stage_rc(tid * 16 + i * 8192, R, C); const int Rb = Epi::PERM ? ((R & ~31) + perm32(R & 31)) : R;
        Rs[i] = R; Cs[i] = C; voffB[i] = (unsigned)(Rb * K + C) * 2u; }
    const size_t kstep = (size_t)(BK * 2);
    const size_t hstep = (size_t)HALF * K * 2;
    const size_t tstep = 2 * hstep;
    const unsigned ldsw = (unsigned)wid * 1024u;
    const int aoff = lds_byte(wr * 64 + fr, fq * 8), boff = lds_byte(wc * 32 + fr, fq * 8);
#define PG8_SA(b, h) (((b) * 2 + (h)) * HTB)
#define PG8_SB(b, h) ((4 + (b) * 2 + (h)) * HTB)
#define PG8_STAGE(bufoff, gbase, voff) do { _Pragma("unroll") for (int _i = 0; _i < 2; ++_i) \
        __builtin_amdgcn_global_load_lds((const unsigned*)((const char*)(gbase) + (voff)[_i]), (PG8_LAS unsigned*)(lds + (bufoff) + ldsw + _i * 8192), 16, 0, 0); } while (0)
#define PG8_LDA(dst, b, h) do { _Pragma("unroll") for (int m = 0; m < 4; ++m) _Pragma("unroll") for (int k = 0; k < 2; ++k) dst[m][k] = *(const PG8_LAS bf16x8*)(lds + PG8_SA(b, h) + aoff + m * 2048 + k * 1024); } while (0)
#define PG8_LDB(dst, b, h) do { _Pragma("unroll") for (int n = 0; n < 2; ++n) _Pragma("unroll") for (int k = 0; k < 2; ++k) dst[n][k] = *(const PG8_LAS bf16x8*)(lds + PG8_SB(b, h) + boff + n * 2048 + k * 1024); } while (0)
#define PG8_MMA(ai, bj, At, Bt) do { __builtin_amdgcn_s_setprio(1); _Pragma("unroll") for (int m = 0; m < 4; ++m) _Pragma("unroll") for (int n = 0; n < 2; ++n) _Pragma("unroll") for (int k = 0; k < 2; ++k) \
        acc[ai][bj][m][n] = __builtin_amdgcn_mfma_f32_16x16x32_bf16(Bt[n][k], At[m][k], acc[ai][bj][m][n], 0, 0, 0); __builtin_amdgcn_s_setprio(0); } while (0)
#define PG8_WAIT_V(n) asm volatile("s_waitcnt vmcnt(" #n ")" ::: "memory")
#define PG8_WAIT_L(n) asm volatile("s_waitcnt lgkmcnt(" #n ")" ::: "memory")
#define PG8_BAR __builtin_amdgcn_s_barrier()
#define PG8_SCHED __builtin_amdgcn_sched_barrier(0)
#define PG8_AOFF(dst, u) do { _Pragma("unroll") for (int _h = 0; _h < 2; ++_h) _Pragma("unroll") for (int _i = 0; _i < 2; ++_i) \
        dst[_h][_i] = ((unsigned)S.arow(u, _h * HALF + Rs[_i]) * (unsigned)K + (unsigned)Cs[_i]) * 2u; } while (0)
    Unit cur, nxt; int ui = 0;
    if (!S.next(0, cur)) return;
    f32x4 acc[2][2][4][2];
#pragma unroll
    for (int a = 0; a < 2; ++a)
#pragma unroll
        for (int b = 0; b < 2; ++b)
#pragma unroll
            for (int m = 0; m < 4; ++m)
#pragma unroll
                for (int n = 0; n < 2; ++n) acc[a][b][m][n] = (f32x4){0.f, 0.f, 0.f, 0.f};
    bf16x8 At[4][2], B0[2][2], B1[2][2];
    unsigned vA[2][2], nvA[2][2];
    PG8_AOFF(vA, cur);
    const char* const cA = (const char*)g.A; const char* cB = (const char*)g.Bt + (size_t)cur.pn * tstep;
    S.a_ready(cur);
    if constexpr (SP2) {
        PG8_STAGE(PG8_SB(0, 0), cB, voffB); PG8_STAGE(PG8_SB(0, 1), cB + hstep, voffB); PG8_STAGE(PG8_SA(0, 0), cA, vA[0]); PG8_STAGE(PG8_SA(0, 1), cA, vA[1]);
        if (wr == 1) PG8_BAR;
        PG8_WAIT_V(2); PG8_BAR;
        PG8_STAGE(PG8_SB(1, 0), cB + kstep, voffB); PG8_STAGE(PG8_SA(1, 0), cA + kstep, vA[0]); PG8_STAGE(PG8_SB(1, 1), cB + hstep + kstep, voffB);
        PG8_WAIT_V(6); PG8_BAR;
    } else {
        PG8_STAGE(PG8_SB(0, 0), cB, voffB); PG8_STAGE(PG8_SA(0, 0), cA, vA[0]); PG8_STAGE(PG8_SB(0, 1), cB + hstep, voffB); PG8_STAGE(PG8_SA(0, 1), cA, vA[1]);
        if (wr == 1) PG8_BAR;
        PG8_WAIT_V(4); PG8_BAR;
        PG8_STAGE(PG8_SB(1, 0), cB + kstep, voffB); PG8_STAGE(PG8_SA(1, 0), cA + kstep, vA[0]); PG8_STAGE(PG8_SB(1, 1), cB + hstep + kstep, voffB);
        PG8_WAIT_V(6); PG8_BAR;
    }
    for (;;) {
        const bool has_next = S.next(ui + 1, nxt);
        const char* nB = has_next ? (const char*)g.Bt + (size_t)nxt.pn * tstep : cB;
        if (has_next) { PG8_AOFF(nvA, nxt); } else {
#pragma unroll
            for (int h = 0; h < 2; ++h)
#pragma unroll
                for (int i = 0; i < 2; ++i) nvA[h][i] = vA[h][i]; }
        for (int t = 0; t < nt; t += 2) {
            const bool last = (t == nt - 2);
            const char* a1 = cA + (size_t)(t + 1) * kstep;
            const char* a2 = last ? cA : cA + (size_t)(t + 2) * kstep; const char* b2 = last ? nB : cB + (size_t)(t + 2) * kstep;
            const char* a3 = a2 + kstep; const char* b3 = b2 + kstep;
            unsigned w0[2], w1[2];
            w0[0] = last ? nvA[0][0] : vA[0][0]; w0[1] = last ? nvA[0][1] : vA[0][1]; w1[0] = last ? nvA[1][0] : vA[1][0]; w1[1] = last ? nvA[1][1] : vA[1][1];
            if (last && has_next) S.a_ready(nxt);
            if constexpr (SP2) {
            PG8_LDB(B0, 0, 0); PG8_LDB(B1, 0, 1); PG8_SCHED; PG8_LDA(At, 0, 0); PG8_STAGE(PG8_SA(1, 1), a1, vA[1]);
            PG8_WAIT_V(8); PG8_WAIT_L(0); PG8_BAR; PG8_MMA(0, 0, At, B0); PG8_MMA(0, 1, At, B1); PG8_BAR; PG8_SCHED;
            PG8_LDA(At, 0, 1); PG8_STAGE(PG8_SB(0, 0), b2, voffB); PG8_STAGE(PG8_SB(0, 1), b2 + hstep, voffB); PG8_STAGE(PG8_SA(0, 0), a2, w0);
            PG8_WAIT_V(8); PG8_WAIT_L(0); PG8_BAR; PG8_MMA(1, 0, At, B0); PG8_MMA(1, 1, At, B1); PG8_BAR; PG8_SCHED;
            PG8_LDB(B0, 1, 0); PG8_LDB(B1, 1, 1); PG8_SCHED; PG8_LDA(At, 1, 0); PG8_STAGE(PG8_SA(0, 1), a2, w1);
            PG8_WAIT_V(8); PG8_WAIT_L(0); PG8_BAR; PG8_MMA(0, 0, At, B0); PG8_MMA(0, 1, At, B1); PG8_BAR; PG8_SCHED;
            PG8_LDA(At, 1, 1); PG8_STAGE(PG8_SB(1, 0), b3, voffB); PG8_STAGE(PG8_SB(1, 1), b3 + hstep, voffB); PG8_STAGE(PG8_SA(1, 0), a3, w0);
            PG8_WAIT_V(8); PG8_WAIT_L(0); PG8_BAR; PG8_MMA(1, 0, At, B0); PG8_MMA(1, 1, At, B1); PG8_BAR; PG8_SCHED;
            } else {
            PG8_LDB(B0, 0, 0); PG8_SCHED; PG8_LDA(At, 0, 0); PG8_STAGE(PG8_SA(1, 1), a1, vA[1]);
            PG8_WAIT_L(8); PG8_BAR; PG8_WAIT_L(0); PG8_MMA(0, 0, At, B0); PG8_BAR; PG8_SCHED;
            PG8_LDB(B1, 0, 1); PG8_STAGE(PG8_SB(0, 0), b2, voffB);
            PG8_BAR; PG8_WAIT_L(0); PG8_MMA(0, 1, At, B1); PG8_BAR;
            PG8_LDA(At, 0, 1); PG8_STAGE(PG8_SA(0, 0), a2, w0);
            PG8_BAR; PG8_WAIT_L(0); PG8_MMA(1, 0, At, B0); PG8_BAR; PG8_SCHED;
            PG8_STAGE(PG8_SB(0, 1), b2 + hstep, voffB);
            PG8_WAIT_V(6); PG8_BAR; PG8_MMA(1, 1, At, B1); PG8_BAR;
            PG8_LDB(B0, 1, 0); PG8_SCHED; PG8_LDA(At, 1, 0); PG8_STAGE(PG8_SA(0, 1), a2, w1);
            PG8_WAIT_L(8); PG8_BAR; PG8_WAIT_L(0); PG8_MMA(0, 0, At, B0); PG8_BAR; PG8_SCHED;
            PG8_LDB(B1, 1, 1); PG8_STAGE(PG8_SB(1, 0), b3, voffB);
            PG8_BAR; PG8_WAIT_L(0); PG8_MMA(0, 1, At, B1); PG8_BAR;
            PG8_LDA(At, 1, 1); PG8_STAGE(PG8_SA(1, 0), a3, w0);
            PG8_BAR; PG8_WAIT_L(0); PG8_MMA(1, 0, At, B0); PG8_BAR; PG8_SCHED;
            PG8_STAGE(PG8_SB(1, 1), b3 + hstep, voffB);
            PG8_WAIT_V(6); PG8_BAR; PG8_MMA(1, 1, At, B1); PG8_BAR;
            }
        }
        if constexpr (ALIGN_EPI) { if (wr == 0) PG8_BAR; }
        E(acc, cur, wr, wc, fr, fq); S.done(cur);
        if (!has_next) break;
#pragma unroll
        for (int a = 0; a < 2; ++a)
#pragma unroll
            for (int b = 0; b < 2; ++b)
#pragma unroll
                for (int m = 0; m < 4; ++m)
#pragma unroll
                    for (int n = 0; n < 2; ++n) acc[a][b][m][n] = (f32x4){0.f, 0.f, 0.f, 0.f};
        cur = nxt; cB = nB; ++ui;
#pragma unroll
        for (int h = 0; h < 2; ++h)
#pragma unroll
            for (int i = 0; i < 2; ++i) vA[h][i] = nvA[h][i];
        if constexpr (ALIGN_EPI) { if (wr == 1) PG8_BAR; }
    }
    PG8_WAIT_V(0);
    if constexpr (!ALIGN_EPI) { if (wr == 0) PG8_BAR; }
    PG8_BAR;
#undef PG8_SA
#undef PG8_SB
#undef PG8_STAGE
#undef PG8_LDA
#undef PG8_LDB
#undef PG8_MMA
#undef PG8_WAIT_V
#undef PG8_WAIT_L
#undef PG8_BAR
#undef PG8_SCHED
#undef PG8_AOFF
}
}
#define GAS __attribute__((address_space(1)))
#define LAS __attribute__((address_space(3)))
typedef unsigned short bf16;
typedef unsigned v4u __attribute__((ext_vector_type(4)));
typedef float f32x4 __attribute__((ext_vector_type(4)));
typedef short bf16x8 __attribute__((ext_vector_type(8)));
typedef GAS unsigned gu32;
typedef GAS unsigned long long gu64;
#define RLX_AGENT __ATOMIC_RELAXED, __HIP_MEMORY_SCOPE_AGENT
#define LDS_WAIT() asm volatile("s_waitcnt lgkmcnt(0)" ::: "memory")
#define VM_WAIT() asm volatile("s_waitcnt vmcnt(0)" ::: "memory")
__device__ __forceinline__ unsigned long long rt() { return __builtin_amdgcn_s_memrealtime(); }
__device__ __forceinline__ unsigned f2bf(float f) { unsigned u = __builtin_bit_cast(unsigned, f); return (u + 0x7fffu + ((u >> 16) & 1u)) >> 16; }
__device__ __forceinline__ unsigned pk2(float lo, float hi) { return f2bf(lo) | (f2bf(hi) << 16); }

#define XB_TMO      128
#define XB_XCNT(j)  (256  + 64 * (j))
#define XB_XSUB(j)  (1280 + 64 * (j))
#define XB_XGEN(j)  (2304 + 64 * (j))
#define XB_TOP      3328
#define XB_TOPGEN   3392
#define XCD_BAR_WORDS 3456
#define XB_SPIN_CAP (1u << 22)

__device__ __forceinline__ unsigned xb_ld(unsigned* p)              { return __hip_atomic_load(p, __ATOMIC_RELAXED, __HIP_MEMORY_SCOPE_AGENT); }
__device__ __forceinline__ unsigned xb_add(unsigned* p, unsigned v) { return __hip_atomic_fetch_add(p, v, __ATOMIC_RELAXED, __HIP_MEMORY_SCOPE_AGENT); }
__device__ __forceinline__ unsigned xb_xcc_id() { return (unsigned)__builtin_amdgcn_s_getreg((3 << 11) | 20) & 0xFu; }
#define XB_SPIN(cond, bar) do { unsigned _sp = 0; while (cond) { __builtin_amdgcn_s_sleep(1); \
    if ((++_sp & 255u) == 0u) { if (xb_ld(&(bar)[XB_TMO])) break; if (_sp > XB_SPIN_CAP) { atomicAdd(&(bar)[XB_TMO], 1u); break; } } } } while (0)

struct XcdBarrier {
    unsigned* bar; unsigned x;
    volatile LAS unsigned* st;
};

__device__ __forceinline__ XcdBarrier xcd_barrier_post(unsigned* bar, volatile LAS unsigned* st) {
    XcdBarrier b; b.bar = bar; b.x = xb_xcc_id(); b.st = st;
    if (threadIdx.x == 0) (void)xb_add(&bar[XB_XCNT(b.x)], 1u);
    return b;
}
__device__ __forceinline__ void xcd_barrier_complete(unsigned* bar, unsigned x, unsigned& nloc, unsigned& nx) {
    const unsigned G = gridDim.x * gridDim.y * gridDim.z;
    unsigned sum, cnt, mine, sp = 0u;
    for (;;) {
        sum = 0u; cnt = 0u; mine = 0u;
#pragma unroll
        for (unsigned j = 0; j < 16; ++j) { const unsigned c = xb_ld(&bar[XB_XCNT(j)]); sum += c; cnt += (c > 0u) ? 1u : 0u; mine = (j == x) ? c : mine; }
        if (sum == G) break;
        __builtin_amdgcn_s_sleep(1);
        if ((++sp & 255u) == 0u) { if (xb_ld(&bar[XB_TMO])) break; if (sp > XB_SPIN_CAP) { atomicAdd(&bar[XB_TMO], 1u); break; } }
    }
    nloc = mine > 0u ? mine : 1u; nx = cnt > 0u ? cnt : 1u;
}

__device__ __forceinline__ void xcd_barrier(const XcdBarrier& b) {
    asm volatile("s_waitcnt vmcnt(0)" ::: "memory");
    __syncthreads();
    if (threadIdx.x == 0) {
        unsigned* bar = b.bar;
        __builtin_amdgcn_s_waitcnt(0);
        unsigned nloc = b.st[0], nx = b.st[1];
        if (nloc == 0u) { xcd_barrier_complete(bar, b.x, nloc, nx); b.st[0] = nloc; b.st[1] = nx; }
        const unsigned old = xb_add(&bar[XB_XSUB(b.x)], 1u);
        const unsigned gen = old / nloc;
        if (old + 1u == (gen + 1u) * nloc) {
            __builtin_amdgcn_fence(__ATOMIC_RELEASE, "agent");
            asm volatile("s_waitcnt vmcnt(0)" ::: "memory");
            const unsigned og = xb_add(&bar[XB_TOP], 1u);
            const unsigned tg = og / nx;
            if (og + 1u == (tg + 1u) * nx) xb_add(&bar[XB_TOPGEN], 1u);
            else XB_SPIN(xb_ld(&bar[XB_TOPGEN]) == tg, bar);
            __builtin_amdgcn_fence(__ATOMIC_ACQUIRE, "agent");
            xb_add(&bar[XB_XGEN(b.x)], 1u);
            asm volatile("s_waitcnt vmcnt(0)" ::: "memory");
        } else {
            XB_SPIN(xb_ld(&bar[XB_XGEN(b.x)]) == gen, bar);
            __builtin_amdgcn_fence(__ATOMIC_ACQUIRE, "agent");
            asm volatile("s_waitcnt vmcnt(0)" ::: "memory");
        }
    }
    __syncthreads();
}

constexpr int NWAVES = 8;
constexpr int BATCH = 2, SEQ = 4096, M = BATCH * SEQ, D = 2048;
constexpr int NPW = 11784;
constexpr int NP = 11776;
constexpr int C_AQ = 0, C_AK = 1536, C_AV = 3072, C_MQK = 4608, C_MV = 5632, C_MO = 6656, C_GATE = 7680;
constexpr int NE = 32, DFF = 1408, ECAP = 8192, MAXT = 96, NT1 = DFF / 128  , NT2 = D / 256  ;
constexpr float LN_EPS = 1e-5f, ALPHA = 1.189207115002721f, QSCALE = 0.08838834764831845f;
constexpr size_t MiB = 1u << 20;
constexpr size_t WS_CTL = 0, CTL_ZERO_BYTES = 1 * MiB;
constexpr size_t WS_WIN = 2 * MiB, WS_WPA = 48 * MiB, WS_WPM = 50 * MiB, WS_WOUT = 54 * MiB, WS_WGU = 62 * MiB, WS_WD = 414 * MiB;
constexpr size_t WS_HB = 590 * MiB, WS_STATS = 622 * MiB, WS_MIF = 622 * MiB + 512 * 1024, WS_PROJ = 623 * MiB;
constexpr size_t WS_ATTO = 807 * MiB, WS_LSE = 831 * MiB, WS_ATT = 832 * MiB, WS_QKC = 840 * MiB, WS_NUM = 856 * MiB, WS_DEN = 888 * MiB, WS_MT = 888 * MiB + 512 * 1024;
constexpr size_t WS_HM = 889 * MiB, WS_TMP = 905 * MiB, WS_MERGED = 969 * MiB, WS_H1 = 1001 * MiB, WS_H1B = 1065 * MiB, WS_TOKLIST = 1097 * MiB, WS_TOKINFO = 1098 * MiB;
constexpr size_t WS_ACT = WS_PROJ, WS_YS = 689 * MiB;
constexpr size_t WS_END = 1200 * MiB;
static_assert(WS_WIN + (size_t)NP * D * 2 <= WS_WPA && WS_WGU + (size_t)NE * 2 * DFF * D * 2 <= WS_WD && WS_WD + (size_t)NE * D * DFF * 2 <= WS_HB, "weights map");
static_assert(WS_PROJ + (size_t)M * NP * 2 <= WS_ATTO && WS_ACT + (size_t)MAXT * 256 * DFF * 2 <= WS_YS && WS_YS + (size_t)MAXT * 256 * D * 2 <= WS_ATTO, "activation map");
constexpr int CW_TMO = 0, CW_CODE = 1, CW_BAR = 4096, CW_CNT = 65536;
constexpr int RING_OFF = 0, RING_BYTES = 131072, LDSCTL_OFF = RING_BYTES, MISC_OFF = LDSCTL_OFF + 320, TS_OFF = LDSCTL_OFF + 512, CNT_OFF = LDSCTL_OFF + 768, GATE_OFF = LDSCTL_OFF + 1024;
constexpr int LDS_BYTES = 147456;

struct Frame { LAS unsigned char* lds; gu32* ctl; int tid, lane, wave, vcu, G; unsigned char* ws; };

__device__ __forceinline__ float wave_sum(float v) {
#pragma unroll
    for (int o = 1; o < 64; o <<= 1) v += __shfl_xor(v, o);
    return v;
}
__device__ __forceinline__ float wave_max(float v) {
#pragma unroll
    for (int o = 1; o < 64; o <<= 1) v = fmaxf(v, __shfl_xor(v, o));
    return v;
}
__device__ __forceinline__ float bflo(unsigned w) { return __uint_as_float(w << 16); }
__device__ __forceinline__ float bfhi(unsigned w) { return __uint_as_float(w & 0xffff0000u); }
__device__ __forceinline__ float sigm(float x) { return 1.0f / (1.0f + __expf(-x)); }

__device__ __forceinline__ void tr_item(const float* W, int ldw, int k0, int c0, bf16* WT, size_t drow0, int Kd, LAS float* scr, int lane) {
#pragma unroll 8
    for (int i = 0; i < 32; ++i) { const int kk = 2 * i + (lane >> 5); scr[kk * 33 + (lane & 31)] = W[(size_t)(k0 + kk) * ldw + c0 + (lane & 31)]; }
    LDS_WAIT(); asm volatile("" ::: "memory");
    const int c = lane & 7;
#pragma unroll
    for (int j = 0; j < 4; ++j) { const int n = (lane >> 3) + 8 * j; const LAS float* s = scr + (8 * c) * 33 + n;
        v4u o; o.x = pk2(s[0 * 33], s[1 * 33]); o.y = pk2(s[2 * 33], s[3 * 33]); o.z = pk2(s[4 * 33], s[5 * 33]); o.w = pk2(s[6 * 33], s[7 * 33]);
        *(GAS v4u*)(WT + (drow0 + n) * Kd + k0 + 8 * c) = o; }
    LDS_WAIT(); asm volatile("" ::: "memory");
}
constexpr int I_WINA = 32 * 240, I_WINB = 32 * 128, I_WPA = 8 * 64, I_WPM = 16 * 64, I_WOUT = 32 * 64, I_EXP = NE * 32 * 44, I_DN = NE * 22 * 64;
constexpr int I_TOTAL = I_WINA + I_WINB + I_WPA + I_WPM + I_WOUT + 2 * I_EXP + I_DN;

__device__ __forceinline__ void p0_prologue(Frame& F, const float* x, const float* lng, const float* lnb, const float* w_in, const float* if_bias, const float* wpa, const float* wpm, const float* wout,
                                            const float* wgate, const float* wup, const float* wdown) {
    unsigned char* ws = F.ws;
    LAS float* scr = (LAS float*)(F.lds + RING_OFF + F.wave * 16384);
    const int gw = F.vcu * NWAVES + F.wave, NGW = F.G * NWAVES;
    for (int it0 = gw; it0 < I_TOTAL; it0 += NGW) {
        int it = it0;
        if (it < I_WINA) { const int kb = it / 240, nb = it % 240; tr_item(w_in, NPW, 64 * kb, 32 * nb, (bf16*)(ws + WS_WIN), (size_t)32 * nb, D, scr, F.lane); continue; } it -= I_WINA;
        if (it < I_WINB) { const int kb = it / 128, nb = it % 128; tr_item(w_in, NPW, 64 * kb, 7688 + 32 * nb, (bf16*)(ws + WS_WIN), (size_t)7680 + 32 * nb, D, scr, F.lane); continue; } it -= I_WINB;
        if (it < I_WPA) { const int kb = it / 64, nb = it % 64; tr_item(wpa, D, 64 * kb, 32 * nb, (bf16*)(ws + WS_WPA), (size_t)32 * nb, 512, scr, F.lane); continue; } it -= I_WPA;
        if (it < I_WPM) { const int kb = it / 64, nb = it % 64; tr_item(wpm, D, 64 * kb, 32 * nb, (bf16*)(ws + WS_WPM), (size_t)32 * nb, 1024, scr, F.lane); continue; } it -= I_WPM;
        if (it < I_WOUT) { const int kb = it / 64, nb = it % 64; tr_item(wout, D, 64 * kb, 32 * nb, (bf16*)(ws + WS_WOUT), (size_t)32 * nb, D, scr, F.lane); continue; } it -= I_WOUT;
        if (it < 2 * I_EXP) { const int up = it >= I_EXP ? 1 : 0; if (up) it -= I_EXP; const int e = it / 1408, r = it % 1408, kb = r / 44, nb = r % 44, j0 = 32 * nb;
            const float* src = (up ? wup : wgate) + (size_t)e * D * DFF;
            tr_item(src, DFF, 64 * kb, j0, (bf16*)(ws + WS_WGU), (size_t)e * 2816 + (size_t)(j0 / 128) * 256 + (j0 % 128) + 128 * up, D, scr, F.lane); continue; } it -= 2 * I_EXP;
        { const int e = it / 1408, r = it % 1408, kb = r / 64, nb = r % 64;
            tr_item(wdown + (size_t)e * DFF * D, D, 64 * kb, 32 * nb, (bf16*)(ws + WS_WD), (size_t)e * D + 32 * nb, DFF, scr, F.lane); }
    }
    __syncthreads();
    LAS float* wif = (LAS float*)(F.lds + RING_OFF);
    for (int k = F.tid; k < D; k += NWAVES * 64) { const f32x4 a = *(const f32x4*)(w_in + (size_t)k * NPW + 7680), b = *(const f32x4*)(w_in + (size_t)k * NPW + 7684);
        *(LAS f32x4*)(wif + k * 8) = a; *(LAS f32x4*)(wif + k * 8 + 4) = b; }
    __syncthreads();
    bf16* HB = (bf16*)(ws + WS_HB); float* STATS = (float*)(ws + WS_STATS); float* MIF = (float*)(ws + WS_MIF);
    for (int m = gw; m < M; m += NGW) {
        const f32x4* xr = (const f32x4*)(x + (size_t)m * D) + F.lane;
        f32x4 v[8]; float s = 0.f;
#pragma unroll
        for (int j = 0; j < 8; ++j) { v[j] = xr[64 * j]; s += (v[j][0] + v[j][1]) + (v[j][2] + v[j][3]); }
        const float mean = wave_sum(s) * (1.f / D); float s2 = 0.f;
#pragma unroll
        for (int j = 0; j < 8; ++j) { const f32x4 d = v[j] - mean; s2 += (d[0] * d[0] + d[1] * d[1]) + (d[2] * d[2] + d[3] * d[3]); }
        const float rstd = rsqrtf(wave_sum(s2) * (1.f / D) + LN_EPS);
        float a[8];
#pragma unroll
        for (int i = 0; i < 8; ++i) a[i] = 0.f;
        unsigned long long* o8 = (unsigned long long*)(HB + (size_t)m * D) + F.lane;
#pragma unroll
        for (int j = 0; j < 8; ++j) { const int k0 = 4 * F.lane + 256 * j; const f32x4 g4 = *(const f32x4*)(lng + k0), b4 = *(const f32x4*)(lnb + k0);
            const f32x4 hv = (v[j] - mean) * rstd * g4 + b4;
            o8[64 * j] = (unsigned long long)pk2(hv[0], hv[1]) | ((unsigned long long)pk2(hv[2], hv[3]) << 32);
#pragma unroll
            for (int c = 0; c < 4; ++c) { const f32x4 w0 = *(const LAS f32x4*)(wif + (k0 + c) * 8), w1 = *(const LAS f32x4*)(wif + (k0 + c) * 8 + 4);
                a[0] += hv[c] * w0[0]; a[1] += hv[c] * w0[1]; a[2] += hv[c] * w0[2]; a[3] += hv[c] * w0[3]; a[4] += hv[c] * w1[0]; a[5] += hv[c] * w1[1]; a[6] += hv[c] * w1[2]; a[7] += hv[c] * w1[3]; }
            asm volatile("" ::: "memory"); }
#pragma unroll
        for (int i = 0; i < 8; ++i) a[i] = wave_sum(a[i]);
        if (F.lane == 0) { STATS[2 * m] = mean; STATS[2 * m + 1] = rstd;
#pragma unroll
            for (int i = 0; i < 8; ++i) MIF[(size_t)m * 8 + i] = a[i] + if_bias[i]; }
    }
}

__device__ __forceinline__ float alibi_slope(int h) {
    switch (h) { case 0: return 0.70710678118654752f; case 1: return 0.5f; case 2: return 0.35355339059327379f; case 3: return 0.25f; case 4: return 0.17677669529663689f; case 5: return 0.125f;
        case 6: return 0.088388347648318447f; case 7: return 0.0625f; case 8: return 0.03125f; case 9: return 0.015625f; case 10: return 0.0078125f; default: return 0.00390625f; }
}
__device__ __forceinline__ void attn_naive(Frame& F) {
    const bf16* PROJ = (const bf16*)(F.ws + WS_PROJ); bf16* ATTO = (bf16*)(F.ws + WS_ATTO); float* LSE = (float*)(F.ws + WS_LSE);
    LAS float* pbuf = (LAS float*)(F.lds + RING_OFF) + F.wave * 256;
    const int gw = F.vcu * NWAVES + F.wave, NGW = F.G * NWAVES;
    for (int it = gw; it < M * 12; it += NGW) {
        const int h = it / M, m = it % M, t = m % SEQ, g = h >> 2, r = (g == 0) ? 1 : (g == 1 ? 4 : 16);
        const float slope = alibi_slope(h);
        const bf16* qp = PROJ + (size_t)m * NP + C_AQ + h * 128;
        float sc[3];
#pragma unroll
        for (int jj = 0; jj < 3; ++jj) {
            const int j = F.lane + 64 * jj; const bool valid = (j <= 128) && (t - j * r >= 0);
            float dot = 0.f;
            if (valid) { const bf16* kp = PROJ + (size_t)(m - j * r) * NP + C_AK + h * 128;
#pragma unroll 4
                for (int c = 0; c < 16; ++c) { const v4u qv = *(const v4u*)(qp + 8 * c), kv = *(const v4u*)(kp + 8 * c);
                    dot += bflo(qv.x) * bflo(kv.x) + bfhi(qv.x) * bfhi(kv.x) + bflo(qv.y) * bflo(kv.y) + bfhi(qv.y) * bfhi(kv.y) + bflo(qv.z) * bflo(kv.z) + bfhi(qv.z) * bfhi(kv.z) + bflo(qv.w) * bflo(kv.w) + bfhi(qv.w) * bfhi(kv.w); } }
            sc[jj] = valid ? dot * QSCALE - slope * (float)(j * r) : -INFINITY;
        }
        const float mx = wave_max(fmaxf(fmaxf(sc[0], sc[1]), sc[2]));
        float ps = 0.f;
#pragma unroll
        for (int jj = 0; jj < 3; ++jj) { const float p = (sc[jj] == -INFINITY) ? 0.f : __expf(sc[jj] - mx); ps += p; pbuf[F.lane + 64 * jj] = p; }
        const float l = wave_sum(ps);
        LDS_WAIT(); asm volatile("" ::: "memory");
        const int nk = ((t / r) < 128 ? (t / r) : 128) + 1;
        float o0 = 0.f, o1 = 0.f;
        const bf16* vp = PROJ + (size_t)m * NP + C_AV + h * 128 + 2 * F.lane;
        for (int j = 0; j < nk; ++j) { const float p = pbuf[j]; const unsigned w = *(const unsigned*)(vp - (size_t)j * r * NP); o0 += p * bflo(w); o1 += p * bfhi(w); }
        const float il = 1.f / l;
        *(unsigned*)(ATTO + (size_t)m * 1536 + h * 128 + 2 * F.lane) = pk2(o0 * il, o1 * il);
        if (F.lane == 0) LSE[(size_t)m * 12 + h] = mx + __logf(l);
        LDS_WAIT(); asm volatile("" ::: "memory");
    }
}
__device__ __forceinline__ void conv_qk(Frame& F, const float* conv_w, const float* conv_b) {
    const bf16* PROJ = (const bf16*)(F.ws + WS_PROJ); bf16* QKC = (bf16*)(F.ws + WS_QKC);
    const int gt = F.vcu * (NWAVES * 64) + F.tid, NT = F.G * NWAVES * 64;
    for (int idx = gt; idx < M * 128; idx += NT) {
        const int m = idx >> 7, c8 = (idx & 127) * 8, t = m % SEQ;
        float acc[8];
#pragma unroll
        for (int i = 0; i < 8; ++i) acc[i] = conv_b[c8 + i];
#pragma unroll
        for (int j = 0; j < 4; ++j) { const int tt = t - 3 + j; if (tt < 0) continue;
            const v4u w = *(const v4u*)(PROJ + (size_t)(m - 3 + j) * NP + C_MQK + c8);
            const f32x4 c0 = *(const f32x4*)(conv_w + j * 1024 + c8), c1 = *(const f32x4*)(conv_w + j * 1024 + c8 + 4);
            acc[0] += c0[0] * bflo(w.x); acc[1] += c0[1] * bfhi(w.x); acc[2] += c0[2] * bflo(w.y); acc[3] += c0[3] * bfhi(w.y);
            acc[4] += c1[0] * bflo(w.z); acc[5] += c1[1] * bfhi(w.z); acc[6] += c1[2] * bflo(w.w); acc[7] += c1[3] * bfhi(w.w); }
#pragma unroll
        for (int i = 0; i < 8; ++i) acc[i] = acc[i] * sigm(acc[i]);
        v4u o; o.x = pk2(acc[0], acc[1]); o.y = pk2(acc[2], acc[3]); o.z = pk2(acc[4], acc[5]); o.w = pk2(acc[6], acc[7]);
        *(v4u*)(QKC + (size_t)m * 1024 + c8) = o;
    }
}

__device__ __forceinline__ float log_sigmoid(float x) { return fminf(x, 0.f) - log1pf(__expf(-fabsf(x))); }
__device__ __forceinline__ void mlstm_naive(Frame& F, int bh) {
    const int b = bh >> 2, h = bh & 3;
    const bf16* PROJ = (const bf16*)(F.ws + WS_PROJ); const bf16* QKC = (const bf16*)(F.ws + WS_QKC); const float* MIF = (const float*)(F.ws + WS_MIF);
    float* NUM = (float*)(F.ws + WS_NUM); float* DEN = (float*)(F.ws + WS_DEN); float* MT = (float*)(F.ws + WS_MT);
    LAS float* qs = (LAS float*)(F.lds + RING_OFF); LAS float* ks = qs + 64 * 128; LAS bf16* vs = (LAS bf16*)(ks + 64 * 128);
    LAS float* gi = (LAS float*)(F.lds + GATE_OFF); LAS float* gf = gi + 64;
    float C[128];
#pragma unroll
    for (int d = 0; d < 128; ++d) C[d] = 0.f;
    float mst = 0.f;
    for (int c = 0; c < SEQ / 64; ++c) {
        __syncthreads();
        const size_t row0 = (size_t)b * SEQ + (size_t)c * 64;
        for (int idx = F.tid; idx < 64 * 32; idx += NWAVES * 64) { const int s = idx >> 5, c8 = idx & 31;
            const bf16* src = QKC + (row0 + s) * 1024 + (c8 < 16 ? h * 128 + c8 * 8 : 512 + h * 128 + (c8 - 16) * 8);
            const v4u w = *(const v4u*)src; const float sc = c8 < 16 ? QSCALE : 1.f;
            LAS float* dst = (c8 < 16 ? qs + s * 128 + c8 * 8 : ks + s * 128 + (c8 - 16) * 8);
            *(LAS f32x4*)dst = (f32x4){bflo(w.x) * sc, bfhi(w.x) * sc, bflo(w.y) * sc, bfhi(w.y) * sc}; *(LAS f32x4*)(dst + 4) = (f32x4){bflo(w.z) * sc, bfhi(w.z) * sc, bflo(w.w) * sc, bfhi(w.w) * sc};
            *(LAS v4u*)(vs + s * 256 + c8 * 8) = *(const v4u*)(PROJ + (row0 + s) * NP + C_MV + h * 256 + c8 * 8); }
        if (F.tid < 64) { gi[F.tid] = MIF[(row0 + F.tid) * 8 + h]; gf[F.tid] = log_sigmoid(MIF[(row0 + F.tid) * 8 + 4 + h]); }
        __syncthreads();
        if (F.tid <= 256) {
            for (int s = 0; s < 64; ++s) {
                const float lf = gf[s], ip = gi[s];
                const float mn = fmaxf(lf + mst, ip), fg = __expf(lf + mst - mn), ig = __expf(ip - mn); mst = mn;
                const float vv = (F.tid < 256) ? __uint_as_float((unsigned)vs[s * 256 + (F.tid & 255)] << 16) : 1.f;
                const float a = ig * vv; float num = 0.f;
#pragma unroll
                for (int d4 = 0; d4 < 32; ++d4) { const f32x4 kk = *(const LAS f32x4*)(ks + s * 128 + 4 * d4), qq = *(const LAS f32x4*)(qs + s * 128 + 4 * d4);
#pragma unroll
                    for (int e = 0; e < 4; ++e) { C[4 * d4 + e] = fg * C[4 * d4 + e] + a * kk[e]; num += C[4 * d4 + e] * qq[e]; } }
                if (F.tid < 256) NUM[(row0 + s) * 1024 + h * 256 + F.tid] = num; else { DEN[(row0 + s) * 4 + h] = num; MT[(row0 + s) * 4 + h] = mn; }
            }
        }
    }
}
__device__ __forceinline__ void attn_merge(Frame& F, int first_wg) {
    const bf16* ATTO = (const bf16*)(F.ws + WS_ATTO); const float* LSE = (const float*)(F.ws + WS_LSE); bf16* ATT = (bf16*)(F.ws + WS_ATT);
    const int gt = (F.vcu - first_wg) * (NWAVES * 64) + F.tid, NT = (F.G - first_wg) * NWAVES * 64;
    for (int idx = gt; idx < M * 64; idx += NT) {
        const int m = idx >> 6, r = idx & 63, j = r >> 4, d8 = (r & 15) * 8;
        const float l0 = LSE[(size_t)m * 12 + j], l1 = LSE[(size_t)m * 12 + 4 + j], l2 = LSE[(size_t)m * 12 + 8 + j], mx = fmaxf(fmaxf(l0, l1), l2);
        float e0 = __expf(l0 - mx), e1 = __expf(l1 - mx), e2 = __expf(l2 - mx); const float inv = 1.f / (e0 + e1 + e2); e0 *= inv; e1 *= inv; e2 *= inv;
        const v4u a = *(const v4u*)(ATTO + (size_t)m * 1536 + j * 128 + d8), b = *(const v4u*)(ATTO + (size_t)m * 1536 + 512 + j * 128 + d8), c = *(const v4u*)(ATTO + (size_t)m * 1536 + 1024 + j * 128 + d8);
        v4u o;
        o.x = pk2(e0 * bflo(a.x) + e1 * bflo(b.x) + e2 * bflo(c.x), e0 * bfhi(a.x) + e1 * bfhi(b.x) + e2 * bfhi(c.x));
        o.y = pk2(e0 * bflo(a.y) + e1 * bflo(b.y) + e2 * bflo(c.y), e0 * bfhi(a.y) + e1 * bfhi(b.y) + e2 * bfhi(c.y));
        o.z = pk2(e0 * bflo(a.z) + e1 * bflo(b.z) + e2 * bflo(c.z), e0 * bfhi(a.z) + e1 * bfhi(b.z) + e2 * bfhi(c.z));
        o.w = pk2(e0 * bflo(a.w) + e1 * bflo(b.w) + e2 * bflo(c.w), e0 * bfhi(a.w) + e1 * bfhi(b.w) + e2 * bfhi(c.w));
        *(v4u*)(ATT + (size_t)m * 512 + j * 128 + d8) = o;
    }
}
__device__ __forceinline__ void mlstm_post(Frame& F, const float* norm_w) {
    const bf16* PROJ = (const bf16*)(F.ws + WS_PROJ); const float* NUM = (const float*)(F.ws + WS_NUM); const float* DEN = (const float*)(F.ws + WS_DEN); const float* MT = (const float*)(F.ws + WS_MT);
    bf16* HM = (bf16*)(F.ws + WS_HM);
    const int gw = F.vcu * NWAVES + F.wave, NGW = F.G * NWAVES;
    for (int it = gw; it < M * 4; it += NGW) {
        const int m = it >> 2, h = it & 3;
        const f32x4 nv = *(const f32x4*)(NUM + (size_t)m * 1024 + h * 256 + 4 * F.lane);
        const float den = DEN[(size_t)m * 4 + h], mt = MT[(size_t)m * 4 + h];
        const float dn = 1.f / fmaxf(fabsf(den), __expf(-mt));
        const f32x4 hv = nv * dn;
        const float mean = wave_sum((hv[0] + hv[1]) + (hv[2] + hv[3])) * (1.f / 256.f);
        const f32x4 dv = hv - mean;
        const float var = wave_sum((dv[0] * dv[0] + dv[1] * dv[1]) + (dv[2] * dv[2] + dv[3] * dv[3])) * (1.f / 256.f);
        const float rs = rsqrtf(var + LN_EPS);
        const f32x4 nw = *(const f32x4*)(norm_w + h * 256 + 4 * F.lane);
        const unsigned long long ow = *(const unsigned long long*)(PROJ + (size_t)m * NP + C_MO + h * 256 + 4 * F.lane);
        const unsigned w0 = (unsigned)ow, w1 = (unsigned)(ow >> 32);
        const float y0 = dv[0] * rs * nw[0] * sigm(bflo(w0)), y1 = dv[1] * rs * nw[1] * sigm(bfhi(w0)), y2 = dv[2] * rs * nw[2] * sigm(bflo(w1)), y3 = dv[3] * rs * nw[3] * sigm(bfhi(w1));
        *(unsigned long long*)(HM + (size_t)m * 1024 + h * 256 + 4 * F.lane) = (unsigned long long)pk2(y0, y1) | ((unsigned long long)pk2(y2, y3) << 32);
    }
}
__device__ __forceinline__ void ln1_router(Frame& F, const float* g1, const float* b1, const float* wrg, const float* brg, const float* wre, const float* bre) {
    const float* PRE = (const float*)(F.ws + WS_TMP); float* H1 = (float*)(F.ws + WS_H1); bf16* H1B = (bf16*)(F.ws + WS_H1B);
    int* TOKLIST = (int*)(F.ws + WS_TOKLIST); int* TOKINFO = (int*)(F.ws + WS_TOKINFO);
    const int gw = F.vcu * NWAVES + F.wave, NGW = F.G * NWAVES;
    for (int m = gw; m < M; m += NGW) {
        const f32x4* xr = (const f32x4*)(PRE + (size_t)m * D) + F.lane;
        f32x4 v[8]; float s = 0.f;
#pragma unroll
        for (int j = 0; j < 8; ++j) { v[j] = xr[64 * j]; s += (v[j][0] + v[j][1]) + (v[j][2] + v[j][3]); }
        const float mean = wave_sum(s) * (1.f / D); float s2 = 0.f;
#pragma unroll
        for (int j = 0; j < 8; ++j) { const f32x4 d = v[j] - mean; s2 += (d[0] * d[0] + d[1] * d[1]) + (d[2] * d[2] + d[3] * d[3]); }
        const float rstd = rsqrtf(wave_sum(s2) * (1.f / D) + LN_EPS);
        float ae[32], ag[4];
#pragma unroll
        for (int i = 0; i < 32; ++i) ae[i] = 0.f;
#pragma unroll
        for (int i = 0; i < 4; ++i) ag[i] = 0.f;
        f32x4* h1r = (f32x4*)(H1 + (size_t)m * D) + F.lane; unsigned long long* o8 = (unsigned long long*)(H1B + (size_t)m * D) + F.lane;
#pragma unroll
        for (int j = 0; j < 8; ++j) { const int k0 = 4 * F.lane + 256 * j; const f32x4 g4 = *(const f32x4*)(g1 + k0), b4 = *(const f32x4*)(b1 + k0);
            const f32x4 hv = (v[j] - mean) * rstd * g4 + b4;
            h1r[64 * j] = hv; o8[64 * j] = (unsigned long long)pk2(hv[0], hv[1]) | ((unsigned long long)pk2(hv[2], hv[3]) << 32);
#pragma unroll
            for (int c = 0; c < 4; ++c) { const f32x4 wg = *(const f32x4*)(wrg + (size_t)(k0 + c) * 4);
                ag[0] += hv[c] * wg[0]; ag[1] += hv[c] * wg[1]; ag[2] += hv[c] * wg[2]; ag[3] += hv[c] * wg[3];
#pragma unroll
                for (int q = 0; q < 8; ++q) { const f32x4 we = *(const f32x4*)(wre + (size_t)(k0 + c) * 32 + 4 * q);
                    ae[4 * q] += hv[c] * we[0]; ae[4 * q + 1] += hv[c] * we[1]; ae[4 * q + 2] += hv[c] * we[2]; ae[4 * q + 3] += hv[c] * we[3]; } } }
#pragma unroll
        for (int i = 0; i < 4; ++i) ag[i] = wave_sum(ag[i]) + brg[i];
#pragma unroll
        for (int i = 0; i < 32; ++i) ae[i] = wave_sum(ae[i]) + bre[i];
        int grp = 0; float gm = ag[0];
#pragma unroll
        for (int i = 1; i < 4; ++i) if (ag[i] > gm) { gm = ag[i]; grp = i; }
        float gs = 0.f;
#pragma unroll
        for (int i = 0; i < 4; ++i) gs += __expf(ag[i] - gm);
        const float gwt = 1.f / gs;
        float el[8];
#pragma unroll
        for (int i = 0; i < 8; ++i) el[i] = grp == 0 ? ae[i] : (grp == 1 ? ae[8 + i] : (grp == 2 ? ae[16 + i] : ae[24 + i]));
        int i1 = 0; float v1 = el[0];
#pragma unroll
        for (int i = 1; i < 8; ++i) if (el[i] > v1) { v1 = el[i]; i1 = i; }
        int i2 = -1; float v2 = -INFINITY;
#pragma unroll
        for (int i = 0; i < 8; ++i) if (i != i1 && el[i] > v2) { v2 = el[i]; i2 = i; }
        const float ex = __expf(v2 - v1), p1 = 1.f / (1.f + ex), p2 = ex * p1;
        if (F.lane == 0) {
            const int e1 = grp * 8 + i1, e2 = grp * 8 + i2;
            const int pos1 = (int)__hip_atomic_fetch_add(F.ctl + CW_CNT + 16 * e1, 1u, RLX_AGENT), pos2 = (int)__hip_atomic_fetch_add(F.ctl + CW_CNT + 16 * e2, 1u, RLX_AGENT);
            TOKLIST[e1 * ECAP + pos1] = m; TOKLIST[e2 * ECAP + pos2] = m;
            int* ti = TOKINFO + (size_t)m * 8; ti[0] = e1; ti[1] = pos1; ti[2] = e2; ti[3] = pos2; ti[4] = __float_as_int(gwt * p1); ti[5] = __float_as_int(gwt * p2);
        }
    }
}
struct MoeOrder {
    const LAS int* TS; const LAS int* CN; const int* toklist; int NT, G, c, U; bool gather;
    __device__ __forceinline__ void init(const LAS int* ts, const LAS int* cn, const int* tl, int nt, int G_, int c_, bool ga) { TS = ts; CN = cn; toklist = tl; NT = nt; G = G_; c = c_; U = ts[NE] * nt; gather = ga; }
    __device__ __forceinline__ bool next(int i, pg8::Unit& u) const {
        const int x = c & 7, r = c >> 3, W = G >> 3;
        const int lo = (int)(((long)U * x) >> 3), hi = (int)(((long)U * (x + 1)) >> 3);
        const int L = lo + r + i * W; if (L >= hi) return false;
        int e = 0;
#pragma unroll 1
        for (int k = 1; k < NE; ++k) if (L >= TS[k] * NT) e = k;
        const int ne = TS[e + 1] - TS[e], loc = L - TS[e] * NT, n_t = loc / ne, m_t = loc % ne;
        u.pm = TS[e] + m_t; u.pn = e * NT + n_t; u.e = e; u.r0 = m_t * 256; return true;
    }
    __device__ __forceinline__ int arow(const pg8::Unit& u, int r) const {
        if (!gather) return u.pm * 256 + r;
        int idx = u.r0 + r; const int cn = CN[u.e]; idx = idx < cn ? idx : cn - 1;
        return toklist[u.e * ECAP + idx];
    }
    __device__ __forceinline__ void a_ready(const pg8::Unit&) const {}
    __device__ __forceinline__ void done(const pg8::Unit&) const {}
};
__device__ __forceinline__ void moe_tables(Frame& F) {
    LAS int* TS = (LAS int*)(F.lds + TS_OFF); LAS int* CN = (LAS int*)(F.lds + CNT_OFF);
    if (F.tid < NE) CN[F.tid] = (int)__hip_atomic_load(F.ctl + CW_CNT + 16 * F.tid, RLX_AGENT);
    __syncthreads();
    if (F.tid == 0) { int acc = 0; for (int e = 0; e < NE; ++e) { TS[e] = acc; acc += (CN[e] + 255) >> 8; } TS[NE] = acc; }
    __syncthreads();
}
__device__ __forceinline__ void final_ln(Frame& F, const float* g2, const float* b2, float* out) {
    const float* H1 = (const float*)(F.ws + WS_H1); const bf16* YS = (const bf16*)(F.ws + WS_YS); const int* TOKINFO = (const int*)(F.ws + WS_TOKINFO);
    const LAS int* TS = (const LAS int*)(F.lds + TS_OFF);
    const int gw = F.vcu * NWAVES + F.wave, NGW = F.G * NWAVES;
    for (int m = gw; m < M; m += NGW) {
        const int* ti = TOKINFO + (size_t)m * 8;
        const int e1 = ti[0], p1 = ti[1], e2 = ti[2], p2 = ti[3]; const float w1 = __int_as_float(ti[4]), w2 = __int_as_float(ti[5]);
        const size_t sl1 = (size_t)TS[e1] * 256 + p1, sl2 = (size_t)TS[e2] * 256 + p2;
        const f32x4* hr = (const f32x4*)(H1 + (size_t)m * D) + F.lane;
        const unsigned long long* y1 = (const unsigned long long*)(YS + sl1 * D) + F.lane; const unsigned long long* y2 = (const unsigned long long*)(YS + sl2 * D) + F.lane;
        f32x4 v[8]; float s = 0.f;
#pragma unroll
        for (int j = 0; j < 8; ++j) { const f32x4 hv = hr[64 * j]; const unsigned long long a = y1[64 * j], b = y2[64 * j];
            const unsigned a0 = (unsigned)a, a1 = (unsigned)(a >> 32), b0 = (unsigned)b, b1 = (unsigned)(b >> 32);
            f32x4 y; y[0] = w1 * bflo(a0) + w2 * bflo(b0); y[1] = w1 * bfhi(a0) + w2 * bfhi(b0); y[2] = w1 * bflo(a1) + w2 * bflo(b1); y[3] = w1 * bfhi(a1) + w2 * bfhi(b1);
            v[j] = hv * ALPHA + y; s += (v[j][0] + v[j][1]) + (v[j][2] + v[j][3]); }
        const float mean = wave_sum(s) * (1.f / D); float s2 = 0.f;
#pragma unroll
        for (int j = 0; j < 8; ++j) { const f32x4 d = v[j] - mean; s2 += (d[0] * d[0] + d[1] * d[1]) + (d[2] * d[2] + d[3] * d[3]); }
        const float rstd = rsqrtf(wave_sum(s2) * (1.f / D) + LN_EPS);
        f32x4* orow = (f32x4*)(out + (size_t)m * D) + F.lane;
#pragma unroll
        for (int j = 0; j < 8; ++j) { const int k0 = 4 * F.lane + 256 * j; const f32x4 g4 = *(const f32x4*)(g2 + k0), b4 = *(const f32x4*)(b2 + k0);
            orow[64 * j] = (v[j] - mean) * rstd * g4 + b4; }
    }
}

#ifndef SKIPMASK
#define SKIPMASK 0
#endif
constexpr int N_PHASES = 11;
struct Args { const float* in[22]; float* out; unsigned char* ws; int ph_lo, ph_hi, li, pad; };
__global__ void __launch_bounds__(NWAVES * 64, 2) fwd_kernel(Args args) {
    extern __shared__ __attribute__((aligned(16))) unsigned char lds[];
    Frame F;
    F.lds = (LAS unsigned char*)lds;
    F.tid = threadIdx.x; F.lane = F.tid & 63; F.wave = __builtin_amdgcn_readfirstlane(F.tid >> 6);
    F.G = gridDim.x; { const int bx = blockIdx.x; F.vcu = (F.G % 8 == 0) ? (bx % 8) * (F.G / 8) + bx / 8 : bx; }
    F.ws = args.ws; F.ctl = (gu32*)(args.ws + WS_CTL);
    for (int u = F.tid; u < (LDS_BYTES - LDSCTL_OFF) / 4; u += NWAVES * 64) ((LAS unsigned*)(F.lds + LDSCTL_OFF))[u] = 0u;
    __syncthreads();
    XcdBarrier bar = xcd_barrier_post((unsigned*)(F.ctl + CW_BAR) + args.li * XCD_BAR_WORDS, (volatile LAS unsigned*)(F.lds + MISC_OFF) + 8);
    const int lo = args.ph_lo, hi = args.ph_hi;
#define IN(k) (lo <= (k) && (k) < hi)
#define SEAM(k) do { if (IN(k) && IN((k) + 1)) xcd_barrier(bar); } while (0)
    unsigned char* ws = args.ws;
    if (IN(0) && !(SKIPMASK & (1 << 0))) { p0_prologue(F, args.in[0], args.in[1], args.in[2], args.in[3], args.in[6], args.in[8], args.in[9], args.in[10], args.in[17], args.in[18], args.in[19]); }
    SEAM(0);
    if (IN(1) && !(SKIPMASK & (1 << 1))) { pg8::Gemm g{(const bf16*)(ws + WS_HB), (const bf16*)(ws + WS_WIN), M, NP, D}; pg8::StaticOrder S; S.init(M, NP, F.G, (int)blockIdx.x);
        pg8::EpiBf16 E{(bf16*)(ws + WS_PROJ), NP};
        pg8::gemm_phase<pg8::EpiBf16, pg8::StaticOrder, true, true>(F.lds + RING_OFF, g, S, E); }
    SEAM(1);
    if (IN(2) && !(SKIPMASK & (1 << 2))) { conv_qk(F, args.in[4], args.in[5]); attn_naive(F); }
    SEAM(2);
    if (IN(3) && !(SKIPMASK & (1 << 3))) { if (F.vcu < 8) mlstm_naive(F, F.vcu); else attn_merge(F, 8); }
    SEAM(3);
    if (IN(4) && !(SKIPMASK & (1 << 4))) { mlstm_post(F, args.in[7]); }
    SEAM(4);
    if (IN(5) && !(SKIPMASK & (1 << 5))) {
        { pg8::Gemm g{(const bf16*)(ws + WS_ATT), (const bf16*)(ws + WS_WPA), M, D, 512}; pg8::StaticOrder S; S.init(M, D, F.G, (int)blockIdx.x);
          pg8::EpiGateA E{(float*)(ws + WS_TMP), D, (const bf16*)(ws + WS_PROJ) + C_GATE, NP};
          pg8::gemm_phase<pg8::EpiGateA, pg8::StaticOrder, true, true>(F.lds + RING_OFF, g, S, E); }
        { pg8::Gemm g{(const bf16*)(ws + WS_HM), (const bf16*)(ws + WS_WPM), M, D, 1024}; pg8::StaticOrder S; S.init(M, D, F.G, (int)blockIdx.x);
          pg8::EpiGateB E{(bf16*)(ws + WS_MERGED), (const float*)(ws + WS_TMP), D, (const bf16*)(ws + WS_PROJ) + C_GATE + D, NP};
          pg8::gemm_phase<pg8::EpiGateB, pg8::StaticOrder, true, true>(F.lds + RING_OFF, g, S, E); }
    }
    SEAM(5);
    if (IN(6) && !(SKIPMASK & (1 << 6))) { pg8::Gemm g{(const bf16*)(ws + WS_MERGED), (const bf16*)(ws + WS_WOUT), M, D, D}; pg8::StaticOrder S; S.init(M, D, F.G, (int)blockIdx.x);
        pg8::EpiResid E{(float*)(ws + WS_TMP), D, args.in[0], (const float*)(ws + WS_STATS), args.in[1], args.in[2], ALPHA};
        pg8::gemm_phase<pg8::EpiResid, pg8::StaticOrder, true, true>(F.lds + RING_OFF, g, S, E); }
    SEAM(6);
    if (IN(7) && !(SKIPMASK & (1 << 7))) { ln1_router(F, args.in[11], args.in[12], args.in[13], args.in[14], args.in[15], args.in[16]); }
    SEAM(7);
    if (IN(8) || IN(9) || IN(10)) moe_tables(F);
    if (IN(8) && !(SKIPMASK & (1 << 8))) { pg8::Gemm g{(const bf16*)(ws + WS_H1B), (const bf16*)(ws + WS_WGU), M, NE * 2 * DFF, D};
        MoeOrder S; S.init((const LAS int*)(F.lds + TS_OFF), (const LAS int*)(F.lds + CNT_OFF), (const int*)(ws + WS_TOKLIST), NT1, F.G, (int)blockIdx.x, true);
        pg8::EpiSwiGlu E{(bf16*)(ws + WS_ACT), DFF, NT1};
        pg8::gemm_phase<pg8::EpiSwiGlu, MoeOrder, true, true>(F.lds + RING_OFF, g, S, E); }
    SEAM(8);
    if (IN(9) && !(SKIPMASK & (1 << 9))) { pg8::Gemm g{(const bf16*)(ws + WS_ACT), (const bf16*)(ws + WS_WD), MAXT * 256, NE * D, DFF};
        MoeOrder S; S.init((const LAS int*)(F.lds + TS_OFF), (const LAS int*)(F.lds + CNT_OFF), (const int*)(ws + WS_TOKLIST), NT2, F.G, (int)blockIdx.x, false);
        pg8::EpiBf16Grp E{(bf16*)(ws + WS_YS), D, NT2};
        pg8::gemm_phase<pg8::EpiBf16Grp, MoeOrder, true, true>(F.lds + RING_OFF, g, S, E); }
    SEAM(9);
    if (IN(10) && !(SKIPMASK & (1 << 10))) { final_ln(F, args.in[20], args.in[21], args.out); }
#undef IN
#undef SEAM
}

#ifndef MK_PER_PHASE
#define MK_PER_PHASE 0
#endif
extern "C" void kernel_launch(void* const* d_in, const int* in_sizes, int n_in, void* d_out, int out_size, void* d_ws, size_t ws_size, hipStream_t stream) {
    static int grid = 0;
    if (grid == 0) {
        if (n_in != 22 || out_size != M * D || ws_size < WS_END) { fprintf(stderr, "kernel_launch: unexpected problem: n_in %d out %d ws %zu\n", n_in, out_size, ws_size); grid = -1; return; }
        int dev = 0, cus = 0, per_cu = 0;
        if (hipGetDevice(&dev) != hipSuccess || hipDeviceGetAttribute(&cus, hipDeviceAttributeMultiprocessorCount, dev) != hipSuccess) { grid = -1; return; }
        if (hipFuncSetAttribute((const void*)fwd_kernel, hipFuncAttributeMaxDynamicSharedMemorySize, LDS_BYTES) != hipSuccess) { fprintf(stderr, "kernel_launch: hipFuncSetAttribute failed\n"); grid = -1; return; }
        if (hipOccupancyMaxActiveBlocksPerMultiprocessor(&per_cu, (const void*)fwd_kernel, NWAVES * 64, LDS_BYTES) != hipSuccess || per_cu < 1)
            fprintf(stderr, "kernel_launch: note: occupancy query reports %d workgroups per CU\n", per_cu);
        (void)hipGetLastError();
        grid = cus - (cus % 8);
        if (grid < 16) grid = 16;
    }
    if (grid < 0) return;
    (void)hipMemsetAsync((char*)d_ws + WS_CTL, 0, CTL_ZERO_BYTES, stream);
    Args a{};
    for (int i = 0; i < 22; ++i) a.in[i] = (const float*)d_in[i];
    a.out = (float*)d_out; a.ws = (unsigned char*)d_ws; a.pad = 0;
#if MK_PER_PHASE
    for (int p = 0; p < N_PHASES; ++p) { a.ph_lo = p; a.ph_hi = p + 1; a.li = p; hipLaunchKernelGGL(fwd_kernel, dim3(grid), dim3(NWAVES * 64), LDS_BYTES, stream, a); }
#else
    a.ph_lo = 0; a.ph_hi = N_PHASES; a.li = 0;
    hipLaunchKernelGGL(fwd_kernel, dim3(grid), dim3(NWAVES * 64), LDS_BYTES, stream, a);
#endif
}
```

```cpp
#include <hip/hip_runtime.h>
#include <cstdio>
#include <cstdint>
namespace pg8 {
#define PG8_LAS __attribute__((address_space(3)))
typedef unsigned short bf16_t;
typedef short bf16x8 __attribute__((ext_vector_type(8)));
typedef float f32x4 __attribute__((ext_vector_type(4)));
typedef unsigned u32x4 __attribute__((ext_vector_type(4)));
constexpr int BM = 256, BK = 64, HALF = 128, HTB = HALF * BK * 2  , STAGE_BYTES = 8 * HTB, NXCD = 8, WGM = 8;

__host__ __device__ __forceinline__ int lds_byte(int r, int c) { const int st = (r >> 4) * 2 + (c >> 5), rr = r & 15, cc = c & 31, ob = rr * 64 + cc * 2; return st * 1024 + (ob ^ (((ob >> 9) & 1) << 5)); }
__host__ __device__ __forceinline__ void stage_rc(int b, int& R, int& C) { const int st = b / 1024, sb = b % 1024, swz = sb ^ (((sb >> 9) & 1) << 5); R = (st >> 1) * 16 + swz / 64; C = (st & 1) * 32 + (swz % 64) / 2; }
__host__ __device__ __forceinline__ int perm32(int rho) { const int n = rho >> 4, i = rho & 15; return 8 * (i >> 2) + 4 * n + (i & 3); }

struct Unit { int pm, pn, e, r0; };
struct Gemm { const bf16_t* A; const bf16_t* Bt; int M, N, K; };

struct StaticOrder {
    int nM, nN, nwg, G, c;
    __host__ __device__ void init(int M, int N, int G_, int c_) { nM = M / BM; nN = N / BM; nwg = nM * nN; G = G_; c = c_; }
    __host__ __device__ bool next(int i, Unit& u) const {
        const long L = (long)i * G + c; if (L >= nwg) return false;
        int wgid = (int)L; { const int q = nwg / NXCD, r = nwg % NXCD, xcd = wgid % NXCD, off = wgid / NXCD; wgid = (xcd < r ? xcd * (q + 1) : r * (q + 1) + (xcd - r) * q) + off; }
        const int nig = WGM * nN, gid = wgid / nig, fm = gid * WGM, gsz = (nM - fm) < WGM ? (nM - fm) : WGM;
        u.pm = fm + ((wgid % nig) % gsz); u.pn = (wgid % nig) / gsz; u.e = 0; u.r0 = 0; return true;
    }
    __device__ __forceinline__ int arow(const Unit& u, int r) const { return u.pm * BM + r; }
    __device__ __forceinline__ void a_ready(const Unit&) const {}
    __device__ __forceinline__ void done(const Unit&) const {}
};

__device__ __forceinline__ unsigned cvt_pk_bf16(float lo, float hi) { unsigned r; asm volatile("v_cvt_pk_bf16_f32 %0, %1, %2" : "=v"(r) : "v"(lo), "v"(hi)); return r; }
__device__ __forceinline__ float bf_lo(unsigned w) { return __uint_as_float(w << 16); }
__device__ __forceinline__ float bf_hi(unsigned w) { return __uint_as_float(w & 0xffff0000u); }
__device__ __forceinline__ float sigmoidf_(float x) { return 1.0f / (1.0f + __expf(-x)); }

struct EpiBf16 {
    static constexpr bool PERM = true, AFTER_DRAIN = false;
    bf16_t* O; int ldc;
    __device__ __forceinline__ void operator()(const f32x4 (&acc)[2][2][4][2], const Unit& u, int wr, int wc, int fr, int fq) const {
        const int row0 = u.pm * BM + wr * 64 + fr; const int col0 = u.pn * BM + wc * 32 + 8 * fq;
#pragma unroll
        for (int ai = 0; ai < 2; ++ai)
#pragma unroll
            for (int m = 0; m < 4; ++m) { bf16_t* rowp = O + (size_t)(row0 + ai * HALF + m * 16) * ldc + col0;
#pragma unroll
                for (int bj = 0; bj < 2; ++bj) { const f32x4 v0 = acc[ai][bj][m][0], v1 = acc[ai][bj][m][1];
                    u32x4 w; w.x = cvt_pk_bf16(v0[0], v0[1]); w.y = cvt_pk_bf16(v0[2], v0[3]); w.z = cvt_pk_bf16(v1[0], v1[1]); w.w = cvt_pk_bf16(v1[2], v1[3]);
                    *(u32x4*)(rowp + bj * HALF) = w; } }
    }
};
struct EpiBf16Grp {
    static constexpr bool PERM = true, AFTER_DRAIN = false;
    bf16_t* O; int ldc; int ntn;
    __device__ __forceinline__ void operator()(const f32x4 (&acc)[2][2][4][2], const Unit& u, int wr, int wc, int fr, int fq) const {
        const int row0 = u.pm * BM + wr * 64 + fr; const int col0 = (u.pn % ntn) * BM + wc * 32 + 8 * fq;
#pragma unroll
        for (int ai = 0; ai < 2; ++ai)
#pragma unroll
            for (int m = 0; m < 4; ++m) { bf16_t* rowp = O + (size_t)(row0 + ai * HALF + m * 16) * ldc + col0;
#pragma unroll
                for (int bj = 0; bj < 2; ++bj) { const f32x4 v0 = acc[ai][bj][m][0], v1 = acc[ai][bj][m][1];
                    u32x4 w; w.x = cvt_pk_bf16(v0[0], v0[1]); w.y = cvt_pk_bf16(v0[2], v0[3]); w.z = cvt_pk_bf16(v1[0], v1[1]); w.w = cvt_pk_bf16(v1[2], v1[3]);
                    *(u32x4*)(rowp + bj * HALF) = w; } }
    }
};
struct EpiGateA {
    static constexpr bool PERM = true, AFTER_DRAIN = false;
    float* T; int ldc; const bf16_t* G; int ldg;
    __device__ __forceinline__ void operator()(const f32x4 (&acc)[2][2][4][2], const Unit& u, int wr, int wc, int fr, int fq) const {
        const int row0 = u.pm * BM + wr * 64 + fr; const int col0 = u.pn * BM + wc * 32 + 8 * fq;
#pragma unroll
        for (int ai = 0; ai < 2; ++ai)
#pragma unroll
            for (int m = 0; m < 4; ++m) { const size_t r = (size_t)(row0 + ai * HALF + m * 16);
#pragma unroll
                for (int bj = 0; bj < 2; ++bj) { const u32x4 gw = *(const u32x4*)(G + r * ldg + col0 + bj * HALF);
                    const f32x4 v0 = acc[ai][bj][m][0], v1 = acc[ai][bj][m][1];
                    f32x4 o0, o1;
                    o0[0] = sigmoidf_(bf_lo(gw.x)) * v0[0]; o0[1] = sigmoidf_(bf_hi(gw.x)) * v0[1]; o0[2] = sigmoidf_(bf_lo(gw.y)) * v0[2]; o0[3] = sigmoidf_(bf_hi(gw.y)) * v0[3];
                    o1[0] = sigmoidf_(bf_lo(gw.z)) * v1[0]; o1[1] = sigmoidf_(bf_hi(gw.z)) * v1[1]; o1[2] = sigmoidf_(bf_lo(gw.w)) * v1[2]; o1[3] = sigmoidf_(bf_hi(gw.w)) * v1[3];
                    float* tp = T + r * ldc + col0 + bj * HALF; *(f32x4*)tp = o0; *(f32x4*)(tp + 4) = o1; } }
    }
};
struct EpiGateB {
    static constexpr bool PERM = true, AFTER_DRAIN = false;
    bf16_t* O; const float* T; int ldc; const bf16_t* G; int ldg;
    __device__ __forceinline__ void operator()(const f32x4 (&acc)[2][2][4][2], const Unit& u, int wr, int wc, int fr, int fq) const {
        const int row0 = u.pm * BM + wr * 64 + fr; const int col0 = u.pn * BM + wc * 32 + 8 * fq;
#pragma unroll
        for (int ai = 0; ai < 2; ++ai)
#pragma unroll
            for (int m = 0; m < 4; ++m) { const size_t r = (size_t)(row0 + ai * HALF + m * 16);
#pragma unroll
                for (int bj = 0; bj < 2; ++bj) { const u32x4 gw = *(const u32x4*)(G + r * ldg + col0 + bj * HALF);
                    const float* tp = T + r * ldc + col0 + bj * HALF; const f32x4 t0 = *(const f32x4*)tp, t1 = *(const f32x4*)(tp + 4);
                    const f32x4 v0 = acc[ai][bj][m][0], v1 = acc[ai][bj][m][1];
                    f32x4 o0, o1;
                    o0[0] = t0[0] + sigmoidf_(bf_lo(gw.x)) * v0[0]; o0[1] = t0[1] + sigmoidf_(bf_hi(gw.x)) * v0[1]; o0[2] = t0[2] + sigmoidf_(bf_lo(gw.y)) * v0[2]; o0[3] = t0[3] + sigmoidf_(bf_hi(gw.y)) * v0[3];
                    o1[0] = t1[0] + sigmoidf_(bf_lo(gw.z)) * v1[0]; o1[1] = t1[1] + sigmoidf_(bf_hi(gw.z)) * v1[1]; o1[2] = t1[2] + sigmoidf_(bf_lo(gw.w)) * v1[2]; o1[3] = t1[3] + sigmoidf_(bf_hi(gw.w)) * v1[3];
                    u32x4 w; w.x = cvt_pk_bf16(o0[0], o0[1]); w.y = cvt_pk_bf16(o0[2], o0[3]); w.z = cvt_pk_bf16(o1[0], o1[1]); w.w = cvt_pk_bf16(o1[2], o1[3]);
                    *(u32x4*)(O + r * ldc + col0 + bj * HALF) = w; } }
    }
};
struct EpiResid {
    static constexpr bool PERM = false, AFTER_DRAIN = false;
    float* P; int ldc; const float* X; const float* stats; const float* g; const float* b; float alpha;
    __device__ __forceinline__ void operator()(const f32x4 (&acc)[2][2][4][2], const Unit& u, int wr, int wc, int fr, int fq) const {
        const int row0 = u.pm * BM + wr * 64 + fr, col0 = u.pn * BM + wc * 32 + 4 * fq;
        f32x4 gv[2][2], bv[2][2];
#pragma unroll
        for (int bj = 0; bj < 2; ++bj)
#pragma unroll
            for (int n = 0; n < 2; ++n) { gv[bj][n] = *(const f32x4*)(g + col0 + bj * HALF + n * 16); bv[bj][n] = *(const f32x4*)(b + col0 + bj * HALF + n * 16); }
#pragma unroll
        for (int ai = 0; ai < 2; ++ai)
#pragma unroll
            for (int m = 0; m < 4; ++m) { const size_t r = (size_t)(row0 + ai * HALF + m * 16); const float mu = stats[2 * r], rs = stats[2 * r + 1];
#pragma unroll
                for (int bj = 0; bj < 2; ++bj)
#pragma unroll
                    for (int n = 0; n < 2; ++n) { const size_t off = r * ldc + col0 + bj * HALF + n * 16; const f32x4 xv = *(const f32x4*)(X + off);
                        *(f32x4*)(P + off) = ((xv - mu) * rs * gv[bj][n] + bv[bj][n]) * alpha + acc[ai][bj][m][n]; } }
    }
};
struct EpiSwiGlu {
    static constexpr bool PERM = true, AFTER_DRAIN = false;
    bf16_t* O; int ldc; int ntn;
    __device__ __forceinline__ void operator()(const f32x4 (&acc)[2][2][4][2], const Unit& u, int wr, int wc, int fr, int fq) const {
        const int row0 = u.pm * BM + wr * 64 + fr; const int col0 = (u.pn % ntn) * HALF + wc * 32 + 8 * fq;
#pragma unroll
        for (int ai = 0; ai < 2; ++ai)
#pragma unroll
            for (int m = 0; m < 4; ++m) { bf16_t* rowp = O + (size_t)(row0 + ai * HALF + m * 16) * ldc + col0;
                float o[8];
#pragma unroll
                for (int n = 0; n < 2; ++n)
#pragma unroll
                    for (int j = 0; j < 4; ++j) { const float gt = acc[ai][0][m][n][j], up = acc[ai][1][m][n][j]; o[4 * n + j] = gt * sigmoidf_(gt) * up; }
                u32x4 w; w.x = cvt_pk_bf16(o[0], o[1]); w.y = cvt_pk_bf16(o[2], o[3]); w.z = cvt_pk_bf16(o[4], o[5]); w.w = cvt_pk_bf16(o[6], o[7]);
                *(u32x4*)rowp = w; }
    }
};

template <class Epi, class Sched, bool ALIGN_EPI = false, bool SP2 = false>
__device__ __forceinline__ void gemm_phase(PG8_LAS unsigned char* lds, const Gemm g, const Sched& S, const Epi& E) {
    const int tid = threadIdx.x, wid = __builtin_amdgcn_readfirstlane(tid >> 6), lane = tid & 63, wr = wid >> 2, wc = wid & 3, fr = lane & 15, fq = lane >> 4;
    const int K = g.K, nt = K / BK;
    int Rs[2], Cs[2]; unsigned voffB[2];
#pragma unroll
    for (int i = 0; i < 2; ++i) { int R, C; stage_rc(tid * 16 + i * 8192, R, C); const int Rb = Epi::PERM ? ((R & ~31) + perm32(R & 31)) : R;
        Rs[i] = R; Cs[i] = C; voffB[i] = (unsigned)(Rb * K + C) * 2u; }
    const size_t kstep = (size_t)(BK * 2);
    const size_t hstep = (size_t)HALF * K * 2;
    const size_t tstep = 2 * hstep;
    const unsigned ldsw = (unsigned)wid * 1024u;
    const int aoff = lds_byte(wr * 64 + fr, fq * 8), boff = lds_byte(wc * 32 + fr, fq * 8);
#define PG8_SA(b, h) (((b) * 2 + (h)) * HTB)
#define PG8_SB(b, h) ((4 + (b) * 2 + (h)) * HTB)
#define PG8_STAGE(bufoff, gbase, voff) do { _Pragma("unroll") for (int _i = 0; _i < 2; ++_i) \
        __builtin_amdgcn_global_load_lds((const unsigned*)((const char*)(gbase) + (voff)[_i]), (PG8_LAS unsigned*)(lds + (bufoff) + ldsw + _i * 8192), 16, 0, 0); } while (0)
#define PG8_LDA(dst, b, h) do { _Pragma("unroll") for (int m = 0; m < 4; ++m) _Pragma("unroll") for (int k = 0; k < 2; ++k) dst[m][k] = *(const PG8_LAS bf16x8*)(lds + PG8_SA(b, h) + aoff + m * 2048 + k * 1024); } while (0)
#define PG8_LDB(dst, b, h) do { _Pragma("unroll") for (int n = 0; n < 2; ++n) _Pragma("unroll") for (int k = 0; k < 2; ++k) dst[n][k] = *(const PG8_LAS bf16x8*)(lds + PG8_SB(b, h) + boff + n * 2048 + k * 1024); } while (0)
#define PG8_MMA(ai, bj, At, Bt) do { __builtin_amdgcn_s_setprio(1); _Pragma("unroll") for (int m = 0; m < 4; ++m) _Pragma("unroll") for (int n = 0; n < 2; ++n) _Pragma("unroll") for (int k = 0; k < 2; ++k) \
        acc[ai][bj][m][n] = __builtin_amdgcn_mfma_f32_16x16x32_bf16(Bt[n][k], At[m][k], acc[ai][bj][m][n], 0, 0, 0); __builtin_amdgcn_s_setprio(0); } while (0)
#define PG8_WAIT_V(n) asm volatile("s_waitcnt vmcnt(" #n ")" ::: "memory")
#define PG8_WAIT_L(n) asm volatile("s_waitcnt lgkmcnt(" #n ")" ::: "memory")
#define PG8_BAR __builtin_amdgcn_s_barrier()
#define PG8_SCHED __builtin_amdgcn_sched_barrier(0)
#define PG8_AOFF(dst, u) do { _Pragma("unroll") for (int _h = 0; _h < 2; ++_h) _Pragma("unroll") for (int _i = 0; _i < 2; ++_i) \
        dst[_h][_i] = ((unsigned)S.arow(u, _h * HALF + Rs[_i]) * (unsigned)K + (unsigned)Cs[_i]) * 2u; } while (0)
    Unit cur, nxt; int ui = 0;
    if (!S.next(0, cur)) return;
    f32x4 acc[2][2][4][2];
#pragma unroll
    for (int a = 0; a < 2; ++a)
#pragma unroll
        for (int b = 0; b < 2; ++b)
#pragma unroll
            for (int m = 0; m < 4; ++m)
#pragma unroll
                for (int n = 0; n < 2; ++n) acc[a][b][m][n] = (f32x4){0.f, 0.f, 0.f, 0.f};
    bf16x8 At[4][2], B0[2][2], B1[2][2];
    unsigned vA[2][2], nvA[2][2];
    PG8_AOFF(vA, cur);
    const char* const cA = (const char*)g.A; const char* cB = (const char*)g.Bt + (size_t)cur.pn * tstep;
    S.a_ready(cur);
    if constexpr (SP2) {
        PG8_STAGE(PG8_SB(0, 0), cB, voffB); PG8_STAGE(PG8_SB(0, 1), cB + hstep, voffB); PG8_STAGE(PG8_SA(0, 0), cA, vA[0]); PG8_STAGE(PG8_SA(0, 1), cA, vA[1]);
        if (wr == 1) PG8_BAR;
        PG8_WAIT_V(2); PG8_BAR;
        PG8_STAGE(PG8_SB(1, 0), cB + kstep, voffB); PG8_STAGE(PG8_SA(1, 0), cA + kstep, vA[0]); PG8_STAGE(PG8_SB(1, 1), cB + hstep + kstep, voffB);
        PG8_WAIT_V(6); PG8_BAR;
    } else {
        PG8_STAGE(PG8_SB(0, 0), cB, voffB); PG8_STAGE(PG8_SA(0, 0), cA, vA[0]); PG8_STAGE(PG8_SB(0, 1), cB + hstep, voffB); PG8_STAGE(PG8_SA(0, 1), cA, vA[1]);
        if (wr == 1) PG8_BAR;
        PG8_WAIT_V(4); PG8_BAR;
        PG8_STAGE(PG8_SB(1, 0), cB + kstep, voffB); PG8_STAGE(PG8_SA(1, 0), cA + kstep, vA[0]); PG8_STAGE(PG8_SB(1, 1), cB + hstep + kstep, voffB);
        PG8_WAIT_V(6); PG8_BAR;
    }
    for (;;) {
        const bool has_next = S.next(ui + 1, nxt);
        const char* nB = has_next ? (const char*)g.Bt + (size_t)nxt.pn * tstep : cB;
        if (has_next) { PG8_AOFF(nvA, nxt); } else {
#pragma unroll
            for (int h = 0; h < 2; ++h)
#pragma unroll
                for (int i = 0; i < 2; ++i) nvA[h][i] = vA[h][i]; }
        for (int t = 0; t < nt; t += 2) {
            const bool last = (t == nt - 2);
            const char* a1 = cA + (size_t)(t + 1) * kstep;
            const char* a2 = last ? cA : cA + (size_t)(t + 2) * kstep; const char* b2 = last ? nB : cB + (size_t)(t + 2) * kstep;
            const char* a3 = a2 + kstep; const char* b3 = b2 + kstep;
            unsigned w0[2], w1[2];
            w0[0] = last ? nvA[0][0] : vA[0][0]; w0[1] = last ? nvA[0][1] : vA[0][1]; w1[0] = last ? nvA[1][0] : vA[1][0]; w1[1] = last ? nvA[1][1] : vA[1][1];
            if (last && has_next) S.a_ready(nxt);
            if constexpr (SP2) {
            PG8_LDB(B0, 0, 0); PG8_LDB(B1, 0, 1); PG8_SCHED; PG8_LDA(At, 0, 0); PG8_STAGE(PG8_SA(1, 1), a1, vA[1]);
            PG8_WAIT_V(8); PG8_WAIT_L(0); PG8_BAR; PG8_MMA(0, 0, At, B0); PG8_MMA(0, 1, At, B1); PG8_BAR; PG8_SCHED;
            PG8_LDA(At, 0, 1); PG8_STAGE(PG8_SB(0, 0), b2, voffB); PG8_STAGE(PG8_SB(0, 1), b2 + hstep, voffB); PG8_STAGE(PG8_SA(0, 0), a2, w0);
            PG8_WAIT_V(8); PG8_WAIT_L(0); PG8_BAR; PG8_MMA(1, 0, At, B0); PG8_MMA(1, 1, At, B1); PG8_BAR; PG8_SCHED;
            PG8_LDB(B0, 1, 0); PG8_LDB(B1, 1, 1); PG8_SCHED; PG8_LDA(At, 1, 0); PG8_STAGE(PG8_SA(0, 1), a2, w1);
            PG8_WAIT_V(8); PG8_WAIT_L(0); PG8_BAR; PG8_MMA(0, 0, At, B0); PG8_MMA(0, 1, At, B1); PG8_BAR; PG8_SCHED;
            PG8_LDA(At, 1, 1); PG8_STAGE(PG8_SB(1, 0), b3, voffB); PG8_STAGE(PG8_SB(1, 1), b3 + hstep, voffB); PG8_STAGE(PG8_SA(1, 0), a3, w0);
            PG8_WAIT_V(8); PG8_WAIT_L(0); PG8_BAR; PG8_MMA(1, 0, At, B0); PG8_MMA(1, 1, At, B1); PG8_BAR; PG8_SCHED;
            } else {
            PG8_LDB(B0, 0, 0); PG8_SCHED; PG8_LDA(At, 0, 0); PG8_STAGE(PG8_SA(1, 1), a1, vA[1]);
            PG8_WAIT_L(8); PG8_BAR; PG8_WAIT_L(0); PG8_MMA(0, 0, At, B0); PG8_BAR; PG8_SCHED;
            PG8_LDB(B1, 0, 1); PG8_STAGE(PG8_SB(0, 0), b2, voffB);
            PG8_BAR; PG8_WAIT_L(0); PG8_MMA(0, 1, At, B1); PG8_BAR;
            PG8_LDA(At, 0, 1); PG8_STAGE(PG8_SA(0, 0), a2, w0);
            PG8_BAR; PG8_WAIT_L(0); PG8_MMA(1, 0, At, B0); PG8_BAR; PG8_SCHED;
            PG8_STAGE(PG8_SB(0, 1), b2 + hstep, voffB);
            PG8_WAIT_V(6); PG8_BAR; PG8_MMA(1, 1, At, B1); PG8_BAR;
            PG8_LDB(B0, 1, 0); PG8_SCHED; PG8_LDA(At, 1, 0); PG8_STAGE(PG8_SA(0, 1), a2, w1);
            PG8_WAIT_L(8); PG8_BAR; PG8_WAIT_L(0); PG8_MMA(0, 0, At, B0); PG8_BAR; PG8_SCHED;
            PG8_LDB(B1, 1, 1); PG8_STAGE(PG8_SB(1, 0), b3, voffB);
            PG8_BAR; PG8_WAIT_L(0); PG8_MMA(0, 1, At, B1); PG8_BAR;
            PG8_LDA(At, 1, 1); PG8_STAGE(PG8_SA(1, 0), a3, w0);
            PG8_BAR; PG8_WAIT_L(0); PG8_MMA(1, 0, At, B0); PG8_BAR; PG8_SCHED;
            PG8_STAGE(PG8_SB(1, 1), b3 + hstep, voffB);
            PG8_WAIT_V(6); PG8_BAR; PG8_MMA(1, 1, At, B1); PG8_BAR;
            }
        }
        if constexpr (ALIGN_EPI) { if (wr == 0) PG8_BAR; }
        E(acc, cur, wr, wc, fr, fq); S.done(cur);
        if (!has_next) break;
#pragma unroll
        for (int a = 0; a < 2; ++a)
#pragma unroll
            for (int b = 0; b < 2; ++b)
#pragma unroll
                for (int m = 0; m < 4; ++m)
#pragma unroll
                    for (int n = 0; n < 2; ++n) acc[a][b][m][n] = (f32x4){0.f, 0.f, 0.f, 0.f};
        cur = nxt; cB = nB; ++ui;
#pragma unroll
        for (int h = 0; h < 2; ++h)
#pragma unroll
            for (int i = 0; i < 2; ++i) vA[h][i] = nvA[h][i];
        if constexpr (ALIGN_EPI) { if (wr == 1) PG8_BAR; }
    }
    PG8_WAIT_V(0);
    if constexpr (!ALIGN_EPI) { if (wr == 0) PG8_BAR; }
    PG8_BAR;
#undef PG8_SA
#undef PG8_SB
#undef PG8_STAGE
#undef PG8_LDA
#undef PG8_LDB
#undef PG8_MMA
#undef PG8_WAIT_V
#undef PG8_WAIT_L
#undef PG8_BAR
#undef PG8_SCHED
#undef PG8_AOFF
}
}
#define GAS __attribute__((address_space(1)))
#define LAS __attribute__((address_space(3)))
typedef unsigned short bf16;
typedef unsigned v4u __attribute__((ext_vector_type(4)));
typedef float f32x4 __attribute__((ext_vector_type(4)));
typedef short bf16x8 __attribute__((ext_vector_type(8)));
typedef GAS unsigned gu32;
typedef GAS unsigned long long gu64;
#define RLX_AGENT __ATOMIC_RELAXED, __HIP_MEMORY_SCOPE_AGENT
#define LDS_WAIT() asm volatile("s_waitcnt lgkmcnt(0)" ::: "memory")
#define VM_WAIT() asm volatile("s_waitcnt vmcnt(0)" ::: "memory")
__device__ __forceinline__ unsigned long long rt() { return __builtin_amdgcn_s_memrealtime(); }
__device__ __forceinline__ unsigned f2bf(float f) { unsigned u = __builtin_bit_cast(unsigned, f); return (u + 0x7fffu + ((u >> 16) & 1u)) >> 16; }
__device__ __forceinline__ unsigned pk2(float lo, float hi) { return f2bf(lo) | (f2bf(hi) << 16); }

#define XB_TMO      128
#define XB_XCNT(j)  (256  + 64 * (j))
#define XB_XSUB(j)  (1280 + 64 * (j))
#define XB_XGEN(j)  (2304 + 64 * (j))
#define XB_TOP      3328
#define XB_TOPGEN   3392
#define XCD_BAR_WORDS 3456
#define XB_SPIN_CAP (1u << 22)

__device__ __forceinline__ unsigned xb_ld(unsigned* p)              { return __hip_atomic_load(p, __ATOMIC_RELAXED, __HIP_MEMORY_SCOPE_AGENT); }
__device__ __forceinline__ unsigned xb_add(unsigned* p, unsigned v) { return __hip_atomic_fetch_add(p, v, __ATOMIC_RELAXED, __HIP_MEMORY_SCOPE_AGENT); }
__device__ __forceinline__ unsigned xb_xcc_id() { return (unsigned)__builtin_amdgcn_s_getreg((3 << 11) | 20) & 0xFu; }
#define XB_SPIN(cond, bar) do { unsigned _sp = 0; while (cond) { __builtin_amdgcn_s_sleep(1); \
    if ((++_sp & 255u) == 0u) { if (xb_ld(&(bar)[XB_TMO])) break; if (_sp > XB_SPIN_CAP) { atomicAdd(&(bar)[XB_TMO], 1u); break; } } } } while (0)

struct XcdBarrier {
    unsigned* bar; unsigned x;
    volatile LAS unsigned* st;
};

__device__ __forceinline__ XcdBarrier xcd_barrier_post(unsigned* bar, volatile LAS unsigned* st) {
    XcdBarrier b; b.bar = bar; b.x = xb_xcc_id(); b.st = st;
    if (threadIdx.x == 0) (void)xb_add(&bar[XB_XCNT(b.x)], 1u);
    return b;
}
__device__ __forceinline__ void xcd_barrier_complete(unsigned* bar, unsigned x, unsigned& nloc, unsigned& nx) {
    const unsigned G = gridDim.x * gridDim.y * gridDim.z;
    unsigned sum, cnt, mine, sp = 0u;
    for (;;) {
        sum = 0u; cnt = 0u; mine = 0u;
#pragma unroll
        for (unsigned j = 0; j < 16; ++j) { const unsigned c = xb_ld(&bar[XB_XCNT(j)]); sum += c; cnt += (c > 0u) ? 1u : 0u; mine = (j == x) ? c : mine; }
        if (sum == G) break;
        __builtin_amdgcn_s_sleep(1);
        if ((++sp & 255u) == 0u) { if (xb_ld(&bar[XB_TMO])) break; if (sp > XB_SPIN_CAP) { atomicAdd(&bar[XB_TMO], 1u); break; } }
    }
    nloc = mine > 0u ? mine : 1u; nx = cnt > 0u ? cnt : 1u;
}

__device__ __forceinline__ void xcd_barrier(const XcdBarrier& b) {
    asm volatile("s_waitcnt vmcnt(0)" ::: "memory");
    __syncthreads();
    if (threadIdx.x == 0) {
        unsigned* bar = b.bar;
        __builtin_amdgcn_s_waitcnt(0);
        unsigned nloc = b.st[0], nx = b.st[1];
        if (nloc == 0u) { xcd_barrier_complete(bar, b.x, nloc, nx); b.st[0] = nloc; b.st[1] = nx; }
        const unsigned old = xb_add(&bar[XB_XSUB(b.x)], 1u);
        const unsigned gen = old / nloc;
        if (old + 1u == (gen + 1u) * nloc) {
            __builtin_amdgcn_fence(__ATOMIC_RELEASE, "agent");
            asm volatile("s_waitcnt vmcnt(0)" ::: "memory");
            const unsigned og = xb_add(&bar[XB_TOP], 1u);
            const unsigned tg = og / nx;
            if (og + 1u == (tg + 1u) * nx) xb_add(&bar[XB_TOPGEN], 1u);
            else XB_SPIN(xb_ld(&bar[XB_TOPGEN]) == tg, bar);
            __builtin_amdgcn_fence(__ATOMIC_ACQUIRE, "agent");
            xb_add(&bar[XB_XGEN(b.x)], 1u);
            asm volatile("s_waitcnt vmcnt(0)" ::: "memory");
        } else {
            XB_SPIN(xb_ld(&bar[XB_XGEN(b.x)]) == gen, bar);
            __builtin_amdgcn_fence(__ATOMIC_ACQUIRE, "agent");
            asm volatile("s_waitcnt vmcnt(0)" ::: "memory");
        }
    }
    __syncthreads();
}

constexpr int NWAVES = 8;
constexpr int BATCH = 2, SEQ = 4096, M = BATCH * SEQ, D = 2048;
constexpr int NPW = 11784;
constexpr int NP = 11776;
constexpr int C_AQ = 0, C_AK = 1536, C_AV = 3072, C_MQK = 4608, C_MV = 5632, C_MO = 6656, C_GATE = 7680;
constexpr int NE = 32, DFF = 1408, ECAP = 8192, MAXT = 96, NT1 = DFF / 128  , NT2 = D / 256  ;
constexpr float LN_EPS = 1e-5f, ALPHA = 1.189207115002721f, QSCALE = 0.08838834764831845f;
constexpr size_t MiB = 1u << 20;
constexpr size_t WS_CTL = 0, CTL_ZERO_BYTES = 1 * MiB;
constexpr size_t WS_WIN = 2 * MiB, WS_WPA = 48 * MiB, WS_WPM = 50 * MiB, WS_WOUT = 54 * MiB, WS_WGU = 62 * MiB, WS_WD = 414 * MiB;
constexpr size_t WS_HB = 590 * MiB, WS_STATS = 622 * MiB, WS_MIF = 622 * MiB + 512 * 1024, WS_PROJ = 623 * MiB;
constexpr size_t WS_ATTO = 807 * MiB, WS_LSE = 831 * MiB, WS_ATT = 832 * MiB, WS_QKC = 840 * MiB, WS_NUM = 856 * MiB, WS_DEN = 888 * MiB, WS_MT = 888 * MiB + 512 * 1024;
constexpr size_t WS_HM = 889 * MiB, WS_TMP = 905 * MiB, WS_MERGED = 969 * MiB, WS_H1 = 1001 * MiB, WS_H1B = 1065 * MiB, WS_TOKLIST = 1097 * MiB, WS_TOKINFO = 1098 * MiB;
constexpr size_t WS_ACT = WS_PROJ, WS_YS = 689 * MiB;
constexpr size_t WS_KVT = 1099 * MiB, WS_CPREV = 1163 * MiB, WS_MSC = 1195 * MiB;
constexpr size_t WS_END = 1200 * MiB;
static_assert(WS_WIN + (size_t)NP * D * 2 <= WS_WPA && WS_WGU + (size_t)NE * 2 * DFF * D * 2 <= WS_WD && WS_WD + (size_t)NE * D * DFF * 2 <= WS_HB, "weights map");
static_assert(WS_PROJ + (size_t)M * NP * 2 <= WS_ATTO && WS_ACT + (size_t)MAXT * 256 * DFF * 2 <= WS_YS && WS_YS + (size_t)MAXT * 256 * D * 2 <= WS_ATTO, "activation map");
constexpr int CW_TMO = 0, CW_CODE = 1, CW_BAR = 4096, CW_CNT = 65536;
constexpr int RING_OFF = 0, RING_BYTES = 131072, LDSCTL_OFF = RING_BYTES, MISC_OFF = LDSCTL_OFF + 320, TS_OFF = LDSCTL_OFF + 512, CNT_OFF = LDSCTL_OFF + 768, GATE_OFF = LDSCTL_OFF + 1024;
constexpr int LDS_BYTES = 147456;

struct Frame { LAS unsigned char* lds; gu32* ctl; int tid, lane, wave, vcu, G; unsigned char* ws; };

__device__ __forceinline__ float wave_sum(float v) {
#pragma unroll
    for (int o = 1; o < 64; o <<= 1) v += __shfl_xor(v, o);
    return v;
}
__device__ __forceinline__ float wave_max(float v) {
#pragma unroll
    for (int o = 1; o < 64; o <<= 1) v = fmaxf(v, __shfl_xor(v, o));
    return v;
}
__device__ __forceinline__ float bflo(unsigned w) { return __uint_as_float(w << 16); }
__device__ __forceinline__ float bfhi(unsigned w) { return __uint_as_float(w & 0xffff0000u); }
__device__ __forceinline__ float sigm(float x) { return 1.0f / (1.0f + __expf(-x)); }

__device__ __forceinline__ void tr_item(const float* W, int ldw, int k0, int c0, bf16* WT, size_t drow0, int Kd, LAS float* scr, int lane) {
#pragma unroll 8
    for (int i = 0; i < 32; ++i) { const int kk = 2 * i + (lane >> 5); scr[kk * 33 + (lane & 31)] = W[(size_t)(k0 + kk) * ldw + c0 + (lane & 31)]; }
    LDS_WAIT(); asm volatile("" ::: "memory");
    const int c = lane & 7;
#pragma unroll
    for (int j = 0; j < 4; ++j) { const int n = (lane >> 3) + 8 * j; const LAS float* s = scr + (8 * c) * 33 + n;
        v4u o; o.x = pk2(s[0 * 33], s[1 * 33]); o.y = pk2(s[2 * 33], s[3 * 33]); o.z = pk2(s[4 * 33], s[5 * 33]); o.w = pk2(s[6 * 33], s[7 * 33]);
        *(GAS v4u*)(WT + (drow0 + n) * Kd + k0 + 8 * c) = o; }
    LDS_WAIT(); asm volatile("" ::: "memory");
}
constexpr int I_WINA = 32 * 240, I_WINB = 32 * 128, I_WPA = 8 * 64, I_WPM = 16 * 64, I_WOUT = 32 * 64, I_EXP = NE * 32 * 44, I_DN = NE * 22 * 64;
constexpr int I_TOTAL = I_WINA + I_WINB + I_WPA + I_WPM + I_WOUT + 2 * I_EXP + I_DN;

__device__ __forceinline__ void p0_prologue(Frame& F, const float* x, const float* lng, const float* lnb, const float* w_in, const float* if_bias, const float* wpa, const float* wpm, const float* wout,
                                            const float* wgate, const float* wup, const float* wdown) {
    unsigned char* ws = F.ws;
    LAS float* scr = (LAS float*)(F.lds + RING_OFF + F.wave * 16384);
    const int gw = F.vcu * NWAVES + F.wave, NGW = F.G * NWAVES;
    for (int it0 = gw; it0 < I_TOTAL; it0 += NGW) {
        int it = it0;
        if (it < I_WINA) { const int kb = it / 240, nb = it % 240; tr_item(w_in, NPW, 64 * kb, 32 * nb, (bf16*)(ws + WS_WIN), (size_t)32 * nb, D, scr, F.lane); continue; } it -= I_WINA;
        if (it < I_WINB) { const int kb = it / 128, nb = it % 128; tr_item(w_in, NPW, 64 * kb, 7688 + 32 * nb, (bf16*)(ws + WS_WIN), (size_t)7680 + 32 * nb, D, scr, F.lane); continue; } it -= I_WINB;
        if (it < I_WPA) { const int kb = it / 64, nb = it % 64; tr_item(wpa, D, 64 * kb, 32 * nb, (bf16*)(ws + WS_WPA), (size_t)32 * nb, 512, scr, F.lane); continue; } it -= I_WPA;
        if (it < I_WPM) { const int kb = it / 64, nb = it % 64; tr_item(wpm, D, 64 * kb, 32 * nb, (bf16*)(ws + WS_WPM), (size_t)32 * nb, 1024, scr, F.lane); continue; } it -= I_WPM;
        if (it < I_WOUT) { const int kb = it / 64, nb = it % 64; tr_item(wout, D, 64 * kb, 32 * nb, (bf16*)(ws + WS_WOUT), (size_t)32 * nb, D, scr, F.lane); continue; } it -= I_WOUT;
        if (it < 2 * I_EXP) { const int up = it >= I_EXP ? 1 : 0; if (up) it -= I_EXP; const int e = it / 1408, r = it % 1408, kb = r / 44, nb = r % 44, j0 = 32 * nb;
            const float* src = (up ? wup : wgate) + (size_t)e * D * DFF;
            tr_item(src, DFF, 64 * kb, j0, (bf16*)(ws + WS_WGU), (size_t)e * 2816 + (size_t)(j0 / 128) * 256 + (j0 % 128) + 128 * up, D, scr, F.lane); continue; } it -= 2 * I_EXP;
        { const int e = it / 1408, r = it % 1408, kb = r / 64, nb = r % 64;
            tr_item(wdown + (size_t)e * DFF * D, D, 64 * kb, 32 * nb, (bf16*)(ws + WS_WD), (size_t)e * D + 32 * nb, DFF, scr, F.lane); }
    }
    __syncthreads();
    LAS float* wif = (LAS float*)(F.lds + RING_OFF);
    for (int k = F.tid; k < D; k += NWAVES * 64) { const f32x4 a = *(const f32x4*)(w_in + (size_t)k * NPW + 7680), b = *(const f32x4*)(w_in + (size_t)k * NPW + 7684);
        *(LAS f32x4*)(wif + k * 8) = a; *(LAS f32x4*)(wif + k * 8 + 4) = b; }
    __syncthreads();
    bf16* HB = (bf16*)(ws + WS_HB); float* STATS = (float*)(ws + WS_STATS); float* MIF = (float*)(ws + WS_MIF);
    for (int m = gw; m < M; m += NGW) {
        const f32x4* xr = (const f32x4*)(x + (size_t)m * D) + F.lane;
        f32x4 v[8]; float s = 0.f;
#pragma unroll
        for (int j = 0; j < 8; ++j) { v[j] = xr[64 * j]; s += (v[j][0] + v[j][1]) + (v[j][2] + v[j][3]); }
        const float mean = wave_sum(s) * (1.f / D); float s2 = 0.f;
#pragma unroll
        for (int j = 0; j < 8; ++j) { const f32x4 d = v[j] - mean; s2 += (d[0] * d[0] + d[1] * d[1]) + (d[2] * d[2] + d[3] * d[3]); }
        const float rstd = rsqrtf(wave_sum(s2) * (1.f / D) + LN_EPS);
        float a[8];
#pragma unroll
        for (int i = 0; i < 8; ++i) a[i] = 0.f;
        unsigned long long* o8 = (unsigned long long*)(HB + (size_t)m * D) + F.lane;
#pragma unroll
        for (int j = 0; j < 8; ++j) { const int k0 = 4 * F.lane + 256 * j; const f32x4 g4 = *(const f32x4*)(lng + k0), b4 = *(const f32x4*)(lnb + k0);
            const f32x4 hv = (v[j] - mean) * rstd * g4 + b4;
            o8[64 * j] = (unsigned long long)pk2(hv[0], hv[1]) | ((unsigned long long)pk2(hv[2], hv[3]) << 32);
#pragma unroll
            for (int c = 0; c < 4; ++c) { const f32x4 w0 = *(const LAS f32x4*)(wif + (k0 + c) * 8), w1 = *(const LAS f32x4*)(wif + (k0 + c) * 8 + 4);
                a[0] += hv[c] * w0[0]; a[1] += hv[c] * w0[1]; a[2] += hv[c] * w0[2]; a[3] += hv[c] * w0[3]; a[4] += hv[c] * w1[0]; a[5] += hv[c] * w1[1]; a[6] += hv[c] * w1[2]; a[7] += hv[c] * w1[3]; }
            asm volatile("" ::: "memory"); }
#pragma unroll
        for (int i = 0; i < 8; ++i) a[i] = wave_sum(a[i]);
        if (F.lane == 0) { STATS[2 * m] = mean; STATS[2 * m + 1] = rstd;
#pragma unroll
            for (int i = 0; i < 8; ++i) MIF[(size_t)m * 8 + i] = a[i] + if_bias[i]; }
    }
}

__device__ __forceinline__ float alibi_slope(int h) {
    switch (h) { case 0: return 0.70710678118654752f; case 1: return 0.5f; case 2: return 0.35355339059327379f; case 3: return 0.25f; case 4: return 0.17677669529663689f; case 5: return 0.125f;
        case 6: return 0.088388347648318447f; case 7: return 0.0625f; case 8: return 0.03125f; case 9: return 0.015625f; case 10: return 0.0078125f; default: return 0.00390625f; }
}
__device__ __forceinline__ void attn_naive(Frame& F) {
    const bf16* PROJ = (const bf16*)(F.ws + WS_PROJ); bf16* ATTO = (bf16*)(F.ws + WS_ATTO); float* LSE = (float*)(F.ws + WS_LSE);
    LAS float* pbuf = (LAS float*)(F.lds + RING_OFF) + F.wave * 256;
    const int gw = F.vcu * NWAVES + F.wave, NGW = F.G * NWAVES;
    for (int it = gw; it < M * 12; it += NGW) {
        const int h = it / M, m = it % M, t = m % SEQ, g = h >> 2, r = (g == 0) ? 1 : (g == 1 ? 4 : 16);
        const float slope = alibi_slope(h);
        const bf16* qp = PROJ + (size_t)m * NP + C_AQ + h * 128;
        float sc[3];
#pragma unroll
        for (int jj = 0; jj < 3; ++jj) {
            const int j = F.lane + 64 * jj; const bool valid = (j <= 128) && (t - j * r >= 0);
            float dot = 0.f;
            if (valid) { const bf16* kp = PROJ + (size_t)(m - j * r) * NP + C_AK + h * 128;
#pragma unroll 4
                for (int c = 0; c < 16; ++c) { const v4u qv = *(const v4u*)(qp + 8 * c), kv = *(const v4u*)(kp + 8 * c);
                    dot += bflo(qv.x) * bflo(kv.x) + bfhi(qv.x) * bfhi(kv.x) + bflo(qv.y) * bflo(kv.y) + bfhi(qv.y) * bfhi(kv.y) + bflo(qv.z) * bflo(kv.z) + bfhi(qv.z) * bfhi(kv.z) + bflo(qv.w) * bflo(kv.w) + bfhi(qv.w) * bfhi(kv.w); } }
            sc[jj] = valid ? dot * QSCALE - slope * (float)(j * r) : -INFINITY;
        }
        const float mx = wave_max(fmaxf(fmaxf(sc[0], sc[1]), sc[2]));
        float ps = 0.f;
#pragma unroll
        for (int jj = 0; jj < 3; ++jj) { const float p = (sc[jj] == -INFINITY) ? 0.f : __expf(sc[jj] - mx); ps += p; pbuf[F.lane + 64 * jj] = p; }
        const float l = wave_sum(ps);
        LDS_WAIT(); asm volatile("" ::: "memory");
        const int nk = ((t / r) < 128 ? (t / r) : 128) + 1;
        float o0 = 0.f, o1 = 0.f;
        const bf16* vp = PROJ + (size_t)m * NP + C_AV + h * 128 + 2 * F.lane;
        for (int j = 0; j < nk; ++j) { const float p = pbuf[j]; const unsigned w = *(const unsigned*)(vp - (size_t)j * r * NP); o0 += p * bflo(w); o1 += p * bfhi(w); }
        const float il = 1.f / l;
        *(unsigned*)(ATTO + (size_t)m * 1536 + h * 128 + 2 * F.lane) = pk2(o0 * il, o1 * il);
        if (F.lane == 0) LSE[(size_t)m * 12 + h] = mx + __logf(l);
        LDS_WAIT(); asm volatile("" ::: "memory");
    }
}
__device__ __forceinline__ void conv_qk(Frame& F, const float* conv_w, const float* conv_b) {
    const bf16* PROJ = (const bf16*)(F.ws + WS_PROJ); bf16* QKC = (bf16*)(F.ws + WS_QKC);
    const int gt = F.vcu * (NWAVES * 64) + F.tid, NT = F.G * NWAVES * 64;
    for (int idx = gt; idx < M * 128; idx += NT) {
        const int m = idx >> 7, c8 = (idx & 127) * 8, t = m % SEQ;
        float acc[8];
#pragma unroll
        for (int i = 0; i < 8; ++i) acc[i] = conv_b[c8 + i];
#pragma unroll
        for (int j = 0; j < 4; ++j) { const int tt = t - 3 + j; if (tt < 0) continue;
            const v4u w = *(const v4u*)(PROJ + (size_t)(m - 3 + j) * NP + C_MQK + c8);
            const f32x4 c0 = *(const f32x4*)(conv_w + j * 1024 + c8), c1 = *(const f32x4*)(conv_w + j * 1024 + c8 + 4);
            acc[0] += c0[0] * bflo(w.x); acc[1] += c0[1] * bfhi(w.x); acc[2] += c0[2] * bflo(w.y); acc[3] += c0[3] * bfhi(w.y);
            acc[4] += c1[0] * bflo(w.z); acc[5] += c1[1] * bfhi(w.z); acc[6] += c1[2] * bflo(w.w); acc[7] += c1[3] * bfhi(w.w); }
#pragma unroll
        for (int i = 0; i < 8; ++i) acc[i] = acc[i] * sigm(acc[i]);
        v4u o; o.x = pk2(acc[0], acc[1]); o.y = pk2(acc[2], acc[3]); o.z = pk2(acc[4], acc[5]); o.w = pk2(acc[6], acc[7]);
        *(v4u*)(QKC + (size_t)m * 1024 + c8) = o;
    }
}

__device__ __forceinline__ float log_sigmoid(float x) { return fminf(x, 0.f) - log1pf(__expf(-fabsf(x))); }
__device__ __forceinline__ void mlstm_naive(Frame& F, int bh) {
    const int b = bh >> 2, h = bh & 3;
    const bf16* PROJ = (const bf16*)(F.ws + WS_PROJ); const bf16* QKC = (const bf16*)(F.ws + WS_QKC); const float* MIF = (const float*)(F.ws + WS_MIF);
    float* NUM = (float*)(F.ws + WS_NUM); float* DEN = (float*)(F.ws + WS_DEN); float* MT = (float*)(F.ws + WS_MT);
    LAS float* qs = (LAS float*)(F.lds + RING_OFF); LAS float* ks = qs + 64 * 128; LAS bf16* vs = (LAS bf16*)(ks + 64 * 128);
    LAS float* gi = (LAS float*)(F.lds + GATE_OFF); LAS float* gf = gi + 64;
    float C[128];
#pragma unroll
    for (int d = 0; d < 128; ++d) C[d] = 0.f;
    float mst = 0.f;
    for (int c = 0; c < SEQ / 64; ++c) {
        __syncthreads();
        const size_t row0 = (size_t)b * SEQ + (size_t)c * 64;
        for (int idx = F.tid; idx < 64 * 32; idx += NWAVES * 64) { const int s = idx >> 5, c8 = idx & 31;
            const bf16* src = QKC + (row0 + s) * 1024 + (c8 < 16 ? h * 128 + c8 * 8 : 512 + h * 128 + (c8 - 16) * 8);
            const v4u w = *(const v4u*)src; const float sc = c8 < 16 ? QSCALE : 1.f;
            LAS float* dst = (c8 < 16 ? qs + s * 128 + c8 * 8 : ks + s * 128 + (c8 - 16) * 8);
            *(LAS f32x4*)dst = (f32x4){bflo(w.x) * sc, bfhi(w.x) * sc, bflo(w.y) * sc, bfhi(w.y) * sc}; *(LAS f32x4*)(dst + 4) = (f32x4){bflo(w.z) * sc, bfhi(w.z) * sc, bflo(w.w) * sc, bfhi(w.w) * sc};
            *(LAS v4u*)(vs + s * 256 + c8 * 8) = *(const v4u*)(PROJ + (row0 + s) * NP + C_MV + h * 256 + c8 * 8); }
        if (F.tid < 64) { gi[F.tid] = MIF[(row0 + F.tid) * 8 + h]; gf[F.tid] = log_sigmoid(MIF[(row0 + F.tid) * 8 + 4 + h]); }
        __syncthreads();
        if (F.tid <= 256) {
            for (int s = 0; s < 64; ++s) {
                const float lf = gf[s], ip = gi[s];
                const float mn = fmaxf(lf + mst, ip), fg = __expf(lf + mst - mn), ig = __expf(ip - mn); mst = mn;
                const float vv = (F.tid < 256) ? __uint_as_float((unsigned)vs[s * 256 + (F.tid & 255)] << 16) : 1.f;
                const float a = ig * vv; float num = 0.f;
#pragma unroll
                for (int d4 = 0; d4 < 32; ++d4) { const f32x4 kk = *(const LAS f32x4*)(ks + s * 128 + 4 * d4), qq = *(const LAS f32x4*)(qs + s * 128 + 4 * d4);
#pragma unroll
                    for (int e = 0; e < 4; ++e) { C[4 * d4 + e] = fg * C[4 * d4 + e] + a * kk[e]; num += C[4 * d4 + e] * qq[e]; } }
                if (F.tid < 256) NUM[(row0 + s) * 1024 + h * 256 + F.tid] = num; else { DEN[(row0 + s) * 4 + h] = num; MT[(row0 + s) * 4 + h] = mn; }
            }
        }
    }
}
__device__ __forceinline__ void attn_merge(Frame& F, int first_wg) {
    const bf16* ATTO = (const bf16*)(F.ws + WS_ATTO); const float* LSE = (const float*)(F.ws + WS_LSE); bf16* ATT = (bf16*)(F.ws + WS_ATT);
    const int gt = (F.vcu - first_wg) * (NWAVES * 64) + F.tid, NT = (F.G - first_wg) * NWAVES * 64;
    for (int idx = gt; idx < M * 64; idx += NT) {
        const int m = idx >> 6, r = idx & 63, j = r >> 4, d8 = (r & 15) * 8;
        const float l0 = LSE[(size_t)m * 12 + j], l1 = LSE[(size_t)m * 12 + 4 + j], l2 = LSE[(size_t)m * 12 + 8 + j], mx = fmaxf(fmaxf(l0, l1), l2);
        float e0 = __expf(l0 - mx), e1 = __expf(l1 - mx), e2 = __expf(l2 - mx); const float inv = 1.f / (e0 + e1 + e2); e0 *= inv; e1 *= inv; e2 *= inv;
        const v4u a = *(const v4u*)(ATTO + (size_t)m * 1536 + j * 128 + d8), b = *(const v4u*)(ATTO + (size_t)m * 1536 + 512 + j * 128 + d8), c = *(const v4u*)(ATTO + (size_t)m * 1536 + 1024 + j * 128 + d8);
        v4u o;
        o.x = pk2(e0 * bflo(a.x) + e1 * bflo(b.x) + e2 * bflo(c.x), e0 * bfhi(a.x) + e1 * bfhi(b.x) + e2 * bfhi(c.x));
        o.y = pk2(e0 * bflo(a.y) + e1 * bflo(b.y) + e2 * bflo(c.y), e0 * bfhi(a.y) + e1 * bfhi(b.y) + e2 * bfhi(c.y));
        o.z = pk2(e0 * bflo(a.z) + e1 * bflo(b.z) + e2 * bflo(c.z), e0 * bfhi(a.z) + e1 * bfhi(b.z) + e2 * bfhi(c.z));
        o.w = pk2(e0 * bflo(a.w) + e1 * bflo(b.w) + e2 * bflo(c.w), e0 * bfhi(a.w) + e1 * bfhi(b.w) + e2 * bfhi(c.w));
        *(v4u*)(ATT + (size_t)m * 512 + j * 128 + d8) = o;
    }
}
__device__ __forceinline__ void mlstm_post(Frame& F, const float* norm_w) {
    const bf16* PROJ = (const bf16*)(F.ws + WS_PROJ); const float* NUM = (const float*)(F.ws + WS_NUM); const float* DEN = (const float*)(F.ws + WS_DEN); const float* MT = (const float*)(F.ws + WS_MT);
    bf16* HM = (bf16*)(F.ws + WS_HM);
    const int gw = F.vcu * NWAVES + F.wave, NGW = F.G * NWAVES;
    for (int it = gw; it < M * 4; it += NGW) {
        const int m = it >> 2, h = it & 3;
        const f32x4 nv = *(const f32x4*)(NUM + (size_t)m * 1024 + h * 256 + 4 * F.lane);
        const float den = DEN[(size_t)m * 4 + h], mt = MT[(size_t)m * 4 + h];
        const float dn = 1.f / fmaxf(fabsf(den), __expf(-mt));
        const f32x4 hv = nv * dn;
        const float mean = wave_sum((hv[0] + hv[1]) + (hv[2] + hv[3])) * (1.f / 256.f);
        const f32x4 dv = hv - mean;
        const float var = wave_sum((dv[0] * dv[0] + dv[1] * dv[1]) + (dv[2] * dv[2] + dv[3] * dv[3])) * (1.f / 256.f);
        const float rs = rsqrtf(var + LN_EPS);
        const f32x4 nw = *(const f32x4*)(norm_w + h * 256 + 4 * F.lane);
        const unsigned long long ow = *(const unsigned long long*)(PROJ + (size_t)m * NP + C_MO + h * 256 + 4 * F.lane);
        const unsigned w0 = (unsigned)ow, w1 = (unsigned)(ow >> 32);
        const float y0 = dv[0] * rs * nw[0] * sigm(bflo(w0)), y1 = dv[1] * rs * nw[1] * sigm(bfhi(w0)), y2 = dv[2] * rs * nw[2] * sigm(bflo(w1)), y3 = dv[3] * rs * nw[3] * sigm(bfhi(w1));
        *(unsigned long long*)(HM + (size_t)m * 1024 + h * 256 + 4 * F.lane) = (unsigned long long)pk2(y0, y1) | ((unsigned long long)pk2(y2, y3) << 32);
    }
}

typedef short s16x4 __attribute__((ext_vector_type(4)));
__device__ __forceinline__ bf16x8 frag_tr(const LAS unsigned char* img, int pitch, int k0, int n0, int lane) {
    const int i = lane & 15, g = lane >> 4;
    const LAS unsigned char* p = img + (k0 + 8 * g + (i >> 2)) * pitch + (n0 + 4 * (i & 3)) * 2;
    const s16x4 a = __builtin_amdgcn_ds_read_tr16_b64_v4i16((LAS s16x4*)p), b = __builtin_amdgcn_ds_read_tr16_b64_v4i16((LAS s16x4*)(p + 4 * pitch));
    return (bf16x8){a[0], a[1], a[2], a[3], b[0], b[1], b[2], b[3]};
}
__device__ __forceinline__ bf16x8 frag_g(const bf16* base, size_t pitch, int r0, int k0, int lane) { return *(const bf16x8*)(base + (size_t)(r0 + (lane & 15)) * pitch + k0 + 8 * (lane >> 4)); }
__device__ __forceinline__ float scan_add(float v, int lane) {
#pragma unroll
    for (int o = 1; o < 64; o <<= 1) { const float t = __shfl_up(v, o); if (lane >= o) v += t; }
    return v;
}
__device__ __forceinline__ float scan_max(float v, int lane) {
#pragma unroll
    for (int o = 1; o < 64; o <<= 1) { const float t = __shfl_up(v, o); if (lane >= o) v = fmaxf(v, t); }
    return v;
}
constexpr int VIMG_PITCH = 528, KIMG_PITCH = 272, QKIMG_PITCH = 144;
constexpr int L_VIMG = 0, L_KIMG = 33792, L_WK = 51200;
constexpr int L_QKIMG = 33792, L_GS = 43008, L_MX = 43264, L_BS = 43520, L_STAT = 43776;
__device__ __forceinline__ void mlstm_m1(Frame& F) {
    const bf16* PROJ = (const bf16*)(F.ws + WS_PROJ); const bf16* QKC = (const bf16*)(F.ws + WS_QKC); const float* MIF = (const float*)(F.ws + WS_MIF);
    float* KVT = (float*)(F.ws + WS_KVT); float* MLOC = (float*)(F.ws + WS_MSC); float* BLAST = MLOC + 1024; float* NLOC = (float*)(F.ws + WS_MSC + 65536);
    LAS unsigned char* Vimg = F.lds + L_VIMG; LAS unsigned char* Kimg = F.lds + L_KIMG; LAS float* wkL = (LAS float*)(F.lds + L_WK);
    for (int item = F.vcu; item < 512; item += F.G) {
        const int bh = item >> 6, c = item & 63, b = bh >> 2, h = bh & 3; const size_t row0 = (size_t)b * SEQ + (size_t)c * 64;
        __syncthreads();
        if (F.wave == 0) { const float lf = log_sigmoid(MIF[(row0 + F.lane) * 8 + 4 + h]), ip = MIF[(row0 + F.lane) * 8 + h];
            const float bs = scan_add(lf, F.lane), bl = __shfl(bs, 63), wl = bl - bs + ip, ml = wave_max(wl);
            wkL[F.lane] = __expf(wl - ml);
            if (F.lane == 0) { MLOC[item] = ml; BLAST[item] = bl; } }
        for (int idx = F.tid; idx < 2048; idx += NWAVES * 64) { const int s = idx >> 5, c8 = idx & 31;
            *(LAS v4u*)(Vimg + s * VIMG_PITCH + c8 * 16) = *(const v4u*)(PROJ + (row0 + s) * NP + C_MV + h * 256 + c8 * 8); }
        __syncthreads();
        for (int idx = F.tid; idx < 1024; idx += NWAVES * 64) { const int s = idx >> 4, c8 = idx & 15; const float wk = wkL[s];
            const v4u w = *(const v4u*)(QKC + (row0 + s) * 1024 + 512 + h * 128 + c8 * 8); v4u o;
            o.x = pk2(bflo(w.x) * wk, bfhi(w.x) * wk); o.y = pk2(bflo(w.y) * wk, bfhi(w.y) * wk); o.z = pk2(bflo(w.z) * wk, bfhi(w.z) * wk); o.w = pk2(bflo(w.w) * wk, bfhi(w.w) * wk);
            *(LAS v4u*)(Kimg + s * KIMG_PITCH + c8 * 16) = o; }
        __syncthreads();
        if (F.tid < 128) { float a = 0.f;
#pragma unroll 8
            for (int s = 0; s < 64; ++s) a += __uint_as_float((unsigned)(*(const LAS bf16*)(Kimg + s * KIMG_PITCH + F.tid * 2)) << 16);
            NLOC[(size_t)item * 128 + F.tid] = a; }
        f32x4 acc[2][8];
#pragma unroll
        for (int r = 0; r < 2; ++r)
#pragma unroll
            for (int ct = 0; ct < 8; ++ct) acc[r][ct] = (f32x4){0.f, 0.f, 0.f, 0.f};
#pragma unroll
        for (int ks = 0; ks < 2; ++ks) {
            const bf16x8 a0 = frag_tr(Vimg, VIMG_PITCH, 32 * ks, 32 * F.wave, F.lane), a1 = frag_tr(Vimg, VIMG_PITCH, 32 * ks, 32 * F.wave + 16, F.lane);
#pragma unroll
            for (int ct = 0; ct < 8; ++ct) { const bf16x8 bb = frag_tr(Kimg, KIMG_PITCH, 32 * ks, 16 * ct, F.lane);
                acc[0][ct] = __builtin_amdgcn_mfma_f32_16x16x32_bf16(a0, bb, acc[0][ct], 0, 0, 0); acc[1][ct] = __builtin_amdgcn_mfma_f32_16x16x32_bf16(a1, bb, acc[1][ct], 0, 0, 0); } }
        const int i = F.lane & 15, g = F.lane >> 4;
#pragma unroll
        for (int r = 0; r < 2; ++r)
#pragma unroll
            for (int ct = 0; ct < 8; ++ct)
#pragma unroll
                for (int q = 0; q < 4; ++q) KVT[((size_t)item * 256 + 32 * F.wave + 16 * r + 4 * g + q) * 128 + 16 * ct + i] = acc[r][ct][q];
    }
}
__device__ __forceinline__ void mlstm_m2(Frame& F) {
    const float* KVT = (const float*)(F.ws + WS_KVT); bf16* CPREV = (bf16*)(F.ws + WS_CPREV);
    const float* MLOC = (const float*)(F.ws + WS_MSC); const float* BLAST = MLOC + 1024; float* MPREV = (float*)(F.ws + WS_MSC) + 2048;
    const float* NLOC = (const float*)(F.ws + WS_MSC + 65536); float* NPREV = (float*)(F.ws + WS_MSC + 524288);
    const int gt = F.vcu * (NWAVES * 64) + F.tid, NT = F.G * NWAVES * 64;
    for (int p = gt; p < 8 * 256 * 64; p += NT) {
        const int bh = p >> 14, rem = p & 16383, v = rem >> 6, d2 = (rem & 63) * 2;
        float c0 = 0.f, c1 = 0.f, m = 0.f;
#pragma unroll 4
        for (int c = 0; c < 64; ++c) { const int item = bh * 64 + c; const size_t off = ((size_t)item * 256 + v) * 128 + d2;
            *(unsigned*)(CPREV + off) = pk2(c0, c1);
            const float2 kv = *(const float2*)(KVT + off);
            const float ml = MLOC[item], bl = BLAST[item], mn = fmaxf(bl + m, ml), dec = __expf(bl + m - mn), sc = __expf(ml - mn); m = mn;
            c0 = dec * c0 + sc * kv.x; c1 = dec * c1 + sc * kv.y; }
    }
    if (gt < 8 * 128) { const int bh = gt >> 7, d = gt & 127; float n = 0.f, m = 0.f;
        for (int c = 0; c < 64; ++c) { const int item = bh * 64 + c;
            NPREV[(size_t)item * 128 + d] = n; if (d == 0) MPREV[item] = m;
            const float ml = MLOC[item], bl = BLAST[item], mn = fmaxf(bl + m, ml), dec = __expf(bl + m - mn), sc = __expf(ml - mn); m = mn;
            n = dec * n + sc * NLOC[(size_t)item * 128 + d]; } }
}
__device__ __forceinline__ void mlstm_m3(Frame& F, const float* norm_w) {
    const bf16* PROJ = (const bf16*)(F.ws + WS_PROJ); const bf16* QKC = (const bf16*)(F.ws + WS_QKC); const float* MIF = (const float*)(F.ws + WS_MIF);
    const bf16* CPREV = (const bf16*)(F.ws + WS_CPREV); const float* MPREV = (const float*)(F.ws + WS_MSC) + 2048; const float* NPREV = (const float*)(F.ws + WS_MSC + 524288);
    bf16* HM = (bf16*)(F.ws + WS_HM);
    LAS unsigned char* Vimg = F.lds + L_VIMG; LAS unsigned char* QKimg = F.lds + L_QKIMG;
    LAS float* gsL = (LAS float*)(F.lds + L_GS); LAS float* mxL = (LAS float*)(F.lds + L_MX); LAS float* bsL = (LAS float*)(F.lds + L_BS); LAS float* stL = (LAS float*)(F.lds + L_STAT);
    const int i = F.lane & 15, g = F.lane >> 4, rt = F.wave & 3, ch = F.wave >> 2;
    for (int item = F.vcu; item < 512; item += F.G) {
        const int bh = item >> 6, c = item & 63, b = bh >> 2, h = bh & 3; const size_t row0 = (size_t)b * SEQ + (size_t)c * 64;
        __syncthreads();
        const float mprev = MPREV[item];
        if (F.wave == 0) { const float lf = log_sigmoid(MIF[(row0 + F.lane) * 8 + 4 + h]), ip = MIF[(row0 + F.lane) * 8 + h];
            const float bs = scan_add(lf, F.lane), gv = ip - bs, pm = scan_max(gv, F.lane);
            gsL[F.lane] = gv; mxL[F.lane] = fmaxf(mprev, pm); bsL[F.lane] = bs; }
        for (int idx = F.tid; idx < 2048; idx += NWAVES * 64) { const int s = idx >> 5, c8 = idx & 31;
            *(LAS v4u*)(Vimg + s * VIMG_PITCH + c8 * 16) = *(const v4u*)(PROJ + (row0 + s) * NP + C_MV + h * 256 + c8 * 8); }
        bf16x8 qf[4];
#pragma unroll
        for (int ks = 0; ks < 4; ++ks) qf[ks] = frag_g(QKC + h * 128, 1024, (int)row0 + 16 * rt, 32 * ks, F.lane);
        __syncthreads();
#pragma unroll
        for (int cc = 0; cc < 2; ++cc) { const int ct = 2 * ch + cc; f32x4 sv = (f32x4){0.f, 0.f, 0.f, 0.f};
            if (ct <= rt) {
#pragma unroll
                for (int ks = 0; ks < 4; ++ks) { const bf16x8 kf = frag_g(QKC + 512 + h * 128, 1024, (int)row0 + 16 * ct, 32 * ks, F.lane); sv = __builtin_amdgcn_mfma_f32_16x16x32_bf16(qf[ks], kf, sv, 0, 0, 0); } }
            const int sidx = 16 * ct + i; const float gsv = gsL[sidx];
#pragma unroll
            for (int q = 0; q < 4; ++q) { const int l = 16 * rt + 4 * g + q; const float val = (sidx <= l) ? sv[q] * QSCALE * __expf(gsv - mxL[l]) : 0.f;
                *(LAS bf16*)(QKimg + l * QKIMG_PITCH + sidx * 2) = (bf16)f2bf(val); } }
        __syncthreads();
        bf16x8 pf[2];
#pragma unroll
        for (int ks = 0; ks < 2; ++ks) pf[ks] = *(const LAS bf16x8*)(QKimg + (16 * rt + i) * QKIMG_PITCH + (32 * ks + 8 * g) * 2);
        f32x4 accs = (f32x4){0.f, 0.f, 0.f, 0.f}, accn = (f32x4){0.f, 0.f, 0.f, 0.f};
        { const bf16x8 ones = (bf16x8){0x3F80, 0x3F80, 0x3F80, 0x3F80, 0x3F80, 0x3F80, 0x3F80, 0x3F80};
#pragma unroll
          for (int ks = 0; ks < 2; ++ks) accs = __builtin_amdgcn_mfma_f32_16x16x32_bf16(pf[ks], ones, accs, 0, 0, 0);
#pragma unroll
          for (int ks = 0; ks < 4; ++ks) { const float* np = NPREV + (size_t)item * 128 + 32 * ks + 8 * g; const f32x4 n0 = *(const f32x4*)np, n1 = *(const f32x4*)(np + 4);
              union { bf16x8 v; unsigned u[4]; } nf; nf.u[0] = pk2(n0[0], n0[1]); nf.u[1] = pk2(n0[2], n0[3]); nf.u[2] = pk2(n1[0], n1[1]); nf.u[3] = pk2(n1[2], n1[3]);
              accn = __builtin_amdgcn_mfma_f32_16x16x32_bf16(qf[ks], nf.v, accn, 0, 0, 0); } }
        f32x4 a1[8], a2[8];
#pragma unroll
        for (int ct = 0; ct < 8; ++ct) { a1[ct] = (f32x4){0.f, 0.f, 0.f, 0.f}; a2[ct] = (f32x4){0.f, 0.f, 0.f, 0.f}; }
        const bf16* cp = CPREV + (size_t)item * 256 * 128;
#pragma unroll
        for (int ct = 0; ct < 8; ++ct) { const int vcol = 128 * ch + 16 * ct;
#pragma unroll
            for (int ks = 0; ks < 4; ++ks) { const bf16x8 cf = frag_g(cp, 128, vcol, 32 * ks, F.lane); a1[ct] = __builtin_amdgcn_mfma_f32_16x16x32_bf16(qf[ks], cf, a1[ct], 0, 0, 0); }
#pragma unroll
            for (int ks = 0; ks < 2; ++ks) { const bf16x8 vf = frag_tr(Vimg, VIMG_PITCH, 32 * ks, vcol, F.lane); a2[ct] = __builtin_amdgcn_mfma_f32_16x16x32_bf16(pf[ks], vf, a2[ct], 0, 0, 0); } }
        float s1[4], s2[4];
#pragma unroll
        for (int q = 0; q < 4; ++q) { const int l = 16 * rt + 4 * g + q; const float mx = mxL[l], wi = __expf(mprev - mx) * QSCALE, mt = bsL[l] + mx;
            const float den = wi * accn[q] + accs[q], dn = 1.f / fmaxf(fabsf(den), __expf(-mt)); float a = 0.f, bq = 0.f;
#pragma unroll
            for (int ct = 0; ct < 8; ++ct) { const float hv = (wi * a1[ct][q] + a2[ct][q]) * dn; a1[ct][q] = hv; a += hv; bq += hv * hv; }
            a += __shfl_xor(a, 1); a += __shfl_xor(a, 2); a += __shfl_xor(a, 4); a += __shfl_xor(a, 8);
            bq += __shfl_xor(bq, 1); bq += __shfl_xor(bq, 2); bq += __shfl_xor(bq, 4); bq += __shfl_xor(bq, 8);
            s1[q] = a; s2[q] = bq;
            if (i == 0) { stL[(l * 2 + ch) * 2] = a; stL[(l * 2 + ch) * 2 + 1] = bq; } }
        __syncthreads();
#pragma unroll
        for (int q = 0; q < 4; ++q) { const int l = 16 * rt + 4 * g + q; const float sa = stL[(l * 2) * 2] + stL[(l * 2 + 1) * 2], qa = stL[(l * 2) * 2 + 1] + stL[(l * 2 + 1) * 2 + 1];
            const float mean = sa * (1.f / 256.f), var = qa * (1.f / 256.f) - mean * mean, rs = rsqrtf(fmaxf(var, 0.f) + LN_EPS);
            const size_t m = row0 + l;
#pragma unroll
            for (int ct = 0; ct < 8; ++ct) { const int v = 128 * ch + 16 * ct + i;
                const float og = __uint_as_float((unsigned)PROJ[m * NP + C_MO + h * 256 + v] << 16);
                HM[m * 1024 + h * 256 + v] = (bf16)f2bf((a1[ct][q] - mean) * rs * norm_w[h * 256 + v] * sigm(og)); } }
        (void)s1; (void)s2;
    }
}
__device__ __forceinline__ void ln1_router(Frame& F, const float* g1, const float* b1, const float* wrg, const float* brg, const float* wre, const float* bre) {
    const float* PRE = (const float*)(F.ws + WS_TMP); float* H1 = (float*)(F.ws + WS_H1); bf16* H1B = (bf16*)(F.ws + WS_H1B);
    int* TOKLIST = (int*)(F.ws + WS_TOKLIST); int* TOKINFO = (int*)(F.ws + WS_TOKINFO);
    const int gw = F.vcu * NWAVES + F.wave, NGW = F.G * NWAVES;
    for (int m = gw; m < M; m += NGW) {
        const f32x4* xr = (const f32x4*)(PRE + (size_t)m * D) + F.lane;
        f32x4 v[8]; float s = 0.f;
#pragma unroll
        for (int j = 0; j < 8; ++j) { v[j] = xr[64 * j]; s += (v[j][0] + v[j][1]) + (v[j][2] + v[j][3]); }
        const float mean = wave_sum(s) * (1.f / D); float s2 = 0.f;
#pragma unroll
        for (int j = 0; j < 8; ++j) { const f32x4 d = v[j] - mean; s2 += (d[0] * d[0] + d[1] * d[1]) + (d[2] * d[2] + d[3] * d[3]); }
        const float rstd = rsqrtf(wave_sum(s2) * (1.f / D) + LN_EPS);
        float ae[32], ag[4];
#pragma unroll
        for (int i = 0; i < 32; ++i) ae[i] = 0.f;
#pragma unroll
        for (int i = 0; i < 4; ++i) ag[i] = 0.f;
        f32x4* h1r = (f32x4*)(H1 + (size_t)m * D) + F.lane; unsigned long long* o8 = (unsigned long long*)(H1B + (size_t)m * D) + F.lane;
#pragma unroll
        for (int j = 0; j < 8; ++j) { const int k0 = 4 * F.lane + 256 * j; const f32x4 g4 = *(const f32x4*)(g1 + k0), b4 = *(const f32x4*)(b1 + k0);
            const f32x4 hv = (v[j] - mean) * rstd * g4 + b4;
            h1r[64 * j] = hv; o8[64 * j] = (unsigned long long)pk2(hv[0], hv[1]) | ((unsigned long long)pk2(hv[2], hv[3]) << 32);
#pragma unroll
            for (int c = 0; c < 4; ++c) { const f32x4 wg = *(const f32x4*)(wrg + (size_t)(k0 + c) * 4);
                ag[0] += hv[c] * wg[0]; ag[1] += hv[c] * wg[1]; ag[2] += hv[c] * wg[2]; ag[3] += hv[c] * wg[3];
#pragma unroll
                for (int q = 0; q < 8; ++q) { const f32x4 we = *(const f32x4*)(wre + (size_t)(k0 + c) * 32 + 4 * q);
                    ae[4 * q] += hv[c] * we[0]; ae[4 * q + 1] += hv[c] * we[1]; ae[4 * q + 2] += hv[c] * we[2]; ae[4 * q + 3] += hv[c] * we[3]; } } }
#pragma unroll
        for (int i = 0; i < 4; ++i) ag[i] = wave_sum(ag[i]) + brg[i];
#pragma unroll
        for (int i = 0; i < 32; ++i) ae[i] = wave_sum(ae[i]) + bre[i];
        int grp = 0; float gm = ag[0];
#pragma unroll
        for (int i = 1; i < 4; ++i) if (ag[i] > gm) { gm = ag[i]; grp = i; }
        float gs = 0.f;
#pragma unroll
        for (int i = 0; i < 4; ++i) gs += __expf(ag[i] - gm);
        const float gwt = 1.f / gs;
        float el[8];
#pragma unroll
        for (int i = 0; i < 8; ++i) el[i] = grp == 0 ? ae[i] : (grp == 1 ? ae[8 + i] : (grp == 2 ? ae[16 + i] : ae[24 + i]));
        int i1 = 0; float v1 = el[0];
#pragma unroll
        for (int i = 1; i < 8; ++i) if (el[i] > v1) { v1 = el[i]; i1 = i; }
        int i2 = -1; float v2 = -INFINITY;
#pragma unroll
        for (int i = 0; i < 8; ++i) if (i != i1 && el[i] > v2) { v2 = el[i]; i2 = i; }
        const float ex = __expf(v2 - v1), p1 = 1.f / (1.f + ex), p2 = ex * p1;
        if (F.lane == 0) {
            const int e1 = grp * 8 + i1, e2 = grp * 8 + i2;
            const int pos1 = (int)__hip_atomic_fetch_add(F.ctl + CW_CNT + 16 * e1, 1u, RLX_AGENT), pos2 = (int)__hip_atomic_fetch_add(F.ctl + CW_CNT + 16 * e2, 1u, RLX_AGENT);
            TOKLIST[e1 * ECAP + pos1] = m; TOKLIST[e2 * ECAP + pos2] = m;
            int* ti = TOKINFO + (size_t)m * 8; ti[0] = e1; ti[1] = pos1; ti[2] = e2; ti[3] = pos2; ti[4] = __float_as_int(gwt * p1); ti[5] = __float_as_int(gwt * p2);
        }
    }
}
struct MoeOrder {
    const LAS int* TS; const LAS int* CN; const int* toklist; int NT, G, c, U; bool gather;
    __device__ __forceinline__ void init(const LAS int* ts, const LAS int* cn, const int* tl, int nt, int G_, int c_, bool ga) { TS = ts; CN = cn; toklist = tl; NT = nt; G = G_; c = c_; U = ts[NE] * nt; gather = ga; }
    __device__ __forceinline__ bool next(int i, pg8::Unit& u) const {
        const int x = c & 7, r = c >> 3, W = G >> 3;
        const int lo = (int)(((long)U * x) >> 3), hi = (int)(((long)U * (x + 1)) >> 3);
        const int L = lo + r + i * W; if (L >= hi) return false;
        int e = 0;
#pragma unroll 1
        for (int k = 1; k < NE; ++k) if (L >= TS[k] * NT) e = k;
        const int ne = TS[e + 1] - TS[e], loc = L - TS[e] * NT, n_t = loc / ne, m_t = loc % ne;
        u.pm = TS[e] + m_t; u.pn = e * NT + n_t; u.e = e; u.r0 = m_t * 256; return true;
    }
    __device__ __forceinline__ int arow(const pg8::Unit& u, int r) const {
        if (!gather) return u.pm * 256 + r;
        int idx = u.r0 + r; const int cn = CN[u.e]; idx = idx < cn ? idx : cn - 1;
        return toklist[u.e * ECAP + idx];
    }
    __device__ __forceinline__ void a_ready(const pg8::Unit&) const {}
    __device__ __forceinline__ void done(const pg8::Unit&) const {}
};
__device__ __forceinline__ void moe_tables(Frame& F) {
    LAS int* TS = (LAS int*)(F.lds + TS_OFF); LAS int* CN = (LAS int*)(F.lds + CNT_OFF);
    if (F.tid < NE) CN[F.tid] = (int)__hip_atomic_load(F.ctl + CW_CNT + 16 * F.tid, RLX_AGENT);
    __syncthreads();
    if (F.tid == 0) { int acc = 0; for (int e = 0; e < NE; ++e) { TS[e] = acc; acc += (CN[e] + 255) >> 8; } TS[NE] = acc; }
    __syncthreads();
}
__device__ __forceinline__ void final_ln(Frame& F, const float* g2, const float* b2, float* out) {
    const float* H1 = (const float*)(F.ws + WS_H1); const bf16* YS = (const bf16*)(F.ws + WS_YS); const int* TOKINFO = (const int*)(F.ws + WS_TOKINFO);
    const LAS int* TS = (const LAS int*)(F.lds + TS_OFF);
    const int gw = F.vcu * NWAVES + F.wave, NGW = F.G * NWAVES;
    for (int m = gw; m < M; m += NGW) {
        const int* ti = TOKINFO + (size_t)m * 8;
        const int e1 = ti[0], p1 = ti[1], e2 = ti[2], p2 = ti[3]; const float w1 = __int_as_float(ti[4]), w2 = __int_as_float(ti[5]);
        const size_t sl1 = (size_t)TS[e1] * 256 + p1, sl2 = (size_t)TS[e2] * 256 + p2;
        const f32x4* hr = (const f32x4*)(H1 + (size_t)m * D) + F.lane;
        const unsigned long long* y1 = (const unsigned long long*)(YS + sl1 * D) + F.lane; const unsigned long long* y2 = (const unsigned long long*)(YS + sl2 * D) + F.lane;
        f32x4 v[8]; float s = 0.f;
#pragma unroll
        for (int j = 0; j < 8; ++j) { const f32x4 hv = hr[64 * j]; const unsigned long long a = y1[64 * j], b = y2[64 * j];
            const unsigned a0 = (unsigned)a, a1 = (unsigned)(a >> 32), b0 = (unsigned)b, b1 = (unsigned)(b >> 32);
            f32x4 y; y[0] = w1 * bflo(a0) + w2 * bflo(b0); y[1] = w1 * bfhi(a0) + w2 * bfhi(b0); y[2] = w1 * bflo(a1) + w2 * bflo(b1); y[3] = w1 * bfhi(a1) + w2 * bfhi(b1);
            v[j] = hv * ALPHA + y; s += (v[j][0] + v[j][1]) + (v[j][2] + v[j][3]); }
        const float mean = wave_sum(s) * (1.f / D); float s2 = 0.f;
#pragma unroll
        for (int j = 0; j < 8; ++j) { const f32x4 d = v[j] - mean; s2 += (d[0] * d[0] + d[1] * d[1]) + (d[2] * d[2] + d[3] * d[3]); }
        const float rstd = rsqrtf(wave_sum(s2) * (1.f / D) + LN_EPS);
        f32x4* orow = (f32x4*)(out + (size_t)m * D) + F.lane;
#pragma unroll
        for (int j = 0; j < 8; ++j) { const int k0 = 4 * F.lane + 256 * j; const f32x4 g4 = *(const f32x4*)(g2 + k0), b4 = *(const f32x4*)(b2 + k0);
            orow[64 * j] = (v[j] - mean) * rstd * g4 + b4; }
    }
}

#ifndef SKIPMASK
#define SKIPMASK 0
#endif
#ifndef MLSTM_NAIVE
#define MLSTM_NAIVE 0
#endif
#ifndef DUPMASK
#define DUPMASK 0
#endif
constexpr int N_PHASES = 12;
struct Args { const float* in[22]; float* out; unsigned char* ws; int ph_lo, ph_hi, li, pad; };
__global__ void __launch_bounds__(NWAVES * 64, 2) fwd_kernel(Args args) {
    extern __shared__ __attribute__((aligned(16))) unsigned char lds[];
    Frame F;
    F.lds = (LAS unsigned char*)lds;
    F.tid = threadIdx.x; F.lane = F.tid & 63; F.wave = __builtin_amdgcn_readfirstlane(F.tid >> 6);
    F.G = gridDim.x; { const int bx = blockIdx.x; F.vcu = (F.G % 8 == 0) ? (bx % 8) * (F.G / 8) + bx / 8 : bx; }
    F.ws = args.ws; F.ctl = (gu32*)(args.ws + WS_CTL);
    for (int u = F.tid; u < (LDS_BYTES - LDSCTL_OFF) / 4; u += NWAVES * 64) ((LAS unsigned*)(F.lds + LDSCTL_OFF))[u] = 0u;
    __syncthreads();
    XcdBarrier bar = xcd_barrier_post((unsigned*)(F.ctl + CW_BAR) + args.li * XCD_BAR_WORDS, (volatile LAS unsigned*)(F.lds + MISC_OFF) + 8);
    const int lo = args.ph_lo, hi = args.ph_hi;
#define IN(k) (lo <= (k) && (k) < hi && !(SKIPMASK & (1 << (k))))
#define REP(k) for (int rep_ = 0; rep_ < ((DUPMASK >> (k)) & 1) + 1; ++rep_)
#define SEAM(k) do { if (lo <= (k) && (k) + 1 < hi) xcd_barrier(bar); } while (0)
    unsigned char* ws = args.ws;
    if (IN(0)) REP(0) { p0_prologue(F, args.in[0], args.in[1], args.in[2], args.in[3], args.in[6], args.in[8], args.in[9], args.in[10], args.in[17], args.in[18], args.in[19]); __syncthreads(); }
    SEAM(0);
    if (IN(1)) REP(1) { pg8::Gemm g{(const bf16*)(ws + WS_HB), (const bf16*)(ws + WS_WIN), M, NP, D}; pg8::StaticOrder S; S.init(M, NP, F.G, (int)blockIdx.x);
        pg8::EpiBf16 E{(bf16*)(ws + WS_PROJ), NP};
        pg8::gemm_phase<pg8::EpiBf16, pg8::StaticOrder, true, true>(F.lds + RING_OFF, g, S, E); }
    SEAM(1);
    if (IN(2)) REP(2) { conv_qk(F, args.in[4], args.in[5]); attn_naive(F); }
    SEAM(2);
#if MLSTM_NAIVE
    if (IN(3)) { if (F.vcu < 8) mlstm_naive(F, F.vcu); else attn_merge(F, 8); }
    SEAM(3);
    if (IN(4)) { mlstm_post(F, args.in[7]); }
    SEAM(4);
    SEAM(5);
#else
    if (IN(3)) REP(3) { mlstm_m1(F); attn_merge(F, 0); }
    SEAM(3);
    if (IN(4)) REP(4) { mlstm_m2(F); }
    SEAM(4);
    if (IN(5)) REP(5) { mlstm_m3(F, args.in[7]); }
    SEAM(5);
#endif
    if (IN(6)) REP(6) {
        { pg8::Gemm g{(const bf16*)(ws + WS_ATT), (const bf16*)(ws + WS_WPA), M, D, 512}; pg8::StaticOrder S; S.init(M, D, F.G, (int)blockIdx.x);
          pg8::EpiGateA E{(float*)(ws + WS_TMP), D, (const bf16*)(ws + WS_PROJ) + C_GATE, NP};
          pg8::gemm_phase<pg8::EpiGateA, pg8::StaticOrder, true, true>(F.lds + RING_OFF, g, S, E); }
        { pg8::Gemm g{(const bf16*)(ws + WS_HM), (const bf16*)(ws + WS_WPM), M, D, 1024}; pg8::StaticOrder S; S.init(M, D, F.G, (int)blockIdx.x);
          pg8::EpiGateB E{(bf16*)(ws + WS_MERGED), (const float*)(ws + WS_TMP), D, (const bf16*)(ws + WS_PROJ) + C_GATE + D, NP};
          pg8::gemm_phase<pg8::EpiGateB, pg8::StaticOrder, true, true>(F.lds + RING_OFF, g, S, E); }
    }
    SEAM(6);
    if (IN(7)) REP(7) { pg8::Gemm g{(const bf16*)(ws + WS_MERGED), (const bf16*)(ws + WS_WOUT), M, D, D}; pg8::StaticOrder S; S.init(M, D, F.G, (int)blockIdx.x);
        pg8::EpiResid E{(float*)(ws + WS_TMP), D, args.in[0], (const float*)(ws + WS_STATS), args.in[1], args.in[2], ALPHA};
        pg8::gemm_phase<pg8::EpiResid, pg8::StaticOrder, true, true>(F.lds + RING_OFF, g, S, E); }
    SEAM(7);
    if (IN(8)) { ln1_router(F, args.in[11], args.in[12], args.in[13], args.in[14], args.in[15], args.in[16]); }
    SEAM(8);
    if (IN(9) || IN(10) || IN(11)) moe_tables(F);
    if (IN(9)) REP(9) { pg8::Gemm g{(const bf16*)(ws + WS_H1B), (const bf16*)(ws + WS_WGU), M, NE * 2 * DFF, D};
        MoeOrder S; S.init((const LAS int*)(F.lds + TS_OFF), (const LAS int*)(F.lds + CNT_OFF), (const int*)(ws + WS_TOKLIST), NT1, F.G, (int)blockIdx.x, true);
        pg8::EpiSwiGlu E{(bf16*)(ws + WS_ACT), DFF, NT1};
        pg8::gemm_phase<pg8::EpiSwiGlu, MoeOrder, true, true>(F.lds + RING_OFF, g, S, E); }
    SEAM(9);
    if (IN(10)) REP(10) { pg8::Gemm g{(const bf16*)(ws + WS_ACT), (const bf16*)(ws + WS_WD), MAXT * 256, NE * D, DFF};
        MoeOrder S; S.init((const LAS int*)(F.lds + TS_OFF), (const LAS int*)(F.lds + CNT_OFF), (const int*)(ws + WS_TOKLIST), NT2, F.G, (int)blockIdx.x, false);
        pg8::EpiBf16Grp E{(bf16*)(ws + WS_YS), D, NT2};
        pg8::gemm_phase<pg8::EpiBf16Grp, MoeOrder, true, true>(F.lds + RING_OFF, g, S, E); }
    SEAM(10);
    if (IN(11)) REP(11) { final_ln(F, args.in[20], args.in[21], args.out); }
#undef IN
#undef SEAM
#undef REP
}

#ifndef MK_PER_PHASE
#define MK_PER_PHASE 0
#endif
extern "C" void kernel_launch(void* const* d_in, const int* in_sizes, int n_in, void* d_out, int out_size, void* d_ws, size_t ws_size, hipStream_t stream) {
    static int grid = 0;
    if (grid == 0) {
        if (n_in != 22 || out_size != M * D || ws_size < WS_END) { fprintf(stderr, "kernel_launch: unexpected problem: n_in %d out %d ws %zu\n", n_in, out_size, ws_size); grid = -1; return; }
        int dev = 0, cus = 0, per_cu = 0;
        if (hipGetDevice(&dev) != hipSuccess || hipDeviceGetAttribute(&cus, hipDeviceAttributeMultiprocessorCount, dev) != hipSuccess) { grid = -1; return; }
        if (hipFuncSetAttribute((const void*)fwd_kernel, hipFuncAttributeMaxDynamicSharedMemorySize, LDS_BYTES) != hipSuccess) { fprintf(stderr, "kernel_launch: hipFuncSetAttribute failed\n"); grid = -1; return; }
        if (hipOccupancyMaxActiveBlocksPerMultiprocessor(&per_cu, (const void*)fwd_kernel, NWAVES * 64, LDS_BYTES) != hipSuccess || per_cu < 1)
            fprintf(stderr, "kernel_launch: note: occupancy query reports %d workgroups per CU\n", per_cu);
        (void)hipGetLastError();
        grid = cus - (cus % 8);
        if (grid < 16) grid = 16;
    }
    if (grid < 0) return;
    (void)hipMemsetAsync((char*)d_ws + WS_CTL, 0, CTL_ZERO_BYTES, stream);
    Args a{};
    for (int i = 0; i < 22; ++i) a.in[i] = (const float*)d_in[i];
    a.out = (float*)d_out; a.ws = (unsigned char*)d_ws; a.pad = 0;
#if MK_PER_PHASE
    for (int p = 0; p < N_PHASES; ++p) { a.ph_lo = p; a.ph_hi = p + 1; a.li = p; hipLaunchKernelGGL(fwd_kernel, dim3(grid), dim3(NWAVES * 64), LDS_BYTES, stream, a); }
#else
    a.ph_lo = 0; a.ph_hi = N_PHASES; a.li = 0;
    hipLaunchKernelGGL(fwd_kernel, dim3(grid), dim3(NWAVES * 64), LDS_BYTES, stream, a);
#endif
}
```

```cpp
#include <hip/hip_runtime.h>
#include <cstdio>
#include <cstdint>
namespace pg8 {
#define PG8_LAS __attribute__((address_space(3)))
typedef unsigned short bf16_t;
typedef short bf16x8 __attribute__((ext_vector_type(8)));
typedef float f32x4 __attribute__((ext_vector_type(4)));
typedef unsigned u32x4 __attribute__((ext_vector_type(4)));
constexpr int BM = 256, BK = 64, HALF = 128, HTB = HALF * BK * 2  , STAGE_BYTES = 8 * HTB, NXCD = 8, WGM = 8;

__host__ __device__ __forceinline__ int lds_byte(int r, int c) { const int st = (r >> 4) * 2 + (c >> 5), rr = r & 15, cc = c & 31, ob = rr * 64 + cc * 2; return st * 1024 + (ob ^ (((ob >> 9) & 1) << 5)); }
__host__ __device__ __forceinline__ void stage_rc(int b, int& R, int& C) { const int st = b / 1024, sb = b % 1024, swz = sb ^ (((sb >> 9) & 1) << 5); R = (st >> 1) * 16 + swz / 64; C = (st & 1) * 32 + (swz % 64) / 2; }
__host__ __device__ __forceinline__ int perm32(int rho) { const int n = rho >> 4, i = rho & 15; return 8 * (i >> 2) + 4 * n + (i & 3); }

struct Unit { int pm, pn, e, r0; };
struct Gemm { const bf16_t* A; const bf16_t* Bt; int M, N, K; };

struct StaticOrder {
    int nM, nN, nwg, G, c;
    __host__ __device__ void init(int M, int N, int G_, int c_) { nM = M / BM; nN = N / BM; nwg = nM * nN; G = G_; c = c_; }
    __host__ __device__ bool next(int i, Unit& u) const {
        const long L = (long)i * G + c; if (L >= nwg) return false;
        int wgid = (int)L; { const int q = nwg / NXCD, r = nwg % NXCD, xcd = wgid % NXCD, off = wgid / NXCD; wgid = (xcd < r ? xcd * (q + 1) : r * (q + 1) + (xcd - r) * q) + off; }
        const int nig = WGM * nN, gid = wgid / nig, fm = gid * WGM, gsz = (nM - fm) < WGM ? (nM - fm) : WGM;
        u.pm = fm + ((wgid % nig) % gsz); u.pn = (wgid % nig) / gsz; u.e = 0; u.r0 = 0; return true;
    }
    __device__ __forceinline__ int arow(const Unit& u, int r) const { return u.pm * BM + r; }
    __device__ __forceinline__ void a_ready(const Unit&) const {}
    __device__ __forceinline__ void done(const Unit&) const {}
};

__device__ __forceinline__ unsigned cvt_pk_bf16(float lo, float hi) { unsigned r; asm volatile("v_cvt_pk_bf16_f32 %0, %1, %2" : "=v"(r) : "v"(lo), "v"(hi)); return r; }
__device__ __forceinline__ float bf_lo(unsigned w) { return __uint_as_float(w << 16); }
__device__ __forceinline__ float bf_hi(unsigned w) { return __uint_as_float(w & 0xffff0000u); }
__device__ __forceinline__ float sigmoidf_(float x) { return 1.0f / (1.0f + __expf(-x)); }

struct EpiBf16 {
    static constexpr bool PERM = true, AFTER_DRAIN = false;
    bf16_t* O; int ldc;
    __device__ __forceinline__ void operator()(const f32x4 (&acc)[2][2][4][2], const Unit& u, int wr, int wc, int fr, int fq) const {
        const int row0 = u.pm * BM + wr * 64 + fr; const int col0 = u.pn * BM + wc * 32 + 8 * fq;
#pragma unroll
        for (int ai = 0; ai < 2; ++ai)
#pragma unroll
            for (int m = 0; m < 4; ++m) { bf16_t* rowp = O + (size_t)(row0 + ai * HALF + m * 16) * ldc + col0;
#pragma unroll
                for (int bj = 0; bj < 2; ++bj) { const f32x4 v0 = acc[ai][bj][m][0], v1 = acc[ai][bj][m][1];
                    u32x4 w; w.x = cvt_pk_bf16(v0[0], v0[1]); w.y = cvt_pk_bf16(v0[2], v0[3]); w.z = cvt_pk_bf16(v1[0], v1[1]); w.w = cvt_pk_bf16(v1[2], v1[3]);
                    *(u32x4*)(rowp + bj * HALF) = w; } }
    }
};
struct EpiBf16Grp {
    static constexpr bool PERM = true, AFTER_DRAIN = false;
    bf16_t* O; int ldc; int ntn;
    __device__ __forceinline__ void operator()(const f32x4 (&acc)[2][2][4][2], const Unit& u, int wr, int wc, int fr, int fq) const {
        const int row0 = u.pm * BM + wr * 64 + fr; const int col0 = (u.pn % ntn) * BM + wc * 32 + 8 * fq;
#pragma unroll
        for (int ai = 0; ai < 2; ++ai)
#pragma unroll
            for (int m = 0; m < 4; ++m) { bf16_t* rowp = O + (size_t)(row0 + ai * HALF + m * 16) * ldc + col0;
#pragma unroll
                for (int bj = 0; bj < 2; ++bj) { const f32x4 v0 = acc[ai][bj][m][0], v1 = acc[ai][bj][m][1];
                    u32x4 w; w.x = cvt_pk_bf16(v0[0], v0[1]); w.y = cvt_pk_bf16(v0[2], v0[3]); w.z = cvt_pk_bf16(v1[0], v1[1]); w.w = cvt_pk_bf16(v1[2], v1[3]);
                    *(u32x4*)(rowp + bj * HALF) = w; } }
    }
};
struct EpiGateA {
    static constexpr bool PERM = true, AFTER_DRAIN = false;
    float* T; int ldc; const bf16_t* G; int ldg;
    __device__ __forceinline__ void operator()(const f32x4 (&acc)[2][2][4][2], const Unit& u, int wr, int wc, int fr, int fq) const {
        const int row0 = u.pm * BM + wr * 64 + fr; const int col0 = u.pn * BM + wc * 32 + 8 * fq;
#pragma unroll
        for (int ai = 0; ai < 2; ++ai)
#pragma unroll
            for (int m = 0; m < 4; ++m) { const size_t r = (size_t)(row0 + ai * HALF + m * 16);
#pragma unroll
                for (int bj = 0; bj < 2; ++bj) { const u32x4 gw = *(const u32x4*)(G + r * ldg + col0 + bj * HALF);
                    const f32x4 v0 = acc[ai][bj][m][0], v1 = acc[ai][bj][m][1];
                    f32x4 o0, o1;
                    o0[0] = sigmoidf_(bf_lo(gw.x)) * v0[0]; o0[1] = sigmoidf_(bf_hi(gw.x)) * v0[1]; o0[2] = sigmoidf_(bf_lo(gw.y)) * v0[2]; o0[3] = sigmoidf_(bf_hi(gw.y)) * v0[3];
                    o1[0] = sigmoidf_(bf_lo(gw.z)) * v1[0]; o1[1] = sigmoidf_(bf_hi(gw.z)) * v1[1]; o1[2] = sigmoidf_(bf_lo(gw.w)) * v1[2]; o1[3] = sigmoidf_(bf_hi(gw.w)) * v1[3];
                    float* tp = T + r * ldc + col0 + bj * HALF; *(f32x4*)tp = o0; *(f32x4*)(tp + 4) = o1; } }
    }
};
struct EpiGateB {
    static constexpr bool PERM = true, AFTER_DRAIN = false;
    bf16_t* O; const float* T; int ldc; const bf16_t* G; int ldg;
    __device__ __forceinline__ void operator()(const f32x4 (&acc)[2][2][4][2], const Unit& u, int wr, int wc, int fr, int fq) const {
        const int row0 = u.pm * BM + wr * 64 + fr; const int col0 = u.pn * BM + wc * 32 + 8 * fq;
#pragma unroll
        for (int ai = 0; ai < 2; ++ai)
#pragma unroll
            for (int m = 0; m < 4; ++m) { const size_t r = (size_t)(row0 + ai * HALF + m * 16);
#pragma unroll
                for (int bj = 0; bj < 2; ++bj) { const u32x4 gw = *(const u32x4*)(G + r * ldg + col0 + bj * HALF);
                    const float* tp = T + r * ldc + col0 + bj * HALF; const f32x4 t0 = *(const f32x4*)tp, t1 = *(const f32x4*)(tp + 4);
                    const f32x4 v0 = acc[ai][bj][m][0], v1 = acc[ai][bj][m][1];
                    f32x4 o0, o1;
                    o0[0] = t0[0] + sigmoidf_(bf_lo(gw.x)) * v0[0]; o0[1] = t0[1] + sigmoidf_(bf_hi(gw.x)) * v0[1]; o0[2] = t0[2] + sigmoidf_(bf_lo(gw.y)) * v0[2]; o0[3] = t0[3] + sigmoidf_(bf_hi(gw.y)) * v0[3];
                    o1[0] = t1[0] + sigmoidf_(bf_lo(gw.z)) * v1[0]; o1[1] = t1[1] + sigmoidf_(bf_hi(gw.z)) * v1[1]; o1[2] = t1[2] + sigmoidf_(bf_lo(gw.w)) * v1[2]; o1[3] = t1[3] + sigmoidf_(bf_hi(gw.w)) * v1[3];
                    u32x4 w; w.x = cvt_pk_bf16(o0[0], o0[1]); w.y = cvt_pk_bf16(o0[2], o0[3]); w.z = cvt_pk_bf16(o1[0], o1[1]); w.w = cvt_pk_bf16(o1[2], o1[3]);
                    *(u32x4*)(O + r * ldc + col0 + bj * HALF) = w; } }
    }
};
struct EpiResid {
    static constexpr bool PERM = false, AFTER_DRAIN = false;
    float* P; int ldc; const float* X; const float* stats; const float* g; const float* b; float alpha;
    __device__ __forceinline__ void operator()(const f32x4 (&acc)[2][2][4][2], const Unit& u, int wr, int wc, int fr, int fq) const {
        const int row0 = u.pm * BM + wr * 64 + fr, col0 = u.pn * BM + wc * 32 + 4 * fq;
        f32x4 gv[2][2], bv[2][2];
#pragma unroll
        for (int bj = 0; bj < 2; ++bj)
#pragma unroll
            for (int n = 0; n < 2; ++n) { gv[bj][n] = *(const f32x4*)(g + col0 + bj * HALF + n * 16); bv[bj][n] = *(const f32x4*)(b + col0 + bj * HALF + n * 16); }
#pragma unroll
        for (int ai = 0; ai < 2; ++ai)
#pragma unroll
            for (int m = 0; m < 4; ++m) { const size_t r = (size_t)(row0 + ai * HALF + m * 16); const float mu = stats[2 * r], rs = stats[2 * r + 1];
#pragma unroll
                for (int bj = 0; bj < 2; ++bj)
#pragma unroll
                    for (int n = 0; n < 2; ++n) { const size_t off = r * ldc + col0 + bj * HALF + n * 16; const f32x4 xv = *(const f32x4*)(X + off);
                        *(f32x4*)(P + off) = ((xv - mu) * rs * gv[bj][n] + bv[bj][n]) * alpha + acc[ai][bj][m][n]; } }
    }
};
struct EpiSwiGlu {
    static constexpr bool PERM = true, AFTER_DRAIN = false;
    bf16_t* O; int ldc; int ntn;
    __device__ __forceinline__ void operator()(const f32x4 (&acc)[2][2][4][2], const Unit& u, int wr, int wc, int fr, int fq) const {
        const int row0 = u.pm * BM + wr * 64 + fr; const int col0 = (u.pn % ntn) * HALF + wc * 32 + 8 * fq;
#pragma unroll
        for (int ai = 0; ai < 2; ++ai)
#pragma unroll
            for (int m = 0; m < 4; ++m) { bf16_t* rowp = O + (size_t)(row0 + ai * HALF + m * 16) * ldc + col0;
                float o[8];
#pragma unroll
                for (int n = 0; n < 2; ++n)
#pragma unroll
                    for (int j = 0; j < 4; ++j) { const float gt = acc[ai][0][m][n][j], up = acc[ai][1][m][n][j]; o[4 * n + j] = gt * sigmoidf_(gt) * up; }
                u32x4 w; w.x = cvt_pk_bf16(o[0], o[1]); w.y = cvt_pk_bf16(o[2], o[3]); w.z = cvt_pk_bf16(o[4], o[5]); w.w = cvt_pk_bf16(o[6], o[7]);
                *(u32x4*)rowp = w; }
    }
};

template <class Epi, class Sched, bool ALIGN_EPI = false, bool SP2 = false>
__device__ __forceinline__ void gemm_phase(PG8_LAS unsigned char* lds, const Gemm g, const Sched& S, const Epi& E) {
    const int tid = threadIdx.x, wid = __builtin_amdgcn_readfirstlane(tid >> 6), lane = tid & 63, wr = wid >> 2, wc = wid & 3, fr = lane & 15, fq = lane >> 4;
    const int K = g.K, nt = K / BK;
    int Rs[2], Cs[2]; unsigned voffB[2];
#pragma unroll
    for (int i = 0; i < 2; ++i) { int R, C; stage_rc(tid * 16 + i * 8192, R, C); const int Rb = Epi::PERM ? ((R & ~31) + perm32(R & 31)) : R;
        Rs[i] = R; Cs[i] = C; voffB[i] = (unsigned)(Rb * K + C) * 2u; }
    const size_t kstep = (size_t)(BK * 2);
    const size_t hstep = (size_t)HALF * K * 2;
    const size_t tstep = 2 * hstep;
    const unsigned ldsw = (unsigned)wid * 1024u;
    const int aoff = lds_byte(wr * 64 + fr, fq * 8), boff = lds_byte(wc * 32 + fr, fq * 8);
#define PG8_SA(b, h) (((b) * 2 + (h)) * HTB)
#define PG8_SB(b, h) ((4 + (b) * 2 + (h)) * HTB)
#define PG8_STAGE(bufoff, gbase, voff) do { _Pragma("unroll") for (int _i = 0; _i < 2; ++_i) \
        __builtin_amdgcn_global_load_lds((const unsigned*)((const char*)(gbase) + (voff)[_i]), (PG8_LAS unsigned*)(lds + (bufoff) + ldsw + _i * 8192), 16, 0, 0); } while (0)
#define PG8_LDA(dst, b, h) do { _Pragma("unroll") for (int m = 0; m < 4; ++m) _Pragma("unroll") for (int k = 0; k < 2; ++k) dst[m][k] = *(const PG8_LAS bf16x8*)(lds + PG8_SA(b, h) + aoff + m * 2048 + k * 1024); } while (0)
#define PG8_LDB(dst, b, h) do { _Pragma("unroll") for (int n = 0; n < 2; ++n) _Pragma("unroll") for (int k = 0; k < 2; ++k) dst[n][k] = *(const PG8_LAS bf16x8*)(lds + PG8_SB(b, h) + boff + n * 2048 + k * 1024); } while (0)
#define PG8_MMA(ai, bj, At, Bt) do { __builtin_amdgcn_s_setprio(1); _Pragma("unroll") for (int m = 0; m < 4; ++m) _Pragma("unroll") for (int n = 0; n < 2; ++n) _Pragma("unroll") for (int k = 0; k < 2; ++k) \
        acc[ai][bj][m][n] = __builtin_amdgcn_mfma_f32_16x16x32_bf16(Bt[n][k], At[m][k], acc[ai][bj][m][n], 0, 0, 0); __builtin_amdgcn_s_setprio(0); } while (0)
#define PG8_WAIT_V(n) asm volatile("s_waitcnt vmcnt(" #n ")" ::: "memory")
#define PG8_WAIT_L(n) asm volatile("s_waitcnt lgkmcnt(" #n ")" ::: "memory")
#define PG8_BAR __builtin_amdgcn_s_barrier()
#define PG8_SCHED __builtin_amdgcn_sched_barrier(0)
#define PG8_AOFF(dst, u) do { _Pragma("unroll") for (int _h = 0; _h < 2; ++_h) _Pragma("unroll") for (int _i = 0; _i < 2; ++_i) \
        dst[_h][_i] = ((unsigned)S.arow(u, _h * HALF + Rs[_i]) * (unsigned)K + (unsigned)Cs[_i]) * 2u; } while (0)
    Unit cur, nxt; int ui = 0;
    if (!S.next(0, cur)) return;
    f32x4 acc[2][2][4][2];
#pragma unroll
    for (int a = 0; a < 2; ++a)
#pragma unroll
        for (int b = 0; b < 2; ++b)
#pragma unroll
            for (int m = 0; m < 4; ++m)
#pragma unroll
                for (int n = 0; n < 2; ++n) acc[a][b][m][n] = (f32x4){0.f, 0.f, 0.f, 0.f};
    bf16x8 At[4][2], B0[2][2], B1[2][2];
    unsigned vA[2][2], nvA[2][2];
    PG8_AOFF(vA, cur);
    const char* const cA = (const char*)g.A; const char* cB = (const char*)g.Bt + (size_t)cur.pn * tstep;
    S.a_ready(cur);
    if constexpr (SP2) {
        PG8_STAGE(PG8_SB(0, 0), cB, voffB); PG8_STAGE(PG8_SB(0, 1), cB + hstep, voffB); PG8_STAGE(PG8_SA(0, 0), cA, vA[0]); PG8_STAGE(PG8_SA(0, 1), cA, vA[1]);
        if (wr == 1) PG8_BAR;
        PG8_WAIT_V(2); PG8_BAR;
        PG8_STAGE(PG8_SB(1, 0), cB + kstep, voffB); PG8_STAGE(PG8_SA(1, 0), cA + kstep, vA[0]); PG8_STAGE(PG8_SB(1, 1), cB + hstep + kstep, voffB);
        PG8_WAIT_V(6); PG8_BAR;
    } else {
        PG8_STAGE(PG8_SB(0, 0), cB, voffB); PG8_STAGE(PG8_SA(0, 0), cA, vA[0]); PG8_STAGE(PG8_SB(0, 1), cB + hstep, voffB); PG8_STAGE(PG8_SA(0, 1), cA, vA[1]);
        if (wr == 1) PG8_BAR;
        PG8_WAIT_V(4); PG8_BAR;
        PG8_STAGE(PG8_SB(1, 0), cB + kstep, voffB); PG8_STAGE(PG8_SA(1, 0), cA + kstep, vA[0]); PG8_STAGE(PG8_SB(1, 1), cB + hstep + kstep, voffB);
        PG8_WAIT_V(6); PG8_BAR;
    }
    for (;;) {
        const bool has_next = S.next(ui + 1, nxt);
        const char* nB = has_next ? (const char*)g.Bt + (size_t)nxt.pn * tstep : cB;
        if (has_next) { PG8_AOFF(nvA, nxt); } else {
#pragma unroll
            for (int h = 0; h < 2; ++h)
#pragma unroll
                for (int i = 0; i < 2; ++i) nvA[h][i] = vA[h][i]; }
        for (int t = 0; t < nt; t += 2) {
            const bool last = (t == nt - 2);
            const char* a1 = cA + (size_t)(t + 1) * kstep;
            const char* a2 = last ? cA : cA + (size_t)(t + 2) * kstep; const char* b2 = last ? nB : cB + (size_t)(t + 2) * kstep;
            const char* a3 = a2 + kstep; const char* b3 = b2 + kstep;
            unsigned w0[2], w1[2];
            w0[0] = last ? nvA[0][0] : vA[0][0]; w0[1] = last ? nvA[0][1] : vA[0][1]; w1[0] = last ? nvA[1][0] : vA[1][0]; w1[1] = last ? nvA[1][1] : vA[1][1];
            if (last && has_next) S.a_ready(nxt);
            if constexpr (SP2) {
            PG8_LDB(B0, 0, 0); PG8_LDB(B1, 0, 1); PG8_SCHED; PG8_LDA(At, 0, 0); PG8_STAGE(PG8_SA(1, 1), a1, vA[1]);
            PG8_WAIT_V(8); PG8_WAIT_L(0); PG8_BAR; PG8_MMA(0, 0, At, B0); PG8_MMA(0, 1, At, B1); PG8_BAR; PG8_SCHED;
            PG8_LDA(At, 0, 1); PG8_STAGE(PG8_SB(0, 0), b2, voffB); PG8_STAGE(PG8_SB(0, 1), b2 + hstep, voffB); PG8_STAGE(PG8_SA(0, 0), a2, w0);
            PG8_WAIT_V(8); PG8_WAIT_L(0); PG8_BAR; PG8_MMA(1, 0, At, B0); PG8_MMA(1, 1, At, B1); PG8_BAR; PG8_SCHED;
            PG8_LDB(B0, 1, 0); PG8_LDB(B1, 1, 1); PG8_SCHED; PG8_LDA(At, 1, 0); PG8_STAGE(PG8_SA(0, 1), a2, w1);
            PG8_WAIT_V(8); PG8_WAIT_L(0); PG8_BAR; PG8_MMA(0, 0, At, B0); PG8_MMA(0, 1, At, B1); PG8_BAR; PG8_SCHED;
            PG8_LDA(At, 1, 1); PG8_STAGE(PG8_SB(1, 0), b3, voffB); PG8_STAGE(PG8_SB(1, 1), b3 + hstep, voffB); PG8_STAGE(PG8_SA(1, 0), a3, w0);
            PG8_WAIT_V(8); PG8_WAIT_L(0); PG8_BAR; PG8_MMA(1, 0, At, B0); PG8_MMA(1, 1, At, B1); PG8_BAR; PG8_SCHED;
            } else {
            PG8_LDB(B0, 0, 0); PG8_SCHED; PG8_LDA(At, 0, 0); PG8_STAGE(PG8_SA(1, 1), a1, vA[1]);
            PG8_WAIT_L(8); PG8_BAR; PG8_WAIT_L(0); PG8_MMA(0, 0, At, B0); PG8_BAR; PG8_SCHED;
            PG8_LDB(B1, 0, 1); PG8_STAGE(PG8_SB(0, 0), b2, voffB);
            PG8_BAR; PG8_WAIT_L(0); PG8_MMA(0, 1, At, B1); PG8_BAR;
            PG8_LDA(At, 0, 1); PG8_STAGE(PG8_SA(0, 0), a2, w0);
            PG8_BAR; PG8_WAIT_L(0); PG8_MMA(1, 0, At, B0); PG8_BAR; PG8_SCHED;
            PG8_STAGE(PG8_SB(0, 1), b2 + hstep, voffB);
            PG8_WAIT_V(6); PG8_BAR; PG8_MMA(1, 1, At, B1); PG8_BAR;
            PG8_LDB(B0, 1, 0); PG8_SCHED; PG8_LDA(At, 1, 0); PG8_STAGE(PG8_SA(0, 1), a2, w1);
            PG8_WAIT_L(8); PG8_BAR; PG8_WAIT_L(0); PG8_MMA(0, 0, At, B0); PG8_BAR; PG8_SCHED;
            PG8_LDB(B1, 1, 1); PG8_STAGE(PG8_SB(1, 0), b3, voffB);
            PG8_BAR; PG8_WAIT_L(0); PG8_MMA(0, 1, At, B1); PG8_BAR;
            PG8_LDA(At, 1, 1); PG8_STAGE(PG8_SA(1, 0), a3, w0);
            PG8_BAR; PG8_WAIT_L(0); PG8_MMA(1, 0, At, B0); PG8_BAR; PG8_SCHED;
            PG8_STAGE(PG8_SB(1, 1), b3 + hstep, voffB);
            PG8_WAIT_V(6); PG8_BAR; PG8_MMA(1, 1, At, B1); PG8_BAR;
            }
        }
        if constexpr (ALIGN_EPI) { if (wr == 0) PG8_BAR; }
        E(acc, cur, wr, wc, fr, fq); S.done(cur);
        if (!has_next) break;
#pragma unroll
        for (int a = 0; a < 2; ++a)
#pragma unroll
            for (int b = 0; b < 2; ++b)
#pragma unroll
                for (int m = 0; m < 4; ++m)
#pragma unroll
                    for (int n = 0; n < 2; ++n) acc[a][b][m][n] = (f32x4){0.f, 0.f, 0.f, 0.f};
        cur = nxt; cB = nB; ++ui;
#pragma unroll
        for (int h = 0; h < 2; ++h)
#pragma unroll
            for (int i = 0; i < 2; ++i) vA[h][i] = nvA[h][i];
        if constexpr (ALIGN_EPI) { if (wr == 1) PG8_BAR; }
    }
    PG8_WAIT_V(0);
    if constexpr (!ALIGN_EPI) { if (wr == 0) PG8_BAR; }
    PG8_BAR;
#undef PG8_SA
#undef PG8_SB
#undef PG8_STAGE
#undef PG8_LDA
#undef PG8_LDB
#undef PG8_MMA
#undef PG8_WAIT_V
#undef PG8_WAIT_L
#undef PG8_BAR
#undef PG8_SCHED
#undef PG8_AOFF
}
}
#define GAS __attribute__((address_space(1)))
#define LAS __attribute__((address_space(3)))
typedef unsigned short bf16;
typedef unsigned v4u __attribute__((ext_vector_type(4)));
typedef float f32x4 __attribute__((ext_vector_type(4)));
typedef short bf16x8 __attribute__((ext_vector_type(8)));
typedef GAS unsigned gu32;
typedef GAS unsigned long long gu64;
#define RLX_AGENT __ATOMIC_RELAXED, __HIP_MEMORY_SCOPE_AGENT
#define LDS_WAIT() asm volatile("s_waitcnt lgkmcnt(0)" ::: "memory")
#define VM_WAIT() asm volatile("s_waitcnt vmcnt(0)" ::: "memory")
__device__ __forceinline__ unsigned long long rt() { return __builtin_amdgcn_s_memrealtime(); }
__device__ __forceinline__ unsigned f2bf(float f) { unsigned u = __builtin_bit_cast(unsigned, f); return (u + 0x7fffu + ((u >> 16) & 1u)) >> 16; }
__device__ __forceinline__ unsigned pk2(float lo, float hi) { return f2bf(lo) | (f2bf(hi) << 16); }

#define XB_TMO      128
#define XB_XCNT(j)  (256  + 64 * (j))
#define XB_XSUB(j)  (1280 + 64 * (j))
#define XB_XGEN(j)  (2304 + 64 * (j))
#define XB_TOP      3328
#define XB_TOPGEN   3392
#define XCD_BAR_WORDS 3456
#define XB_SPIN_CAP (1u << 22)

__device__ __forceinline__ unsigned xb_ld(unsigned* p)              { return __hip_atomic_load(p, __ATOMIC_RELAXED, __HIP_MEMORY_SCOPE_AGENT); }
__device__ __forceinline__ unsigned xb_add(unsigned* p, unsigned v) { return __hip_atomic_fetch_add(p, v, __ATOMIC_RELAXED, __HIP_MEMORY_SCOPE_AGENT); }
__device__ __forceinline__ unsigned xb_xcc_id() { return (unsigned)__builtin_amdgcn_s_getreg((3 << 11) | 20) & 0xFu; }
#define XB_SPIN(cond, bar) do { unsigned _sp = 0; while (cond) { __builtin_amdgcn_s_sleep(1); \
    if ((++_sp & 255u) == 0u) { if (xb_ld(&(bar)[XB_TMO])) break; if (_sp > XB_SPIN_CAP) { atomicAdd(&(bar)[XB_TMO], 1u); break; } } } } while (0)

struct XcdBarrier {
    unsigned* bar; unsigned x;
    volatile LAS unsigned* st;
};

__device__ __forceinline__ XcdBarrier xcd_barrier_post(unsigned* bar, volatile LAS unsigned* st) {
    XcdBarrier b; b.bar = bar; b.x = xb_xcc_id(); b.st = st;
    if (threadIdx.x == 0) (void)xb_add(&bar[XB_XCNT(b.x)], 1u);
    return b;
}
__device__ __forceinline__ void xcd_barrier_complete(unsigned* bar, unsigned x, unsigned& nloc, unsigned& nx) {
    const unsigned G = gridDim.x * gridDim.y * gridDim.z;
    unsigned sum, cnt, mine, sp = 0u;
    for (;;) {
        sum = 0u; cnt = 0u; mine = 0u;
#pragma unroll
        for (unsigned j = 0; j < 16; ++j) { const unsigned c = xb_ld(&bar[XB_XCNT(j)]); sum += c; cnt += (c > 0u) ? 1u : 0u; mine = (j == x) ? c : mine; }
        if (sum == G) break;
        __builtin_amdgcn_s_sleep(1);
        if ((++sp & 255u) == 0u) { if (xb_ld(&bar[XB_TMO])) break; if (sp > XB_SPIN_CAP) { atomicAdd(&bar[XB_TMO], 1u); break; } }
    }
    nloc = mine > 0u ? mine : 1u; nx = cnt > 0u ? cnt : 1u;
}

__device__ __forceinline__ void xcd_barrier(const XcdBarrier& b) {
    asm volatile("s_waitcnt vmcnt(0)" ::: "memory");
    __syncthreads();
    if (threadIdx.x == 0) {
        unsigned* bar = b.bar;
        __builtin_amdgcn_s_waitcnt(0);
        unsigned nloc = b.st[0], nx = b.st[1];
        if (nloc == 0u) { xcd_barrier_complete(bar, b.x, nloc, nx); b.st[0] = nloc; b.st[1] = nx; }
        const unsigned old = xb_add(&bar[XB_XSUB(b.x)], 1u);
        const unsigned gen = old / nloc;
        if (old + 1u == (gen + 1u) * nloc) {
            __builtin_amdgcn_fence(__ATOMIC_RELEASE, "agent");
            asm volatile("s_waitcnt vmcnt(0)" ::: "memory");
            const unsigned og = xb_add(&bar[XB_TOP], 1u);
            const unsigned tg = og / nx;
            if (og + 1u == (tg + 1u) * nx) xb_add(&bar[XB_TOPGEN], 1u);
            else XB_SPIN(xb_ld(&bar[XB_TOPGEN]) == tg, bar);
            __builtin_amdgcn_fence(__ATOMIC_ACQUIRE, "agent");
            xb_add(&bar[XB_XGEN(b.x)], 1u);
            asm volatile("s_waitcnt vmcnt(0)" ::: "memory");
        } else {
            XB_SPIN(xb_ld(&bar[XB_XGEN(b.x)]) == gen, bar);
            __builtin_amdgcn_fence(__ATOMIC_ACQUIRE, "agent");
            asm volatile("s_waitcnt vmcnt(0)" ::: "memory");
        }
    }
    __syncthreads();
}

constexpr int NWAVES = 8;
constexpr int BATCH = 2, SEQ = 4096, M = BATCH * SEQ, D = 2048;
constexpr int NPW = 11784;
constexpr int NP = 11776;
constexpr int C_AQ = 0, C_AK = 1536, C_AV = 3072, C_MQK = 4608, C_MV = 5632, C_MO = 6656, C_GATE = 7680;
constexpr int NE = 32, DFF = 1408, ECAP = 8192, MAXT = 96, NT1 = DFF / 128  , NT2 = D / 256  ;
constexpr float LN_EPS = 1e-5f, ALPHA = 1.189207115002721f, QSCALE = 0.08838834764831845f;
constexpr size_t MiB = 1u << 20;
constexpr size_t WS_CTL = 0, CTL_ZERO_BYTES = 1 * MiB;
constexpr size_t WS_WIN = 2 * MiB, WS_WPA = 48 * MiB, WS_WPM = 50 * MiB, WS_WOUT = 54 * MiB, WS_WGU = 62 * MiB, WS_WD = 414 * MiB;
constexpr size_t WS_HB = 590 * MiB, WS_STATS = 622 * MiB, WS_MIF = 622 * MiB + 512 * 1024, WS_PROJ = 623 * MiB;
constexpr size_t WS_ATTO = 807 * MiB, WS_LSE = 831 * MiB, WS_ATT = 832 * MiB, WS_QKC = 840 * MiB, WS_NUM = 856 * MiB, WS_DEN = 888 * MiB, WS_MT = 888 * MiB + 512 * 1024;
constexpr size_t WS_HM = 889 * MiB, WS_TMP = 905 * MiB, WS_MERGED = 969 * MiB, WS_H1 = 1001 * MiB, WS_H1B = 1065 * MiB, WS_TOKLIST = 1097 * MiB, WS_TOKINFO = 1098 * MiB;
constexpr size_t WS_ACT = WS_PROJ, WS_YS = 689 * MiB;
constexpr size_t WS_KVT = 1099 * MiB, WS_CPREV = 1163 * MiB, WS_MSC = 1195 * MiB;
constexpr size_t WS_END = 1200 * MiB;
static_assert(WS_WIN + (size_t)NP * D * 2 <= WS_WPA && WS_WGU + (size_t)NE * 2 * DFF * D * 2 <= WS_WD && WS_WD + (size_t)NE * D * DFF * 2 <= WS_HB, "weights map");
static_assert(WS_PROJ + (size_t)M * NP * 2 <= WS_ATTO && WS_ACT + (size_t)MAXT * 256 * DFF * 2 <= WS_YS && WS_YS + (size_t)MAXT * 256 * D * 2 <= WS_ATTO, "activation map");
constexpr int CW_TMO = 0, CW_CODE = 1, CW_BAR = 4096, CW_CNT = 65536;
constexpr int RING_OFF = 0, RING_BYTES = 131072, LDSCTL_OFF = RING_BYTES, MISC_OFF = LDSCTL_OFF + 320, TS_OFF = LDSCTL_OFF + 512, CNT_OFF = LDSCTL_OFF + 768, GATE_OFF = LDSCTL_OFF + 1024;
constexpr int LDS_BYTES = 147456;

struct Frame { LAS unsigned char* lds; gu32* ctl; int tid, lane, wave, vcu, G; unsigned char* ws; };

__device__ __forceinline__ float wave_sum(float v) {
#pragma unroll
    for (int o = 1; o < 64; o <<= 1) v += __shfl_xor(v, o);
    return v;
}
__device__ __forceinline__ float wave_max(float v) {
#pragma unroll
    for (int o = 1; o < 64; o <<= 1) v = fmaxf(v, __shfl_xor(v, o));
    return v;
}
__device__ __forceinline__ float bflo(unsigned w) { return __uint_as_float(w << 16); }
__device__ __forceinline__ float bfhi(unsigned w) { return __uint_as_float(w & 0xffff0000u); }
__device__ __forceinline__ float sigm(float x) { return 1.0f / (1.0f + __expf(-x)); }

__device__ __forceinline__ void tr_item(const float* W, int ldw, int k0, int c0, bf16* WT, size_t drow0, int Kd, LAS float* scr, int lane) {
#pragma unroll 8
    for (int i = 0; i < 32; ++i) { const int kk = 2 * i + (lane >> 5); scr[kk * 33 + (lane & 31)] = W[(size_t)(k0 + kk) * ldw + c0 + (lane & 31)]; }
    LDS_WAIT(); asm volatile("" ::: "memory");
    const int c = lane & 7;
#pragma unroll
    for (int j = 0; j < 4; ++j) { const int n = (lane >> 3) + 8 * j; const LAS float* s = scr + (8 * c) * 33 + n;
        v4u o; o.x = pk2(s[0 * 33], s[1 * 33]); o.y = pk2(s[2 * 33], s[3 * 33]); o.z = pk2(s[4 * 33], s[5 * 33]); o.w = pk2(s[6 * 33], s[7 * 33]);
        *(GAS v4u*)(WT + (drow0 + n) * Kd + k0 + 8 * c) = o; }
    LDS_WAIT(); asm volatile("" ::: "memory");
}
constexpr int I_WINA = 32 * 240, I_WINB = 32 * 128, I_WPA = 8 * 64, I_WPM = 16 * 64, I_WOUT = 32 * 64, I_EXP = NE * 32 * 44, I_DN = NE * 22 * 64;
constexpr int I_TOTAL = I_WINA + I_WINB + I_WPA + I_WPM + I_WOUT + 2 * I_EXP + I_DN;

__device__ __forceinline__ void p0_prologue(Frame& F, const float* x, const float* lng, const float* lnb, const float* w_in, const float* if_bias, const float* wpa, const float* wpm, const float* wout,
                                            const float* wgate, const float* wup, const float* wdown) {
    unsigned char* ws = F.ws;
    LAS float* scr = (LAS float*)(F.lds + RING_OFF + F.wave * 16384);
    const int gw = F.vcu * NWAVES + F.wave, NGW = F.G * NWAVES;
    for (int it0 = gw; it0 < I_TOTAL; it0 += NGW) {
        int it = it0;
        if (it < I_WINA) { const int kb = it / 240, nb = it % 240; tr_item(w_in, NPW, 64 * kb, 32 * nb, (bf16*)(ws + WS_WIN), (size_t)32 * nb, D, scr, F.lane); continue; } it -= I_WINA;
        if (it < I_WINB) { const int kb = it / 128, nb = it % 128; tr_item(w_in, NPW, 64 * kb, 7688 + 32 * nb, (bf16*)(ws + WS_WIN), (size_t)7680 + 32 * nb, D, scr, F.lane); continue; } it -= I_WINB;
        if (it < I_WPA) { const int kb = it / 64, nb = it % 64; tr_item(wpa, D, 64 * kb, 32 * nb, (bf16*)(ws + WS_WPA), (size_t)32 * nb, 512, scr, F.lane); continue; } it -= I_WPA;
        if (it < I_WPM) { const int kb = it / 64, nb = it % 64; tr_item(wpm, D, 64 * kb, 32 * nb, (bf16*)(ws + WS_WPM), (size_t)32 * nb, 1024, scr, F.lane); continue; } it -= I_WPM;
        if (it < I_WOUT) { const int kb = it / 64, nb = it % 64; tr_item(wout, D, 64 * kb, 32 * nb, (bf16*)(ws + WS_WOUT), (size_t)32 * nb, D, scr, F.lane); continue; } it -= I_WOUT;
        if (it < 2 * I_EXP) { const int up = it >= I_EXP ? 1 : 0; if (up) it -= I_EXP; const int e = it / 1408, r = it % 1408, kb = r / 44, nb = r % 44, j0 = 32 * nb;
            const float* src = (up ? wup : wgate) + (size_t)e * D * DFF;
            tr_item(src, DFF, 64 * kb, j0, (bf16*)(ws + WS_WGU), (size_t)e * 2816 + (size_t)(j0 / 128) * 256 + (j0 % 128) + 128 * up, D, scr, F.lane); continue; } it -= 2 * I_EXP;
        { const int e = it / 1408, r = it % 1408, kb = r / 64, nb = r % 64;
            tr_item(wdown + (size_t)e * DFF * D, D, 64 * kb, 32 * nb, (bf16*)(ws + WS_WD), (size_t)e * D + 32 * nb, DFF, scr, F.lane); }
    }
    __syncthreads();
    LAS float* wif = (LAS float*)(F.lds + RING_OFF);
    for (int k = F.tid; k < D; k += NWAVES * 64) { const f32x4 a = *(const f32x4*)(w_in + (size_t)k * NPW + 7680), b = *(const f32x4*)(w_in + (size_t)k * NPW + 7684);
        *(LAS f32x4*)(wif + k * 8) = a; *(LAS f32x4*)(wif + k * 8 + 4) = b; }
    __syncthreads();
    bf16* HB = (bf16*)(ws + WS_HB); float* STATS = (float*)(ws + WS_STATS); float* MIF = (float*)(ws + WS_MIF);
    for (int m = gw; m < M; m += NGW) {
        const f32x4* xr = (const f32x4*)(x + (size_t)m * D) + F.lane;
        f32x4 v[8]; float s = 0.f;
#pragma unroll
        for (int j = 0; j < 8; ++j) { v[j] = xr[64 * j]; s += (v[j][0] + v[j][1]) + (v[j][2] + v[j][3]); }
        const float mean = wave_sum(s) * (1.f / D); float s2 = 0.f;
#pragma unroll
        for (int j = 0; j < 8; ++j) { const f32x4 d = v[j] - mean; s2 += (d[0] * d[0] + d[1] * d[1]) + (d[2] * d[2] + d[3] * d[3]); }
        const float rstd = rsqrtf(wave_sum(s2) * (1.f / D) + LN_EPS);
        float a[8];
#pragma unroll
        for (int i = 0; i < 8; ++i) a[i] = 0.f;
        unsigned long long* o8 = (unsigned long long*)(HB + (size_t)m * D) + F.lane;
#pragma unroll
        for (int j = 0; j < 8; ++j) { const int k0 = 4 * F.lane + 256 * j; const f32x4 g4 = *(const f32x4*)(lng + k0), b4 = *(const f32x4*)(lnb + k0);
            const f32x4 hv = (v[j] - mean) * rstd * g4 + b4;
            o8[64 * j] = (unsigned long long)pk2(hv[0], hv[1]) | ((unsigned long long)pk2(hv[2], hv[3]) << 32);
#pragma unroll
            for (int c = 0; c < 4; ++c) { const f32x4 w0 = *(const LAS f32x4*)(wif + (k0 + c) * 8), w1 = *(const LAS f32x4*)(wif + (k0 + c) * 8 + 4);
                a[0] += hv[c] * w0[0]; a[1] += hv[c] * w0[1]; a[2] += hv[c] * w0[2]; a[3] += hv[c] * w0[3]; a[4] += hv[c] * w1[0]; a[5] += hv[c] * w1[1]; a[6] += hv[c] * w1[2]; a[7] += hv[c] * w1[3]; }
            asm volatile("" ::: "memory"); }
#pragma unroll
        for (int i = 0; i < 8; ++i) a[i] = wave_sum(a[i]);
        if (F.lane == 0) { STATS[2 * m] = mean; STATS[2 * m + 1] = rstd;
#pragma unroll
            for (int i = 0; i < 8; ++i) MIF[(size_t)m * 8 + i] = a[i] + if_bias[i]; }
    }
}

__device__ __forceinline__ float alibi_slope(int h) {
    switch (h) { case 0: return 0.70710678118654752f; case 1: return 0.5f; case 2: return 0.35355339059327379f; case 3: return 0.25f; case 4: return 0.17677669529663689f; case 5: return 0.125f;
        case 6: return 0.088388347648318447f; case 7: return 0.0625f; case 8: return 0.03125f; case 9: return 0.015625f; case 10: return 0.0078125f; default: return 0.00390625f; }
}
__device__ __forceinline__ void attn_naive(Frame& F) {
    const bf16* PROJ = (const bf16*)(F.ws + WS_PROJ); bf16* ATTO = (bf16*)(F.ws + WS_ATTO); float* LSE = (float*)(F.ws + WS_LSE);
    LAS float* pbuf = (LAS float*)(F.lds + RING_OFF) + F.wave * 256;
    const int gw = F.vcu * NWAVES + F.wave, NGW = F.G * NWAVES;
    for (int it = gw; it < M * 12; it += NGW) {
        const int h = it / M, m = it % M, t = m % SEQ, g = h >> 2, r = (g == 0) ? 1 : (g == 1 ? 4 : 16);
        const float slope = alibi_slope(h);
        const bf16* qp = PROJ + (size_t)m * NP + C_AQ + h * 128;
        float sc[3];
#pragma unroll
        for (int jj = 0; jj < 3; ++jj) {
            const int j = F.lane + 64 * jj; const bool valid = (j <= 128) && (t - j * r >= 0);
            float dot = 0.f;
            if (valid) { const bf16* kp = PROJ + (size_t)(m - j * r) * NP + C_AK + h * 128;
#pragma unroll 4
                for (int c = 0; c < 16; ++c) { const v4u qv = *(const v4u*)(qp + 8 * c), kv = *(const v4u*)(kp + 8 * c);
                    dot += bflo(qv.x) * bflo(kv.x) + bfhi(qv.x) * bfhi(kv.x) + bflo(qv.y) * bflo(kv.y) + bfhi(qv.y) * bfhi(kv.y) + bflo(qv.z) * bflo(kv.z) + bfhi(qv.z) * bfhi(kv.z) + bflo(qv.w) * bflo(kv.w) + bfhi(qv.w) * bfhi(kv.w); } }
            sc[jj] = valid ? dot * QSCALE - slope * (float)(j * r) : -INFINITY;
        }
        const float mx = wave_max(fmaxf(fmaxf(sc[0], sc[1]), sc[2]));
        float ps = 0.f;
#pragma unroll
        for (int jj = 0; jj < 3; ++jj) { const float p = (sc[jj] == -INFINITY) ? 0.f : __expf(sc[jj] - mx); ps += p; pbuf[F.lane + 64 * jj] = p; }
        const float l = wave_sum(ps);
        LDS_WAIT(); asm volatile("" ::: "memory");
        const int nk = ((t / r) < 128 ? (t / r) : 128) + 1;
        float o0 = 0.f, o1 = 0.f;
        const bf16* vp = PROJ + (size_t)m * NP + C_AV + h * 128 + 2 * F.lane;
        for (int j = 0; j < nk; ++j) { const float p = pbuf[j]; const unsigned w = *(const unsigned*)(vp - (size_t)j * r * NP); o0 += p * bflo(w); o1 += p * bfhi(w); }
        const float il = 1.f / l;
        *(unsigned*)(ATTO + (size_t)m * 1536 + h * 128 + 2 * F.lane) = pk2(o0 * il, o1 * il);
        if (F.lane == 0) LSE[(size_t)m * 12 + h] = mx + __logf(l);
        LDS_WAIT(); asm volatile("" ::: "memory");
    }
}
__device__ __forceinline__ void conv_qk(Frame& F, const float* conv_w, const float* conv_b) {
    const bf16* PROJ = (const bf16*)(F.ws + WS_PROJ); bf16* QKC = (bf16*)(F.ws + WS_QKC);
    const int gt = F.vcu * (NWAVES * 64) + F.tid, NT = F.G * NWAVES * 64;
    for (int idx = gt; idx < M * 128; idx += NT) {
        const int m = idx >> 7, c8 = (idx & 127) * 8, t = m % SEQ;
        float acc[8];
#pragma unroll
        for (int i = 0; i < 8; ++i) acc[i] = conv_b[c8 + i];
#pragma unroll
        for (int j = 0; j < 4; ++j) { const int tt = t - 3 + j; if (tt < 0) continue;
            const v4u w = *(const v4u*)(PROJ + (size_t)(m - 3 + j) * NP + C_MQK + c8);
            const f32x4 c0 = *(const f32x4*)(conv_w + j * 1024 + c8), c1 = *(const f32x4*)(conv_w + j * 1024 + c8 + 4);
            acc[0] += c0[0] * bflo(w.x); acc[1] += c0[1] * bfhi(w.x); acc[2] += c0[2] * bflo(w.y); acc[3] += c0[3] * bfhi(w.y);
            acc[4] += c1[0] * bflo(w.z); acc[5] += c1[1] * bfhi(w.z); acc[6] += c1[2] * bflo(w.w); acc[7] += c1[3] * bfhi(w.w); }
#pragma unroll
        for (int i = 0; i < 8; ++i) acc[i] = acc[i] * sigm(acc[i]);
        v4u o; o.x = pk2(acc[0], acc[1]); o.y = pk2(acc[2], acc[3]); o.z = pk2(acc[4], acc[5]); o.w = pk2(acc[6], acc[7]);
        *(v4u*)(QKC + (size_t)m * 1024 + c8) = o;
    }
}

__device__ __forceinline__ float log_sigmoid(float x) { return fminf(x, 0.f) - log1pf(__expf(-fabsf(x))); }
__device__ __forceinline__ void mlstm_naive(Frame& F, int bh) {
    const int b = bh >> 2, h = bh & 3;
    const bf16* PROJ = (const bf16*)(F.ws + WS_PROJ); const bf16* QKC = (const bf16*)(F.ws + WS_QKC); const float* MIF = (const float*)(F.ws + WS_MIF);
    float* NUM = (float*)(F.ws + WS_NUM); float* DEN = (float*)(F.ws + WS_DEN); float* MT = (float*)(F.ws + WS_MT);
    LAS float* qs = (LAS float*)(F.lds + RING_OFF); LAS float* ks = qs + 64 * 128; LAS bf16* vs = (LAS bf16*)(ks + 64 * 128);
    LAS float* gi = (LAS float*)(F.lds + GATE_OFF); LAS float* gf = gi + 64;
    float C[128];
#pragma unroll
    for (int d = 0; d < 128; ++d) C[d] = 0.f;
    float mst = 0.f;
    for (int c = 0; c < SEQ / 64; ++c) {
        __syncthreads();
        const size_t row0 = (size_t)b * SEQ + (size_t)c * 64;
        for (int idx = F.tid; idx < 64 * 32; idx += NWAVES * 64) { const int s = idx >> 5, c8 = idx & 31;
            const bf16* src = QKC + (row0 + s) * 1024 + (c8 < 16 ? h * 128 + c8 * 8 : 512 + h * 128 + (c8 - 16) * 8);
            const v4u w = *(const v4u*)src; const float sc = c8 < 16 ? QSCALE : 1.f;
            LAS float* dst = (c8 < 16 ? qs + s * 128 + c8 * 8 : ks + s * 128 + (c8 - 16) * 8);
            *(LAS f32x4*)dst = (f32x4){bflo(w.x) * sc, bfhi(w.x) * sc, bflo(w.y) * sc, bfhi(w.y) * sc}; *(LAS f32x4*)(dst + 4) = (f32x4){bflo(w.z) * sc, bfhi(w.z) * sc, bflo(w.w) * sc, bfhi(w.w) * sc};
            *(LAS v4u*)(vs + s * 256 + c8 * 8) = *(const v4u*)(PROJ + (row0 + s) * NP + C_MV + h * 256 + c8 * 8); }
        if (F.tid < 64) { gi[F.tid] = MIF[(row0 + F.tid) * 8 + h]; gf[F.tid] = log_sigmoid(MIF[(row0 + F.tid) * 8 + 4 + h]); }
        __syncthreads();
        if (F.tid <= 256) {
            for (int s = 0; s < 64; ++s) {
                const float lf = gf[s], ip = gi[s];
                const float mn = fmaxf(lf + mst, ip), fg = __expf(lf + mst - mn), ig = __expf(ip - mn); mst = mn;
                const float vv = (F.tid < 256) ? __uint_as_float((unsigned)vs[s * 256 + (F.tid & 255)] << 16) : 1.f;
                const float a = ig * vv; float num = 0.f;
#pragma unroll
                for (int d4 = 0; d4 < 32; ++d4) { const f32x4 kk = *(const LAS f32x4*)(ks + s * 128 + 4 * d4), qq = *(const LAS f32x4*)(qs + s * 128 + 4 * d4);
#pragma unroll
                    for (int e = 0; e < 4; ++e) { C[4 * d4 + e] = fg * C[4 * d4 + e] + a * kk[e]; num += C[4 * d4 + e] * qq[e]; } }
                if (F.tid < 256) NUM[(row0 + s) * 1024 + h * 256 + F.tid] = num; else { DEN[(row0 + s) * 4 + h] = num; MT[(row0 + s) * 4 + h] = mn; }
            }
        }
    }
}
__device__ __forceinline__ void attn_merge(Frame& F, int first_wg) {
    const bf16* ATTO = (const bf16*)(F.ws + WS_ATTO); const float* LSE = (const float*)(F.ws + WS_LSE); bf16* ATT = (bf16*)(F.ws + WS_ATT);
    const int gt = (F.vcu - first_wg) * (NWAVES * 64) + F.tid, NT = (F.G - first_wg) * NWAVES * 64;
    for (int idx = gt; idx < M * 64; idx += NT) {
        const int m = idx >> 6, r = idx & 63, j = r >> 4, d8 = (r & 15) * 8;
        const float l0 = LSE[(size_t)m * 12 + j], l1 = LSE[(size_t)m * 12 + 4 + j], l2 = LSE[(size_t)m * 12 + 8 + j], mx = fmaxf(fmaxf(l0, l1), l2);
        float e0 = __expf(l0 - mx), e1 = __expf(l1 - mx), e2 = __expf(l2 - mx); const float inv = 1.f / (e0 + e1 + e2); e0 *= inv; e1 *= inv; e2 *= inv;
        const v4u a = *(const v4u*)(ATTO + (size_t)m * 1536 + j * 128 + d8), b = *(const v4u*)(ATTO + (size_t)m * 1536 + 512 + j * 128 + d8), c = *(const v4u*)(ATTO + (size_t)m * 1536 + 1024 + j * 128 + d8);
        v4u o;
        o.x = pk2(e0 * bflo(a.x) + e1 * bflo(b.x) + e2 * bflo(c.x), e0 * bfhi(a.x) + e1 * bfhi(b.x) + e2 * bfhi(c.x));
        o.y = pk2(e0 * bflo(a.y) + e1 * bflo(b.y) + e2 * bflo(c.y), e0 * bfhi(a.y) + e1 * bfhi(b.y) + e2 * bfhi(c.y));
        o.z = pk2(e0 * bflo(a.z) + e1 * bflo(b.z) + e2 * bflo(c.z), e0 * bfhi(a.z) + e1 * bfhi(b.z) + e2 * bfhi(c.z));
        o.w = pk2(e0 * bflo(a.w) + e1 * bflo(b.w) + e2 * bflo(c.w), e0 * bfhi(a.w) + e1 * bfhi(b.w) + e2 * bfhi(c.w));
        *(v4u*)(ATT + (size_t)m * 512 + j * 128 + d8) = o;
    }
}
__device__ __forceinline__ void mlstm_post(Frame& F, const float* norm_w) {
    const bf16* PROJ = (const bf16*)(F.ws + WS_PROJ); const float* NUM = (const float*)(F.ws + WS_NUM); const float* DEN = (const float*)(F.ws + WS_DEN); const float* MT = (const float*)(F.ws + WS_MT);
    bf16* HM = (bf16*)(F.ws + WS_HM);
    const int gw = F.vcu * NWAVES + F.wave, NGW = F.G * NWAVES;
    for (int it = gw; it < M * 4; it += NGW) {
        const int m = it >> 2, h = it & 3;
        const f32x4 nv = *(const f32x4*)(NUM + (size_t)m * 1024 + h * 256 + 4 * F.lane);
        const float den = DEN[(size_t)m * 4 + h], mt = MT[(size_t)m * 4 + h];
        const float dn = 1.f / fmaxf(fabsf(den), __expf(-mt));
        const f32x4 hv = nv * dn;
        const float mean = wave_sum((hv[0] + hv[1]) + (hv[2] + hv[3])) * (1.f / 256.f);
        const f32x4 dv = hv - mean;
        const float var = wave_sum((dv[0] * dv[0] + dv[1] * dv[1]) + (dv[2] * dv[2] + dv[3] * dv[3])) * (1.f / 256.f);
        const float rs = rsqrtf(var + LN_EPS);
        const f32x4 nw = *(const f32x4*)(norm_w + h * 256 + 4 * F.lane);
        const unsigned long long ow = *(const unsigned long long*)(PROJ + (size_t)m * NP + C_MO + h * 256 + 4 * F.lane);
        const unsigned w0 = (unsigned)ow, w1 = (unsigned)(ow >> 32);
        const float y0 = dv[0] * rs * nw[0] * sigm(bflo(w0)), y1 = dv[1] * rs * nw[1] * sigm(bfhi(w0)), y2 = dv[2] * rs * nw[2] * sigm(bflo(w1)), y3 = dv[3] * rs * nw[3] * sigm(bfhi(w1));
        *(unsigned long long*)(HM + (size_t)m * 1024 + h * 256 + 4 * F.lane) = (unsigned long long)pk2(y0, y1) | ((unsigned long long)pk2(y2, y3) << 32);
    }
}

typedef short s16x4 __attribute__((ext_vector_type(4)));
__device__ __forceinline__ bf16x8 frag_tr(const LAS unsigned char* img, int pitch, int k0, int n0, int lane) {
    const int i = lane & 15, g = lane >> 4;
    const LAS unsigned char* p = img + (k0 + 8 * g + (i >> 2)) * pitch + (n0 + 4 * (i & 3)) * 2;
    const s16x4 a = __builtin_amdgcn_ds_read_tr16_b64_v4i16((LAS s16x4*)p), b = __builtin_amdgcn_ds_read_tr16_b64_v4i16((LAS s16x4*)(p + 4 * pitch));
    return (bf16x8){a[0], a[1], a[2], a[3], b[0], b[1], b[2], b[3]};
}
__device__ __forceinline__ bf16x8 frag_g(const bf16* base, size_t pitch, int r0, int k0, int lane) { return *(const bf16x8*)(base + (size_t)(r0 + (lane & 15)) * pitch + k0 + 8 * (lane >> 4)); }
__device__ __forceinline__ float scan_add(float v, int lane) {
#pragma unroll
    for (int o = 1; o < 64; o <<= 1) { const float t = __shfl_up(v, o); if (lane >= o) v += t; }
    return v;
}
__device__ __forceinline__ float scan_max(float v, int lane) {
#pragma unroll
    for (int o = 1; o < 64; o <<= 1) { const float t = __shfl_up(v, o); if (lane >= o) v = fmaxf(v, t); }
    return v;
}
constexpr int VIMG_PITCH = 528, KIMG_PITCH = 272, QKIMG_PITCH = 144;
constexpr int L_VIMG = 0, L_KIMG = 33792, L_WK = 51200;
constexpr int L_QKIMG = 33792, L_GS = 43008, L_MX = 43264, L_BS = 43520, L_STAT = 43776;
__device__ __forceinline__ void mlstm_m1(Frame& F) {
    const bf16* PROJ = (const bf16*)(F.ws + WS_PROJ); const bf16* QKC = (const bf16*)(F.ws + WS_QKC); const float* MIF = (const float*)(F.ws + WS_MIF);
    float* KVT = (float*)(F.ws + WS_KVT); float* MLOC = (float*)(F.ws + WS_MSC); float* BLAST = MLOC + 1024; float* NLOC = (float*)(F.ws + WS_MSC + 65536);
    LAS unsigned char* Vimg = F.lds + L_VIMG; LAS unsigned char* Kimg = F.lds + L_KIMG; LAS float* wkL = (LAS float*)(F.lds + L_WK);
    for (int item = F.vcu; item < 512; item += F.G) {
        const int bh = item >> 6, c = item & 63, b = bh >> 2, h = bh & 3; const size_t row0 = (size_t)b * SEQ + (size_t)c * 64;
        __syncthreads();
        if (F.wave == 0) { const float lf = log_sigmoid(MIF[(row0 + F.lane) * 8 + 4 + h]), ip = MIF[(row0 + F.lane) * 8 + h];
            const float bs = scan_add(lf, F.lane), bl = __shfl(bs, 63), wl = bl - bs + ip, ml = wave_max(wl);
            wkL[F.lane] = __expf(wl - ml);
            if (F.lane == 0) { MLOC[item] = ml; BLAST[item] = bl; } }
        for (int idx = F.tid; idx < 2048; idx += NWAVES * 64) { const int s = idx >> 5, c8 = idx & 31;
            *(LAS v4u*)(Vimg + s * VIMG_PITCH + c8 * 16) = *(const v4u*)(PROJ + (row0 + s) * NP + C_MV + h * 256 + c8 * 8); }
        __syncthreads();
        for (int idx = F.tid; idx < 1024; idx += NWAVES * 64) { const int s = idx >> 4, c8 = idx & 15; const float wk = wkL[s];
            const v4u w = *(const v4u*)(QKC + (row0 + s) * 1024 + 512 + h * 128 + c8 * 8); v4u o;
            o.x = pk2(bflo(w.x) * wk, bfhi(w.x) * wk); o.y = pk2(bflo(w.y) * wk, bfhi(w.y) * wk); o.z = pk2(bflo(w.z) * wk, bfhi(w.z) * wk); o.w = pk2(bflo(w.w) * wk, bfhi(w.w) * wk);
            *(LAS v4u*)(Kimg + s * KIMG_PITCH + c8 * 16) = o; }
        __syncthreads();
        if (F.tid < 128) { float a = 0.f;
#pragma unroll 8
            for (int s = 0; s < 64; ++s) a += __uint_as_float((unsigned)(*(const LAS bf16*)(Kimg + s * KIMG_PITCH + F.tid * 2)) << 16);
            NLOC[(size_t)item * 128 + F.tid] = a; }
        f32x4 acc[2][8];
#pragma unroll
        for (int r = 0; r < 2; ++r)
#pragma unroll
            for (int ct = 0; ct < 8; ++ct) acc[r][ct] = (f32x4){0.f, 0.f, 0.f, 0.f};
#pragma unroll
        for (int ks = 0; ks < 2; ++ks) {
            const bf16x8 a0 = frag_tr(Vimg, VIMG_PITCH, 32 * ks, 32 * F.wave, F.lane), a1 = frag_tr(Vimg, VIMG_PITCH, 32 * ks, 32 * F.wave + 16, F.lane);
#pragma unroll
            for (int ct = 0; ct < 8; ++ct) { const bf16x8 bb = frag_tr(Kimg, KIMG_PITCH, 32 * ks, 16 * ct, F.lane);
                acc[0][ct] = __builtin_amdgcn_mfma_f32_16x16x32_bf16(a0, bb, acc[0][ct], 0, 0, 0); acc[1][ct] = __builtin_amdgcn_mfma_f32_16x16x32_bf16(a1, bb, acc[1][ct], 0, 0, 0); } }
        const int i = F.lane & 15, g = F.lane >> 4;
#pragma unroll
        for (int r = 0; r < 2; ++r)
#pragma unroll
            for (int ct = 0; ct < 8; ++ct)
#pragma unroll
                for (int q = 0; q < 4; ++q) KVT[((size_t)item * 256 + 32 * F.wave + 16 * r + 4 * g + q) * 128 + 16 * ct + i] = acc[r][ct][q];
    }
}
__device__ __forceinline__ void mlstm_m2(Frame& F) {
    const float* KVT = (const float*)(F.ws + WS_KVT); bf16* CPREV = (bf16*)(F.ws + WS_CPREV);
    const float* MLOC = (const float*)(F.ws + WS_MSC); const float* BLAST = MLOC + 1024; float* MPREV = (float*)(F.ws + WS_MSC) + 2048;
    const float* NLOC = (const float*)(F.ws + WS_MSC + 65536); float* NPREV = (float*)(F.ws + WS_MSC + 524288);
    const int gt = F.vcu * (NWAVES * 64) + F.tid, NT = F.G * NWAVES * 64;
    for (int p = gt; p < 8 * 256 * 64; p += NT) {
        const int bh = p >> 14, rem = p & 16383, v = rem >> 6, d2 = (rem & 63) * 2;
        float c0 = 0.f, c1 = 0.f, m = 0.f;
#pragma unroll 4
        for (int c = 0; c < 64; ++c) { const int item = bh * 64 + c; const size_t off = ((size_t)item * 256 + v) * 128 + d2;
            *(unsigned*)(CPREV + off) = pk2(c0, c1);
            const float2 kv = *(const float2*)(KVT + off);
            const float ml = MLOC[item], bl = BLAST[item], mn = fmaxf(bl + m, ml), dec = __expf(bl + m - mn), sc = __expf(ml - mn); m = mn;
            c0 = dec * c0 + sc * kv.x; c1 = dec * c1 + sc * kv.y; }
    }
    if (gt < 8 * 128) { const int bh = gt >> 7, d = gt & 127; float n = 0.f, m = 0.f;
        for (int c = 0; c < 64; ++c) { const int item = bh * 64 + c;
            NPREV[(size_t)item * 128 + d] = n; if (d == 0) MPREV[item] = m;
            const float ml = MLOC[item], bl = BLAST[item], mn = fmaxf(bl + m, ml), dec = __expf(bl + m - mn), sc = __expf(ml - mn); m = mn;
            n = dec * n + sc * NLOC[(size_t)item * 128 + d]; } }
}
__device__ __forceinline__ void mlstm_m3(Frame& F, const float* norm_w) {
    const bf16* PROJ = (const bf16*)(F.ws + WS_PROJ); const bf16* QKC = (const bf16*)(F.ws + WS_QKC); const float* MIF = (const float*)(F.ws + WS_MIF);
    const bf16* CPREV = (const bf16*)(F.ws + WS_CPREV); const float* MPREV = (const float*)(F.ws + WS_MSC) + 2048; const float* NPREV = (const float*)(F.ws + WS_MSC + 524288);
    bf16* HM = (bf16*)(F.ws + WS_HM);
    LAS unsigned char* Vimg = F.lds + L_VIMG; LAS unsigned char* QKimg = F.lds + L_QKIMG;
    LAS float* gsL = (LAS float*)(F.lds + L_GS); LAS float* mxL = (LAS float*)(F.lds + L_MX); LAS float* bsL = (LAS float*)(F.lds + L_BS); LAS float* stL = (LAS float*)(F.lds + L_STAT);
    const int i = F.lane & 15, g = F.lane >> 4, rt = F.wave & 3, ch = F.wave >> 2;
    for (int item = F.vcu; item < 512; item += F.G) {
        const int bh = item >> 6, c = item & 63, b = bh >> 2, h = bh & 3; const size_t row0 = (size_t)b * SEQ + (size_t)c * 64;
        __syncthreads();
        const float mprev = MPREV[item];
        if (F.wave == 0) { const float lf = log_sigmoid(MIF[(row0 + F.lane) * 8 + 4 + h]), ip = MIF[(row0 + F.lane) * 8 + h];
            const float bs = scan_add(lf, F.lane), gv = ip - bs, pm = scan_max(gv, F.lane);
            gsL[F.lane] = gv; mxL[F.lane] = fmaxf(mprev, pm); bsL[F.lane] = bs; }
        for (int idx = F.tid; idx < 2048; idx += NWAVES * 64) { const int s = idx >> 5, c8 = idx & 31;
            *(LAS v4u*)(Vimg + s * VIMG_PITCH + c8 * 16) = *(const v4u*)(PROJ + (row0 + s) * NP + C_MV + h * 256 + c8 * 8); }
        bf16x8 qf[4];
#pragma unroll
        for (int ks = 0; ks < 4; ++ks) qf[ks] = frag_g(QKC + h * 128, 1024, (int)row0 + 16 * rt, 32 * ks, F.lane);
        __syncthreads();
#pragma unroll
        for (int cc = 0; cc < 2; ++cc) { const int ct = 2 * ch + cc; f32x4 sv = (f32x4){0.f, 0.f, 0.f, 0.f};
            if (ct <= rt) {
#pragma unroll
                for (int ks = 0; ks < 4; ++ks) { const bf16x8 kf = frag_g(QKC + 512 + h * 128, 1024, (int)row0 + 16 * ct, 32 * ks, F.lane); sv = __builtin_amdgcn_mfma_f32_16x16x32_bf16(qf[ks], kf, sv, 0, 0, 0); } }
            const int sidx = 16 * ct + i; const float gsv = gsL[sidx];
#pragma unroll
            for (int q = 0; q < 4; ++q) { const int l = 16 * rt + 4 * g + q; const float val = (sidx <= l) ? sv[q] * QSCALE * __expf(gsv - mxL[l]) : 0.f;
                *(LAS bf16*)(QKimg + l * QKIMG_PITCH + sidx * 2) = (bf16)f2bf(val); } }
        __syncthreads();
        bf16x8 pf[2];
#pragma unroll
        for (int ks = 0; ks < 2; ++ks) pf[ks] = *(const LAS bf16x8*)(QKimg + (16 * rt + i) * QKIMG_PITCH + (32 * ks + 8 * g) * 2);
        f32x4 accs = (f32x4){0.f, 0.f, 0.f, 0.f}, accn = (f32x4){0.f, 0.f, 0.f, 0.f};
        { const bf16x8 ones = (bf16x8){0x3F80, 0x3F80, 0x3F80, 0x3F80, 0x3F80, 0x3F80, 0x3F80, 0x3F80};
#pragma unroll
          for (int ks = 0; ks < 2; ++ks) accs = __builtin_amdgcn_mfma_f32_16x16x32_bf16(pf[ks], ones, accs, 0, 0, 0);
#pragma unroll
          for (int ks = 0; ks < 4; ++ks) { const float* np = NPREV + (size_t)item * 128 + 32 * ks + 8 * g; const f32x4 n0 = *(const f32x4*)np, n1 = *(const f32x4*)(np + 4);
              union { bf16x8 v; unsigned u[4]; } nf; nf.u[0] = pk2(n0[0], n0[1]); nf.u[1] = pk2(n0[2], n0[3]); nf.u[2] = pk2(n1[0], n1[1]); nf.u[3] = pk2(n1[2], n1[3]);
              accn = __builtin_amdgcn_mfma_f32_16x16x32_bf16(qf[ks], nf.v, accn, 0, 0, 0); } }
        f32x4 a1[8], a2[8];
#pragma unroll
        for (int ct = 0; ct < 8; ++ct) { a1[ct] = (f32x4){0.f, 0.f, 0.f, 0.f}; a2[ct] = (f32x4){0.f, 0.f, 0.f, 0.f}; }
        const bf16* cp = CPREV + (size_t)item * 256 * 128;
#pragma unroll
        for (int ct = 0; ct < 8; ++ct) { const int vcol = 128 * ch + 16 * ct;
#pragma unroll
            for (int ks = 0; ks < 4; ++ks) { const bf16x8 cf = frag_g(cp, 128, vcol, 32 * ks, F.lane); a1[ct] = __builtin_amdgcn_mfma_f32_16x16x32_bf16(qf[ks], cf, a1[ct], 0, 0, 0); }
#pragma unroll
            for (int ks = 0; ks < 2; ++ks) { const bf16x8 vf = frag_tr(Vimg, VIMG_PITCH, 32 * ks, vcol, F.lane); a2[ct] = __builtin_amdgcn_mfma_f32_16x16x32_bf16(pf[ks], vf, a2[ct], 0, 0, 0); } }
        float s1[4], s2[4];
#pragma unroll
        for (int q = 0; q < 4; ++q) { const int l = 16 * rt + 4 * g + q; const float mx = mxL[l], wi = __expf(mprev - mx) * QSCALE, mt = bsL[l] + mx;
            const float den = wi * accn[q] + accs[q], dn = 1.f / fmaxf(fabsf(den), __expf(-mt)); float a = 0.f, bq = 0.f;
#pragma unroll
            for (int ct = 0; ct < 8; ++ct) { const float hv = (wi * a1[ct][q] + a2[ct][q]) * dn; a1[ct][q] = hv; a += hv; bq += hv * hv; }
            a += __shfl_xor(a, 1); a += __shfl_xor(a, 2); a += __shfl_xor(a, 4); a += __shfl_xor(a, 8);
            bq += __shfl_xor(bq, 1); bq += __shfl_xor(bq, 2); bq += __shfl_xor(bq, 4); bq += __shfl_xor(bq, 8);
            s1[q] = a; s2[q] = bq;
            if (i == 0) { stL[(l * 2 + ch) * 2] = a; stL[(l * 2 + ch) * 2 + 1] = bq; } }
        __syncthreads();
#pragma unroll
        for (int q = 0; q < 4; ++q) { const int l = 16 * rt + 4 * g + q; const float sa = stL[(l * 2) * 2] + stL[(l * 2 + 1) * 2], qa = stL[(l * 2) * 2 + 1] + stL[(l * 2 + 1) * 2 + 1];
            const float mean = sa * (1.f / 256.f), var = qa * (1.f / 256.f) - mean * mean, rs = rsqrtf(fmaxf(var, 0.f) + LN_EPS);
            const size_t m = row0 + l;
#pragma unroll
            for (int ct = 0; ct < 8; ++ct) { const int v = 128 * ch + 16 * ct + i;
                const float og = __uint_as_float((unsigned)PROJ[m * NP + C_MO + h * 256 + v] << 16);
                HM[m * 1024 + h * 256 + v] = (bf16)f2bf((a1[ct][q] - mean) * rs * norm_w[h * 256 + v] * sigm(og)); } }
        (void)s1; (void)s2;
    }
}

__device__ __forceinline__ bf16x8 frag_vt(const LAS unsigned char* Vimg, int row0a, int row0b, int dcol0, int lane) {
    const int i = lane & 15, g = lane >> 4, q = i >> 2, gi = (dcol0 >> 2) + (i & 3);
    const int ra = row0a + 4 * g + q, rb = row0b + 4 * g + q;
    const s16x4 a = __builtin_amdgcn_ds_read_tr16_b64_v4i16((LAS s16x4*)(Vimg + ra * 256 + ((gi ^ ((ra & 7) << 2)) << 3)));
    const s16x4 b = __builtin_amdgcn_ds_read_tr16_b64_v4i16((LAS s16x4*)(Vimg + rb * 256 + ((gi ^ ((rb & 7) << 2)) << 3)));
    return (bf16x8){a[0], a[1], a[2], a[3], b[0], b[1], b[2], b[3]};
}
__device__ __forceinline__ void attn_mfma(Frame& F) {
    const bf16* PROJ = (const bf16*)(F.ws + WS_PROJ); bf16* ATTO = (bf16*)(F.ws + WS_ATTO); float* LSE = (float*)(F.ws + WS_LSE);
    LAS unsigned char* Vimg = F.lds + RING_OFF;
    const int i = F.lane & 15, g = F.lane >> 4, w = F.wave;
    for (int it = F.vcu; it < 768; it += F.G) {
        const int grp = it >> 8, r1 = it & 255, b = r1 >> 7, hh = (r1 >> 5) & 3, rest = r1 & 31;
        const int rd = grp == 0 ? 1 : (grp == 1 ? 4 : 16), nb = 32 / rd, p = rest / nb, n = rest % nb, h = grp * 4 + hh;
        const float sl = alibi_slope(h) * (float)rd;
        const size_t tok0 = (size_t)b * SEQ + p;
        __syncthreads();
        for (int idx = F.tid; idx < 4096; idx += NWAVES * 64) { const int ki = idx >> 4, cj = idx & 15, u = (n - 1) * 128 + ki; v4u val = (v4u){0u, 0u, 0u, 0u};
            if (u >= 0) val = *(const v4u*)(PROJ + (tok0 + (size_t)u * rd) * NP + C_AV + h * 128 + cj * 8);
            *(LAS v4u*)(Vimg + ki * 256 + ((cj ^ ((ki & 7) << 1)) << 4)) = val; }
        const int qi = 16 * w + i; const size_t qtok = tok0 + (size_t)(128 * n + qi) * rd;
        bf16x8 qf[4];
#pragma unroll
        for (int ks = 0; ks < 4; ++ks) qf[ks] = *(const bf16x8*)(PROJ + qtok * NP + C_AQ + h * 128 + 32 * ks + 8 * g);
        f32x4 sv[10];
#pragma unroll
        for (int j = 0; j < 9; ++j) { sv[j] = (f32x4){0.f, 0.f, 0.f, 0.f}; int u = (n - 1) * 128 + 16 * (w + j) + i; u = u < 0 ? 0 : u;
            const bf16* kp = PROJ + (tok0 + (size_t)u * rd) * NP + C_AK + h * 128 + 8 * g;
#pragma unroll
            for (int ks = 0; ks < 4; ++ks) { const bf16x8 kf = *(const bf16x8*)(kp + 32 * ks); sv[j] = __builtin_amdgcn_mfma_f32_16x16x32_bf16(kf, qf[ks], sv[j], 0, 0, 0); } }
        sv[9] = (f32x4){0.f, 0.f, 0.f, 0.f};
        float mx = -INFINITY;
#pragma unroll
        for (int j = 0; j < 9; ++j)
#pragma unroll
            for (int q = 0; q < 4; ++q) { const int ki = 16 * (w + j) + 4 * g + q, delta = 128 + qi - ki; const bool valid = delta >= 0 && delta <= 128 && (n > 0 || ki >= 128);
                const float s = valid ? sv[j][q] * QSCALE - sl * (float)delta : -INFINITY; sv[j][q] = s; mx = fmaxf(mx, s); }
        mx = fmaxf(mx, __shfl_xor(mx, 16)); mx = fmaxf(mx, __shfl_xor(mx, 32));
        float l = 0.f;
#pragma unroll
        for (int j = 0; j < 9; ++j)
#pragma unroll
            for (int q = 0; q < 4; ++q) { const float pv = (sv[j][q] == -INFINITY) ? 0.f : __expf(sv[j][q] - mx); sv[j][q] = pv; l += pv; }
        l += __shfl_xor(l, 16); l += __shfl_xor(l, 32);
        bf16x8 pf[5];
#pragma unroll
        for (int st = 0; st < 5; ++st) { union { bf16x8 v; unsigned u[4]; } t; t.u[0] = pk2(sv[2 * st][0], sv[2 * st][1]); t.u[1] = pk2(sv[2 * st][2], sv[2 * st][3]);
            t.u[2] = pk2(sv[2 * st + 1][0], sv[2 * st + 1][1]); t.u[3] = pk2(sv[2 * st + 1][2], sv[2 * st + 1][3]); pf[st] = t.v; }
        __syncthreads();
        f32x4 o[8];
#pragma unroll
        for (int dt = 0; dt < 8; ++dt) o[dt] = (f32x4){0.f, 0.f, 0.f, 0.f};
#pragma unroll
        for (int st = 0; st < 5; ++st) { const int T0 = w + 2 * st, T1 = (T0 + 1) > 15 ? 15 : (T0 + 1);
#pragma unroll
            for (int dt = 0; dt < 8; ++dt) { const bf16x8 vf = frag_vt(Vimg, 16 * T0, 16 * T1, 16 * dt, F.lane); o[dt] = __builtin_amdgcn_mfma_f32_16x16x32_bf16(vf, pf[st], o[dt], 0, 0, 0); } }
        const float il = 1.f / l;
#pragma unroll
        for (int dt = 0; dt < 8; ++dt)
            *(unsigned long long*)(ATTO + qtok * 1536 + h * 128 + 16 * dt + 4 * g) = (unsigned long long)pk2(o[dt][0] * il, o[dt][1] * il) | ((unsigned long long)pk2(o[dt][2] * il, o[dt][3] * il) << 32);
        if (g == 0) LSE[qtok * 12 + h] = mx + __logf(l);
    }
}
__device__ __forceinline__ void ln1_router(Frame& F, const float* g1, const float* b1, const float* wrg, const float* brg, const float* wre, const float* bre) {
    const float* PRE = (const float*)(F.ws + WS_TMP); float* H1 = (float*)(F.ws + WS_H1); bf16* H1B = (bf16*)(F.ws + WS_H1B);
    int* TOKLIST = (int*)(F.ws + WS_TOKLIST); int* TOKINFO = (int*)(F.ws + WS_TOKINFO);
    const int gw = F.vcu * NWAVES + F.wave, NGW = F.G * NWAVES;
    for (int m = gw; m < M; m += NGW) {
        const f32x4* xr = (const f32x4*)(PRE + (size_t)m * D) + F.lane;
        f32x4 v[8]; float s = 0.f;
#pragma unroll
        for (int j = 0; j < 8; ++j) { v[j] = xr[64 * j]; s += (v[j][0] + v[j][1]) + (v[j][2] + v[j][3]); }
        const float mean = wave_sum(s) * (1.f / D); float s2 = 0.f;
#pragma unroll
        for (int j = 0; j < 8; ++j) { const f32x4 d = v[j] - mean; s2 += (d[0] * d[0] + d[1] * d[1]) + (d[2] * d[2] + d[3] * d[3]); }
        const float rstd = rsqrtf(wave_sum(s2) * (1.f / D) + LN_EPS);
        float ae[32], ag[4];
#pragma unroll
        for (int i = 0; i < 32; ++i) ae[i] = 0.f;
#pragma unroll
        for (int i = 0; i < 4; ++i) ag[i] = 0.f;
        f32x4* h1r = (f32x4*)(H1 + (size_t)m * D) + F.lane; unsigned long long* o8 = (unsigned long long*)(H1B + (size_t)m * D) + F.lane;
#pragma unroll
        for (int j = 0; j < 8; ++j) { const int k0 = 4 * F.lane + 256 * j; const f32x4 g4 = *(const f32x4*)(g1 + k0), b4 = *(const f32x4*)(b1 + k0);
            const f32x4 hv = (v[j] - mean) * rstd * g4 + b4;
            h1r[64 * j] = hv; o8[64 * j] = (unsigned long long)pk2(hv[0], hv[1]) | ((unsigned long long)pk2(hv[2], hv[3]) << 32);
#pragma unroll
            for (int c = 0; c < 4; ++c) { const f32x4 wg = *(const f32x4*)(wrg + (size_t)(k0 + c) * 4);
                ag[0] += hv[c] * wg[0]; ag[1] += hv[c] * wg[1]; ag[2] += hv[c] * wg[2]; ag[3] += hv[c] * wg[3];
#pragma unroll
                for (int q = 0; q < 8; ++q) { const f32x4 we = *(const f32x4*)(wre + (size_t)(k0 + c) * 32 + 4 * q);
                    ae[4 * q] += hv[c] * we[0]; ae[4 * q + 1] += hv[c] * we[1]; ae[4 * q + 2] += hv[c] * we[2]; ae[4 * q + 3] += hv[c] * we[3]; } } }
#pragma unroll
        for (int i = 0; i < 4; ++i) ag[i] = wave_sum(ag[i]) + brg[i];
#pragma unroll
        for (int i = 0; i < 32; ++i) ae[i] = wave_sum(ae[i]) + bre[i];
        int grp = 0; float gm = ag[0];
#pragma unroll
        for (int i = 1; i < 4; ++i) if (ag[i] > gm) { gm = ag[i]; grp = i; }
        float gs = 0.f;
#pragma unroll
        for (int i = 0; i < 4; ++i) gs += __expf(ag[i] - gm);
        const float gwt = 1.f / gs;
        float el[8];
#pragma unroll
        for (int i = 0; i < 8; ++i) el[i] = grp == 0 ? ae[i] : (grp == 1 ? ae[8 + i] : (grp == 2 ? ae[16 + i] : ae[24 + i]));
        int i1 = 0; float v1 = el[0];
#pragma unroll
        for (int i = 1; i < 8; ++i) if (el[i] > v1) { v1 = el[i]; i1 = i; }
        int i2 = -1; float v2 = -INFINITY;
#pragma unroll
        for (int i = 0; i < 8; ++i) if (i != i1 && el[i] > v2) { v2 = el[i]; i2 = i; }
        const float ex = __expf(v2 - v1), p1 = 1.f / (1.f + ex), p2 = ex * p1;
        if (F.lane == 0) {
            const int e1 = grp * 8 + i1, e2 = grp * 8 + i2;
            const int pos1 = (int)__hip_atomic_fetch_add(F.ctl + CW_CNT + 16 * e1, 1u, RLX_AGENT), pos2 = (int)__hip_atomic_fetch_add(F.ctl + CW_CNT + 16 * e2, 1u, RLX_AGENT);
            TOKLIST[e1 * ECAP + pos1] = m; TOKLIST[e2 * ECAP + pos2] = m;
            int* ti = TOKINFO + (size_t)m * 8; ti[0] = e1; ti[1] = pos1; ti[2] = e2; ti[3] = pos2; ti[4] = __float_as_int(gwt * p1); ti[5] = __float_as_int(gwt * p2);
        }
    }
}
struct MoeOrder {
    const LAS int* TS; const LAS int* CN; const int* toklist; int NT, G, c, U; bool gather;
    __device__ __forceinline__ void init(const LAS int* ts, const LAS int* cn, const int* tl, int nt, int G_, int c_, bool ga) { TS = ts; CN = cn; toklist = tl; NT = nt; G = G_; c = c_; U = ts[NE] * nt; gather = ga; }
    __device__ __forceinline__ bool next(int i, pg8::Unit& u) const {
        const int x = c & 7, r = c >> 3, W = G >> 3;
        const int lo = (int)(((long)U * x) >> 3), hi = (int)(((long)U * (x + 1)) >> 3);
        const int L = lo + r + i * W; if (L >= hi) return false;
        int e = 0;
#pragma unroll 1
        for (int k = 1; k < NE; ++k) if (L >= TS[k] * NT) e = k;
        const int ne = TS[e + 1] - TS[e], loc = L - TS[e] * NT, n_t = loc / ne, m_t = loc % ne;
        u.pm = TS[e] + m_t; u.pn = e * NT + n_t; u.e = e; u.r0 = m_t * 256; return true;
    }
    __device__ __forceinline__ int arow(const pg8::Unit& u, int r) const {
        if (!gather) return u.pm * 256 + r;
        int idx = u.r0 + r; const int cn = CN[u.e]; idx = idx < cn ? idx : cn - 1;
        return toklist[u.e * ECAP + idx];
    }
    __device__ __forceinline__ void a_ready(const pg8::Unit&) const {}
    __device__ __forceinline__ void done(const pg8::Unit&) const {}
};
__device__ __forceinline__ void moe_tables(Frame& F) {
    LAS int* TS = (LAS int*)(F.lds + TS_OFF); LAS int* CN = (LAS int*)(F.lds + CNT_OFF);
    if (F.tid < NE) CN[F.tid] = (int)__hip_atomic_load(F.ctl + CW_CNT + 16 * F.tid, RLX_AGENT);
    __syncthreads();
    if (F.tid == 0) { int acc = 0; for (int e = 0; e < NE; ++e) { TS[e] = acc; acc += (CN[e] + 255) >> 8; } TS[NE] = acc; }
    __syncthreads();
}
__device__ __forceinline__ void final_ln(Frame& F, const float* g2, const float* b2, float* out) {
    const float* H1 = (const float*)(F.ws + WS_H1); const bf16* YS = (const bf16*)(F.ws + WS_YS); const int* TOKINFO = (const int*)(F.ws + WS_TOKINFO);
    const LAS int* TS = (const LAS int*)(F.lds + TS_OFF);
    const int gw = F.vcu * NWAVES + F.wave, NGW = F.G * NWAVES;
    for (int m = gw; m < M; m += NGW) {
        const int* ti = TOKINFO + (size_t)m * 8;
        const int e1 = ti[0], p1 = ti[1], e2 = ti[2], p2 = ti[3]; const float w1 = __int_as_float(ti[4]), w2 = __int_as_float(ti[5]);
        const size_t sl1 = (size_t)TS[e1] * 256 + p1, sl2 = (size_t)TS[e2] * 256 + p2;
        const f32x4* hr = (const f32x4*)(H1 + (size_t)m * D) + F.lane;
        const unsigned long long* y1 = (const unsigned long long*)(YS + sl1 * D) + F.lane; const unsigned long long* y2 = (const unsigned long long*)(YS + sl2 * D) + F.lane;
        f32x4 v[8]; float s = 0.f;
#pragma unroll
        for (int j = 0; j < 8; ++j) { const f32x4 hv = hr[64 * j]; const unsigned long long a = y1[64 * j], b = y2[64 * j];
            const unsigned a0 = (unsigned)a, a1 = (unsigned)(a >> 32), b0 = (unsigned)b, b1 = (unsigned)(b >> 32);
            f32x4 y; y[0] = w1 * bflo(a0) + w2 * bflo(b0); y[1] = w1 * bfhi(a0) + w2 * bfhi(b0); y[2] = w1 * bflo(a1) + w2 * bflo(b1); y[3] = w1 * bfhi(a1) + w2 * bfhi(b1);
            v[j] = hv * ALPHA + y; s += (v[j][0] + v[j][1]) + (v[j][2] + v[j][3]); }
        const float mean = wave_sum(s) * (1.f / D); float s2 = 0.f;
#pragma unroll
        for (int j = 0; j < 8; ++j) { const f32x4 d = v[j] - mean; s2 += (d[0] * d[0] + d[1] * d[1]) + (d[2] * d[2] + d[3] * d[3]); }
        const float rstd = rsqrtf(wave_sum(s2) * (1.f / D) + LN_EPS);
        f32x4* orow = (f32x4*)(out + (size_t)m * D) + F.lane;
#pragma unroll
        for (int j = 0; j < 8; ++j) { const int k0 = 4 * F.lane + 256 * j; const f32x4 g4 = *(const f32x4*)(g2 + k0), b4 = *(const f32x4*)(b2 + k0);
            orow[64 * j] = (v[j] - mean) * rstd * g4 + b4; }
    }
}

#ifndef SKIPMASK
#define SKIPMASK 0
#endif
#ifndef ATTN_NAIVE
#define ATTN_NAIVE 0
#endif
#ifndef MLSTM_NAIVE
#define MLSTM_NAIVE 0
#endif
#ifndef DUPMASK
#define DUPMASK 0
#endif
constexpr int N_PHASES = 12;
struct Args { const float* in[22]; float* out; unsigned char* ws; int ph_lo, ph_hi, li, pad; };
__global__ void __launch_bounds__(NWAVES * 64, 2) fwd_kernel(Args args) {
    extern __shared__ __attribute__((aligned(16))) unsigned char lds[];
    Frame F;
    F.lds = (LAS unsigned char*)lds;
    F.tid = threadIdx.x; F.lane = F.tid & 63; F.wave = __builtin_amdgcn_readfirstlane(F.tid >> 6);
    F.G = gridDim.x; { const int bx = blockIdx.x; F.vcu = (F.G % 8 == 0) ? (bx % 8) * (F.G / 8) + bx / 8 : bx; }
    F.ws = args.ws; F.ctl = (gu32*)(args.ws + WS_CTL);
    for (int u = F.tid; u < (LDS_BYTES - LDSCTL_OFF) / 4; u += NWAVES * 64) ((LAS unsigned*)(F.lds + LDSCTL_OFF))[u] = 0u;
    __syncthreads();
    XcdBarrier bar = xcd_barrier_post((unsigned*)(F.ctl + CW_BAR) + args.li * XCD_BAR_WORDS, (volatile LAS unsigned*)(F.lds + MISC_OFF) + 8);
    const int lo = args.ph_lo, hi = args.ph_hi;
#define IN(k) (lo <= (k) && (k) < hi && !(SKIPMASK & (1 << (k))))
#define REP(k) for (int rep_ = 0; rep_ < ((DUPMASK >> (k)) & 1) + 1; ++rep_)
#define SEAM(k) do { if (lo <= (k) && (k) + 1 < hi) xcd_barrier(bar); } while (0)
    unsigned char* ws = args.ws;
    if (IN(0)) REP(0) { p0_prologue(F, args.in[0], args.in[1], args.in[2], args.in[3], args.in[6], args.in[8], args.in[9], args.in[10], args.in[17], args.in[18], args.in[19]); __syncthreads(); }
    SEAM(0);
    if (IN(1)) REP(1) { pg8::Gemm g{(const bf16*)(ws + WS_HB), (const bf16*)(ws + WS_WIN), M, NP, D}; pg8::StaticOrder S; S.init(M, NP, F.G, (int)blockIdx.x);
        pg8::EpiBf16 E{(bf16*)(ws + WS_PROJ), NP};
        pg8::gemm_phase<pg8::EpiBf16, pg8::StaticOrder, true, true>(F.lds + RING_OFF, g, S, E); }
    SEAM(1);
#if ATTN_NAIVE
    if (IN(2)) REP(2) { conv_qk(F, args.in[4], args.in[5]); attn_naive(F); }
#else
    if (IN(2)) REP(2) { conv_qk(F, args.in[4], args.in[5]); attn_mfma(F); }
#endif
    SEAM(2);
#if MLSTM_NAIVE
    if (IN(3)) { if (F.vcu < 8) mlstm_naive(F, F.vcu); else attn_merge(F, 8); }
    SEAM(3);
    if (IN(4)) { mlstm_post(F, args.in[7]); }
    SEAM(4);
    SEAM(5);
#else
    if (IN(3)) REP(3) { mlstm_m1(F); attn_merge(F, 0); }
    SEAM(3);
    if (IN(4)) REP(4) { mlstm_m2(F); }
    SEAM(4);
    if (IN(5)) REP(5) { mlstm_m3(F, args.in[7]); }
    SEAM(5);
#endif
    if (IN(6)) REP(6) {
        { pg8::Gemm g{(const bf16*)(ws + WS_ATT), (const bf16*)(ws + WS_WPA), M, D, 512}; pg8::StaticOrder S; S.init(M, D, F.G, (int)blockIdx.x);
          pg8::EpiGateA E{(float*)(ws + WS_TMP), D, (const bf16*)(ws + WS_PROJ) + C_GATE, NP};
          pg8::gemm_phase<pg8::EpiGateA, pg8::StaticOrder, true, true>(F.lds + RING_OFF, g, S, E); }
        { pg8::Gemm g{(const bf16*)(ws + WS_HM), (const bf16*)(ws + WS_WPM), M, D, 1024}; pg8::StaticOrder S; S.init(M, D, F.G, (int)blockIdx.x);
          pg8::EpiGateB E{(bf16*)(ws + WS_MERGED), (const float*)(ws + WS_TMP), D, (const bf16*)(ws + WS_PROJ) + C_GATE + D, NP};
          pg8::gemm_phase<pg8::EpiGateB, pg8::StaticOrder, true, true>(F.lds + RING_OFF, g, S, E); }
    }
    SEAM(6);
    if (IN(7)) REP(7) { pg8::Gemm g{(const bf16*)(ws + WS_MERGED), (const bf16*)(ws + WS_WOUT), M, D, D}; pg8::StaticOrder S; S.init(M, D, F.G, (int)blockIdx.x);
        pg8::EpiResid E{(float*)(ws + WS_TMP), D, args.in[0], (const float*)(ws + WS_STATS), args.in[1], args.in[2], ALPHA};
        pg8::gemm_phase<pg8::EpiResid, pg8::StaticOrder, true, true>(F.lds + RING_OFF, g, S, E); }
    SEAM(7);
    if (IN(8)) { ln1_router(F, args.in[11], args.in[12], args.in[13], args.in[14], args.in[15], args.in[16]); }
    SEAM(8);
    if (IN(9) || IN(10) || IN(11)) moe_tables(F);
    if (IN(9)) REP(9) { pg8::Gemm g{(const bf16*)(ws + WS_H1B), (const bf16*)(ws + WS_WGU), M, NE * 2 * DFF, D};
        MoeOrder S; S.init((const LAS int*)(F.lds + TS_OFF), (const LAS int*)(F.lds + CNT_OFF), (const int*)(ws + WS_TOKLIST), NT1, F.G, (int)blockIdx.x, true);
        pg8::EpiSwiGlu E{(bf16*)(ws + WS_ACT), DFF, NT1};
        pg8::gemm_phase<pg8::EpiSwiGlu, MoeOrder, true, true>(F.lds + RING_OFF, g, S, E); }
    SEAM(9);
    if (IN(10)) REP(10) { pg8::Gemm g{(const bf16*)(ws + WS_ACT), (const bf16*)(ws + WS_WD), MAXT * 256, NE * D, DFF};
        MoeOrder S; S.init((const LAS int*)(F.lds + TS_OFF), (const LAS int*)(F.lds + CNT_OFF), (const int*)(ws + WS_TOKLIST), NT2, F.G, (int)blockIdx.x, false);
        pg8::EpiBf16Grp E{(bf16*)(ws + WS_YS), D, NT2};
        pg8::gemm_phase<pg8::EpiBf16Grp, MoeOrder, true, true>(F.lds + RING_OFF, g, S, E); }
    SEAM(10);
    if (IN(11)) REP(11) { final_ln(F, args.in[20], args.in[21], args.out); }
#undef IN
#undef SEAM
#undef REP
}

#ifndef MK_PER_PHASE
#define MK_PER_PHASE 0
#endif
extern "C" void kernel_launch(void* const* d_in, const int* in_sizes, int n_in, void* d_out, int out_size, void* d_ws, size_t ws_size, hipStream_t stream) {
    static int grid = 0;
    if (grid == 0) {
        if (n_in != 22 || out_size != M * D || ws_size < WS_END) { fprintf(stderr, "kernel_launch: unexpected problem: n_in %d out %d ws %zu\n", n_in, out_size, ws_size); grid = -1; return; }
        int dev = 0, cus = 0, per_cu = 0;
        if (hipGetDevice(&dev) != hipSuccess || hipDeviceGetAttribute(&cus, hipDeviceAttributeMultiprocessorCount, dev) != hipSuccess) { grid = -1; return; }
        if (hipFuncSetAttribute((const void*)fwd_kernel, hipFuncAttributeMaxDynamicSharedMemorySize, LDS_BYTES) != hipSuccess) { fprintf(stderr, "kernel_launch: hipFuncSetAttribute failed\n"); grid = -1; return; }
        if (hipOccupancyMaxActiveBlocksPerMultiprocessor(&per_cu, (const void*)fwd_kernel, NWAVES * 64, LDS_BYTES) != hipSuccess || per_cu < 1)
            fprintf(stderr, "kernel_launch: note: occupancy query reports %d workgroups per CU\n", per_cu);
        (void)hipGetLastError();
        grid = cus - (cus % 8);
        if (grid < 16) grid = 16;
    }
    if (grid < 0) return;
    (void)hipMemsetAsync((char*)d_ws + WS_CTL, 0, CTL_ZERO_BYTES, stream);
    Args a{};
    for (int i = 0; i < 22; ++i) a.in[i] = (const float*)d_in[i];
    a.out = (float*)d_out; a.ws = (unsigned char*)d_ws; a.pad = 0;
#if MK_PER_PHASE
    for (int p = 0; p < N_PHASES; ++p) { a.ph_lo = p; a.ph_hi = p + 1; a.li = p; hipLaunchKernelGGL(fwd_kernel, dim3(grid), dim3(NWAVES * 64), LDS_BYTES, stream, a); }
#else
    a.ph_lo = 0; a.ph_hi = N_PHASES; a.li = 0;
    hipLaunchKernelGGL(fwd_kernel, dim3(grid), dim3(NWAVES * 64), LDS_BYTES, stream, a);
#endif
}
```

```cpp
#include <hip/hip_runtime.h>
#include <cstdio>
#include <cstdint>
namespace pg8 {
#define PG8_LAS __attribute__((address_space(3)))
typedef unsigned short bf16_t;
typedef short bf16x8 __attribute__((ext_vector_type(8)));
typedef float f32x4 __attribute__((ext_vector_type(4)));
typedef unsigned u32x4 __attribute__((ext_vector_type(4)));
constexpr int BM = 256, BK = 64, HALF = 128, HTB = HALF * BK * 2  , STAGE_BYTES = 8 * HTB, NXCD = 8, WGM = 8;

__host__ __device__ __forceinline__ int lds_byte(int r, int c) { const int st = (r >> 4) * 2 + (c >> 5), rr = r & 15, cc = c & 31, ob = rr * 64 + cc * 2; return st * 1024 + (ob ^ (((ob >> 9) & 1) << 5)); }
__host__ __device__ __forceinline__ void stage_rc(int b, int& R, int& C) { const int st = b / 1024, sb = b % 1024, swz = sb ^ (((sb >> 9) & 1) << 5); R = (st >> 1) * 16 + swz / 64; C = (st & 1) * 32 + (swz % 64) / 2; }
__host__ __device__ __forceinline__ int perm32(int rho) { const int n = rho >> 4, i = rho & 15; return 8 * (i >> 2) + 4 * n + (i & 3); }

struct Unit { int pm, pn, e, r0; };
struct Gemm { const bf16_t* A; const bf16_t* Bt; int M, N, K; };

struct StaticOrder {
    int nM, nN, nwg, G, c;
    __host__ __device__ void init(int M, int N, int G_, int c_) { nM = M / BM; nN = N / BM; nwg = nM * nN; G = G_; c = c_; }
    __host__ __device__ bool next(int i, Unit& u) const {
        const long L = (long)i * G + c; if (L >= nwg) return false;
        int wgid = (int)L; { const int q = nwg / NXCD, r = nwg % NXCD, xcd = wgid % NXCD, off = wgid / NXCD; wgid = (xcd < r ? xcd * (q + 1) : r * (q + 1) + (xcd - r) * q) + off; }
        const int nig = WGM * nN, gid = wgid / nig, fm = gid * WGM, gsz = (nM - fm) < WGM ? (nM - fm) : WGM;
        u.pm = fm + ((wgid % nig) % gsz); u.pn = (wgid % nig) / gsz; u.e = 0; u.r0 = 0; return true;
    }
    __device__ __forceinline__ int arow(const Unit& u, int r) const { return u.pm * BM + r; }
    __device__ __forceinline__ void a_ready(const Unit&) const {}
    __device__ __forceinline__ void done(const Unit&) const {}
};

__device__ __forceinline__ unsigned cvt_pk_bf16(float lo, float hi) { unsigned r; asm volatile("v_cvt_pk_bf16_f32 %0, %1, %2" : "=v"(r) : "v"(lo), "v"(hi)); return r; }
__device__ __forceinline__ float bf_lo(unsigned w) { return __uint_as_float(w << 16); }
__device__ __forceinline__ float bf_hi(unsigned w) { return __uint_as_float(w & 0xffff0000u); }
__device__ __forceinline__ float sigmoidf_(float x) { return 1.0f / (1.0f + __expf(-x)); }

struct EpiBf16 {
    static constexpr bool PERM = true, AFTER_DRAIN = false;
    bf16_t* O; int ldc;
    __device__ __forceinline__ void operator()(const f32x4 (&acc)[2][2][4][2], const Unit& u, int wr, int wc, int fr, int fq) const {
        const int row0 = u.pm * BM + wr * 64 + fr; const int col0 = u.pn * BM + wc * 32 + 8 * fq;
#pragma unroll
        for (int ai = 0; ai < 2; ++ai)
#pragma unroll
            for (int m = 0; m < 4; ++m) { bf16_t* rowp = O + (size_t)(row0 + ai * HALF + m * 16) * ldc + col0;
#pragma unroll
                for (int bj = 0; bj < 2; ++bj) { const f32x4 v0 = acc[ai][bj][m][0], v1 = acc[ai][bj][m][1];
                    u32x4 w; w.x = cvt_pk_bf16(v0[0], v0[1]); w.y = cvt_pk_bf16(v0[2], v0[3]); w.z = cvt_pk_bf16(v1[0], v1[1]); w.w = cvt_pk_bf16(v1[2], v1[3]);
                    *(u32x4*)(rowp + bj * HALF) = w; } }
    }
};
struct EpiBf16Grp {
    static constexpr bool PERM = true, AFTER_DRAIN = false;
    bf16_t* O; int ldc; int ntn;
    __device__ __forceinline__ void operator()(const f32x4 (&acc)[2][2][4][2], const Unit& u, int wr, int wc, int fr, int fq) const {
        const int row0 = u.pm * BM + wr * 64 + fr; const int col0 = (u.pn % ntn) * BM + wc * 32 + 8 * fq;
#pragma unroll
        for (int ai = 0; ai < 2; ++ai)
#pragma unroll
            for (int m = 0; m < 4; ++m) { bf16_t* rowp = O + (size_t)(row0 + ai * HALF + m * 16) * ldc + col0;
#pragma unroll
                for (int bj = 0; bj < 2; ++bj) { const f32x4 v0 = acc[ai][bj][m][0], v1 = acc[ai][bj][m][1];
                    u32x4 w; w.x = cvt_pk_bf16(v0[0], v0[1]); w.y = cvt_pk_bf16(v0[2], v0[3]); w.z = cvt_pk_bf16(v1[0], v1[1]); w.w = cvt_pk_bf16(v1[2], v1[3]);
                    *(u32x4*)(rowp + bj * HALF) = w; } }
    }
};
struct EpiGateA {
    static constexpr bool PERM = true, AFTER_DRAIN = false;
    float* T; int ldc; const bf16_t* G; int ldg;
    __device__ __forceinline__ void operator()(const f32x4 (&acc)[2][2][4][2], const Unit& u, int wr, int wc, int fr, int fq) const {
        const int row0 = u.pm * BM + wr * 64 + fr; const int col0 = u.pn * BM + wc * 32 + 8 * fq;
#pragma unroll
        for (int ai = 0; ai < 2; ++ai)
#pragma unroll
            for (int m = 0; m < 4; ++m) { const size_t r = (size_t)(row0 + ai * HALF + m * 16);
#pragma unroll
                for (int bj = 0; bj < 2; ++bj) { const u32x4 gw = *(const u32x4*)(G + r * ldg + col0 + bj * HALF);
                    const f32x4 v0 = acc[ai][bj][m][0], v1 = acc[ai][bj][m][1];
                    f32x4 o0, o1;
                    o0[0] = sigmoidf_(bf_lo(gw.x)) * v0[0]; o0[1] = sigmoidf_(bf_hi(gw.x)) * v0[1]; o0[2] = sigmoidf_(bf_lo(gw.y)) * v0[2]; o0[3] = sigmoidf_(bf_hi(gw.y)) * v0[3];
                    o1[0] = sigmoidf_(bf_lo(gw.z)) * v1[0]; o1[1] = sigmoidf_(bf_hi(gw.z)) * v1[1]; o1[2] = sigmoidf_(bf_lo(gw.w)) * v1[2]; o1[3] = sigmoidf_(bf_hi(gw.w)) * v1[3];
                    float* tp = T + r * ldc + col0 + bj * HALF; *(f32x4*)tp = o0; *(f32x4*)(tp + 4) = o1; } }
    }
};
struct EpiGateB {
    static constexpr bool PERM = true, AFTER_DRAIN = false;
    bf16_t* O; const float* T; int ldc; const bf16_t* G; int ldg;
    __device__ __forceinline__ void operator()(const f32x4 (&acc)[2][2][4][2], const Unit& u, int wr, int wc, int fr, int fq) const {
        const int row0 = u.pm * BM + wr * 64 + fr; const int col0 = u.pn * BM + wc * 32 + 8 * fq;
#pragma unroll
        for (int ai = 0; ai < 2; ++ai)
#pragma unroll
            for (int m = 0; m < 4; ++m) { const size_t r = (size_t)(row0 + ai * HALF + m * 16);
#pragma unroll
                for (int bj = 0; bj < 2; ++bj) { const u32x4 gw = *(const u32x4*)(G + r * ldg + col0 + bj * HALF);
                    const float* tp = T + r * ldc + col0 + bj * HALF; const f32x4 t0 = *(const f32x4*)tp, t1 = *(const f32x4*)(tp + 4);
                    const f32x4 v0 = acc[ai][bj][m][0], v1 = acc[ai][bj][m][1];
                    f32x4 o0, o1;
                    o0[0] = t0[0] + sigmoidf_(bf_lo(gw.x)) * v0[0]; o0[1] = t0[1] + sigmoidf_(bf_hi(gw.x)) * v0[1]; o0[2] = t0[2] + sigmoidf_(bf_lo(gw.y)) * v0[2]; o0[3] = t0[3] + sigmoidf_(bf_hi(gw.y)) * v0[3];
                    o1[0] = t1[0] + sigmoidf_(bf_lo(gw.z)) * v1[0]; o1[1] = t1[1] + sigmoidf_(bf_hi(gw.z)) * v1[1]; o1[2] = t1[2] + sigmoidf_(bf_lo(gw.w)) * v1[2]; o1[3] = t1[3] + sigmoidf_(bf_hi(gw.w)) * v1[3];
                    u32x4 w; w.x = cvt_pk_bf16(o0[0], o0[1]); w.y = cvt_pk_bf16(o0[2], o0[3]); w.z = cvt_pk_bf16(o1[0], o1[1]); w.w = cvt_pk_bf16(o1[2], o1[3]);
                    *(u32x4*)(O + r * ldc + col0 + bj * HALF) = w; } }
    }
};
struct EpiResid {
    static constexpr bool PERM = false, AFTER_DRAIN = false;
    float* P; int ldc; const float* X; const float* stats; const float* g; const float* b; float alpha;
    __device__ __forceinline__ void operator()(const f32x4 (&acc)[2][2][4][2], const Unit& u, int wr, int wc, int fr, int fq) const {
        const int row0 = u.pm * BM + wr * 64 + fr, col0 = u.pn * BM + wc * 32 + 4 * fq;
        f32x4 gv[2][2], bv[2][2];
#pragma unroll
        for (int bj = 0; bj < 2; ++bj)
#pragma unroll
            for (int n = 0; n < 2; ++n) { gv[bj][n] = *(const f32x4*)(g + col0 + bj * HALF + n * 16); bv[bj][n] = *(const f32x4*)(b + col0 + bj * HALF + n * 16); }
#pragma unroll
        for (int ai = 0; ai < 2; ++ai)
#pragma unroll
            for (int m = 0; m < 4; ++m) { const size_t r = (size_t)(row0 + ai * HALF + m * 16); const float mu = stats[2 * r], rs = stats[2 * r + 1];
#pragma unroll
                for (int bj = 0; bj < 2; ++bj)
#pragma unroll
                    for (int n = 0; n < 2; ++n) { const size_t off = r * ldc + col0 + bj * HALF + n * 16; const f32x4 xv = *(const f32x4*)(X + off);
                        *(f32x4*)(P + off) = ((xv - mu) * rs * gv[bj][n] + bv[bj][n]) * alpha + acc[ai][bj][m][n]; } }
    }
};
struct EpiSwiGlu {
    static constexpr bool PERM = true, AFTER_DRAIN = false;
    bf16_t* O; int ldc; int ntn;
    __device__ __forceinline__ void operator()(const f32x4 (&acc)[2][2][4][2], const Unit& u, int wr, int wc, int fr, int fq) const {
        const int row0 = u.pm * BM + wr * 64 + fr; const int col0 = (u.pn % ntn) * HALF + wc * 32 + 8 * fq;
#pragma unroll
        for (int ai = 0; ai < 2; ++ai)
#pragma unroll
            for (int m = 0; m < 4; ++m) { bf16_t* rowp = O + (size_t)(row0 + ai * HALF + m * 16) * ldc + col0;
                float o[8];
#pragma unroll
                for (int n = 0; n < 2; ++n)
#pragma unroll
                    for (int j = 0; j < 4; ++j) { const float gt = acc[ai][0][m][n][j], up = acc[ai][1][m][n][j]; o[4 * n + j] = gt * sigmoidf_(gt) * up; }
                u32x4 w; w.x = cvt_pk_bf16(o[0], o[1]); w.y = cvt_pk_bf16(o[2], o[3]); w.z = cvt_pk_bf16(o[4], o[5]); w.w = cvt_pk_bf16(o[6], o[7]);
                *(u32x4*)rowp = w; }
    }
};

template <class Epi, class Sched, bool ALIGN_EPI = false, bool SP2 = false>
__device__ __forceinline__ void gemm_phase(PG8_LAS unsigned char* lds, const Gemm g, const Sched& S, const Epi& E) {
    const int tid = threadIdx.x, wid = __builtin_amdgcn_readfirstlane(tid >> 6), lane = tid & 63, wr = wid >> 2, wc = wid & 3, fr = lane & 15, fq = lane >> 4;
    const int K = g.K, nt = K / BK;
    int Rs[2], Cs[2]; unsigned voffB[2];
#pragma unroll
    for (int i = 0; i < 2; ++i) { int R, C; stage_rc(tid * 16 + i * 8192, R, C); const int Rb = Epi::PERM ? ((R & ~31) + perm32(R & 31)) : R;
        Rs[i] = R; Cs[i] = C; voffB[i] = (unsigned)(Rb * K + C) * 2u; }
    const size_t kstep = (size_t)(BK * 2);
    const size_t hstep = (size_t)HALF * K * 2;
    const size_t tstep = 2 * hstep;
    const unsigned ldsw = (unsigned)wid * 1024u;
    const int aoff = lds_byte(wr * 64 + fr, fq * 8), boff = lds_byte(wc * 32 + fr, fq * 8);
#define PG8_SA(b, h) (((b) * 2 + (h)) * HTB)
#define PG8_SB(b, h) ((4 + (b) * 2 + (h)) * HTB)
#define PG8_STAGE(bufoff, gbase, voff) do { _Pragma("unroll") for (int _i = 0; _i < 2; ++_i) \
        __builtin_amdgcn_global_load_lds((const unsigned*)((const char*)(gbase) + (voff)[_i]), (PG8_LAS unsigned*)(lds + (bufoff) + ldsw + _i * 8192), 16, 0, 0); } while (0)
#define PG8_LDA(dst, b, h) do { _Pragma("unroll") for (int m = 0; m < 4; ++m) _Pragma("unroll") for (int k = 0; k < 2; ++k) dst[m][k] = *(const PG8_LAS bf16x8*)(lds + PG8_SA(b, h) + aoff + m * 2048 + k * 1024); } while (0)
#define PG8_LDB(dst, b, h) do { _Pragma("unroll") for (int n = 0; n < 2; ++n) _Pragma("unroll") for (int k = 0; k < 2; ++k) dst[n][k] = *(const PG8_LAS bf16x8*)(lds + PG8_SB(b, h) + boff + n * 2048 + k * 1024); } while (0)
#define PG8_MMA(ai, bj, At, Bt) do { __builtin_amdgcn_s_setprio(1); _Pragma("unroll") for (int m = 0; m < 4; ++m) _Pragma("unroll") for (int n = 0; n < 2; ++n) _Pragma("unroll") for (int k = 0; k < 2; ++k) \
        acc[ai][bj][m][n] = __builtin_amdgcn_mfma_f32_16x16x32_bf16(Bt[n][k], At[m][k], acc[ai][bj][m][n], 0, 0, 0); __builtin_amdgcn_s_setprio(0); } while (0)
#define PG8_WAIT_V(n) asm volatile("s_waitcnt vmcnt(" #n ")" ::: "memory")
#define PG8_WAIT_L(n) asm volatile("s_waitcnt lgkmcnt(" #n ")" ::: "memory")
#define PG8_BAR __builtin_amdgcn_s_barrier()
#define PG8_SCHED __builtin_amdgcn_sched_barrier(0)
#define PG8_AOFF(dst, u) do { _Pragma("unroll") for (int _h = 0; _h < 2; ++_h) _Pragma("unroll") for (int _i = 0; _i < 2; ++_i) \
        dst[_h][_i] = ((unsigned)S.arow(u, _h * HALF + Rs[_i]) * (unsigned)K + (unsigned)Cs[_i]) * 2u; } while (0)
    Unit cur, nxt; int ui = 0;
    if (!S.next(0, cur)) return;
    f32x4 acc[2][2][4][2];
#pragma unroll
    for (int a = 0; a < 2; ++a)
#pragma unroll
        for (int b = 0; b < 2; ++b)
#pragma unroll
            for (int m = 0; m < 4; ++m)
#pragma unroll
                for (int n = 0; n < 2; ++n) acc[a][b][m][n] = (f32x4){0.f, 0.f, 0.f, 0.f};
    bf16x8 At[4][2], B0[2][2], B1[2][2];
    unsigned vA[2][2], nvA[2][2];
    PG8_AOFF(vA, cur);
    const char* const cA = (const char*)g.A; const char* cB = (const char*)g.Bt + (size_t)cur.pn * tstep;
    S.a_ready(cur);
    if constexpr (SP2) {
        PG8_STAGE(PG8_SB(0, 0), cB, voffB); PG8_STAGE(PG8_SB(0, 1), cB + hstep, voffB); PG8_STAGE(PG8_SA(0, 0), cA, vA[0]); PG8_STAGE(PG8_SA(0, 1), cA, vA[1]);
        if (wr == 1) PG8_BAR;
        PG8_WAIT_V(2); PG8_BAR;
        PG8_STAGE(PG8_SB(1, 0), cB + kstep, voffB); PG8_STAGE(PG8_SA(1, 0), cA + kstep, vA[0]); PG8_STAGE(PG8_SB(1, 1), cB + hstep + kstep, voffB);
        PG8_WAIT_V(6); PG8_BAR;
    } else {
        PG8_STAGE(PG8_SB(0, 0), cB, voffB); PG8_STAGE(PG8_SA(0, 0), cA, vA[0]); PG8_STAGE(PG8_SB(0, 1), cB + hstep, voffB); PG8_STAGE(PG8_SA(0, 1), cA, vA[1]);
        if (wr == 1) PG8_BAR;
        PG8_WAIT_V(4); PG8_BAR;
        PG8_STAGE(PG8_SB(1, 0), cB + kstep, voffB); PG8_STAGE(PG8_SA(1, 0), cA + kstep, vA[0]); PG8_STAGE(PG8_SB(1, 1), cB + hstep + kstep, voffB);
        PG8_WAIT_V(6); PG8_BAR;
    }
    for (;;) {
        const bool has_next = S.next(ui + 1, nxt);
        const char* nB = has_next ? (const char*)g.Bt + (size_t)nxt.pn * tstep : cB;
        if (has_next) { PG8_AOFF(nvA, nxt); } else {
#pragma unroll
            for (int h = 0; h < 2; ++h)
#pragma unroll
                for (int i = 0; i < 2; ++i) nvA[h][i] = vA[h][i]; }
        for (int t = 0; t < nt; t += 2) {
            const bool last = (t == nt - 2);
            const char* a1 = cA + (size_t)(t + 1) * kstep;
            const char* a2 = last ? cA : cA + (size_t)(t + 2) * kstep; const char* b2 = last ? nB : cB + (size_t)(t + 2) * kstep;
            const char* a3 = a2 + kstep; const char* b3 = b2 + kstep;
            unsigned w0[2], w1[2];
            w0[0] = last ? nvA[0][0] : vA[0][0]; w0[1] = last ? nvA[0][1] : vA[0][1]; w1[0] = last ? nvA[1][0] : vA[1][0]; w1[1] = last ? nvA[1][1] : vA[1][1];
            if (last && has_next) S.a_ready(nxt);
            if constexpr (SP2) {
            PG8_LDB(B0, 0, 0); PG8_LDB(B1, 0, 1); PG8_SCHED; PG8_LDA(At, 0, 0); PG8_STAGE(PG8_SA(1, 1), a1, vA[1]);
            PG8_WAIT_V(8); PG8_WAIT_L(0); PG8_BAR; PG8_MMA(0, 0, At, B0); PG8_MMA(0, 1, At, B1); PG8_BAR; PG8_SCHED;
            PG8_LDA(At, 0, 1); PG8_STAGE(PG8_SB(0, 0), b2, voffB); PG8_STAGE(PG8_SB(0, 1), b2 + hstep, voffB); PG8_STAGE(PG8_SA(0, 0), a2, w0);
            PG8_WAIT_V(8); PG8_WAIT_L(0); PG8_BAR; PG8_MMA(1, 0, At, B0); PG8_MMA(1, 1, At, B1); PG8_BAR; PG8_SCHED;
            PG8_LDB(B0, 1, 0); PG8_LDB(B1, 1, 1); PG8_SCHED; PG8_LDA(At, 1, 0); PG8_STAGE(PG8_SA(0, 1), a2, w1);
            PG8_WAIT_V(8); PG8_WAIT_L(0); PG8_BAR; PG8_MMA(0, 0, At, B0); PG8_MMA(0, 1, At, B1); PG8_BAR; PG8_SCHED;
            PG8_LDA(At, 1, 1); PG8_STAGE(PG8_SB(1, 0), b3, voffB); PG8_STAGE(PG8_SB(1, 1), b3 + hstep, voffB); PG8_STAGE(PG8_SA(1, 0), a3, w0);
            PG8_WAIT_V(8); PG8_WAIT_L(0); PG8_BAR; PG8_MMA(1, 0, At, B0); PG8_MMA(1, 1, At, B1); PG8_BAR; PG8_SCHED;
            } else {
            PG8_LDB(B0, 0, 0); PG8_SCHED; PG8_LDA(At, 0, 0); PG8_STAGE(PG8_SA(1, 1), a1, vA[1]);
            PG8_WAIT_L(8); PG8_BAR; PG8_WAIT_L(0); PG8_MMA(0, 0, At, B0); PG8_BAR; PG8_SCHED;
            PG8_LDB(B1, 0, 1); PG8_STAGE(PG8_SB(0, 0), b2, voffB);
            PG8_BAR; PG8_WAIT_L(0); PG8_MMA(0, 1, At, B1); PG8_BAR;
            PG8_LDA(At, 0, 1); PG8_STAGE(PG8_SA(0, 0), a2, w0);
            PG8_BAR; PG8_WAIT_L(0); PG8_MMA(1, 0, At, B0); PG8_BAR; PG8_SCHED;
            PG8_STAGE(PG8_SB(0, 1), b2 + hstep, voffB);
            PG8_WAIT_V(6); PG8_BAR; PG8_MMA(1, 1, At, B1); PG8_BAR;
            PG8_LDB(B0, 1, 0); PG8_SCHED; PG8_LDA(At, 1, 0); PG8_STAGE(PG8_SA(0, 1), a2, w1);
            PG8_WAIT_L(8); PG8_BAR; PG8_WAIT_L(0); PG8_MMA(0, 0, At, B0); PG8_BAR; PG8_SCHED;
            PG8_LDB(B1, 1, 1); PG8_STAGE(PG8_SB(1, 0), b3, voffB);
            PG8_BAR; PG8_WAIT_L(0); PG8_MMA(0, 1, At, B1); PG8_BAR;
            PG8_LDA(At, 1, 1); PG8_STAGE(PG8_SA(1, 0), a3, w0);
            PG8_BAR; PG8_WAIT_L(0); PG8_MMA(1, 0, At, B0); PG8_BAR; PG8_SCHED;
            PG8_STAGE(PG8_SB(1, 1), b3 + hstep, voffB);
            PG8_WAIT_V(6); PG8_BAR; PG8_MMA(1, 1, At, B1); PG8_BAR;
            }
        }
        if constexpr (ALIGN_EPI) { if (wr == 0) PG8_BAR; }
        E(acc, cur, wr, wc, fr, fq); S.done(cur);
        if (!has_next) break;
#pragma unroll
        for (int a = 0; a < 2; ++a)
#pragma unroll
            for (int b = 0; b < 2; ++b)
#pragma unroll
                for (int m = 0; m < 4; ++m)
#pragma unroll
                    for (int n = 0; n < 2; ++n) acc[a][b][m][n] = (f32x4){0.f, 0.f, 0.f, 0.f};
        cur = nxt; cB = nB; ++ui;
#pragma unroll
        for (int h = 0; h < 2; ++h)
#pragma unroll
            for (int i = 0; i < 2; ++i) vA[h][i] = nvA[h][i];
        if constexpr (ALIGN_EPI) { if (wr == 1) PG8_BAR; }
    }
    PG8_WAIT_V(0);
    if constexpr (!ALIGN_EPI) { if (wr == 0) PG8_BAR; }
    PG8_BAR;
#undef PG8_SA
#undef PG8_SB
#undef PG8_STAGE
#undef PG8_LDA
#undef PG8_LDB
#undef PG8_MMA
#undef PG8_WAIT_V
#undef PG8_WAIT_L
#undef PG8_BAR
#undef PG8_SCHED
#undef PG8_AOFF
}
}
#define GAS __attribute__((address_space(1)))
#define LAS __attribute__((address_space(3)))
typedef unsigned short bf16;
typedef unsigned v4u __attribute__((ext_vector_type(4)));
typedef float f32x4 __attribute__((ext_vector_type(4)));
typedef short bf16x8 __attribute__((ext_vector_type(8)));
typedef GAS unsigned gu32;
typedef GAS unsigned long long gu64;
#define RLX_AGENT __ATOMIC_RELAXED, __HIP_MEMORY_SCOPE_AGENT
#define LDS_WAIT() asm volatile("s_waitcnt lgkmcnt(0)" ::: "memory")
#define VM_WAIT() asm volatile("s_waitcnt vmcnt(0)" ::: "memory")
__device__ __forceinline__ unsigned long long rt() { return __builtin_amdgcn_s_memrealtime(); }
__device__ __forceinline__ unsigned f2bf(float f) { unsigned u = __builtin_bit_cast(unsigned, f); return (u + 0x7fffu + ((u >> 16) & 1u)) >> 16; }
__device__ __forceinline__ unsigned pk2(float lo, float hi) { return f2bf(lo) | (f2bf(hi) << 16); }

#define XB_TMO      128
#define XB_XCNT(j)  (256  + 64 * (j))
#define XB_XSUB(j)  (1280 + 64 * (j))
#define XB_XGEN(j)  (2304 + 64 * (j))
#define XB_TOP      3328
#define XB_TOPGEN   3392
#define XCD_BAR_WORDS 3456
#define XB_SPIN_CAP (1u << 22)

__device__ __forceinline__ unsigned xb_ld(unsigned* p)              { return __hip_atomic_load(p, __ATOMIC_RELAXED, __HIP_MEMORY_SCOPE_AGENT); }
__device__ __forceinline__ unsigned xb_add(unsigned* p, unsigned v) { return __hip_atomic_fetch_add(p, v, __ATOMIC_RELAXED, __HIP_MEMORY_SCOPE_AGENT); }
__device__ __forceinline__ unsigned xb_xcc_id() { return (unsigned)__builtin_amdgcn_s_getreg((3 << 11) | 20) & 0xFu; }
#define XB_SPIN(cond, bar) do { unsigned _sp = 0; while (cond) { __builtin_amdgcn_s_sleep(1); \
    if ((++_sp & 255u) == 0u) { if (xb_ld(&(bar)[XB_TMO])) break; if (_sp > XB_SPIN_CAP) { atomicAdd(&(bar)[XB_TMO], 1u); break; } } } } while (0)

struct XcdBarrier {
    unsigned* bar; unsigned x;
    volatile LAS unsigned* st;
};

__device__ __forceinline__ XcdBarrier xcd_barrier_post(unsigned* bar, volatile LAS unsigned* st) {
    XcdBarrier b; b.bar = bar; b.x = xb_xcc_id(); b.st = st;
    if (threadIdx.x == 0) (void)xb_add(&bar[XB_XCNT(b.x)], 1u);
    return b;
}
__device__ __forceinline__ void xcd_barrier_complete(unsigned* bar, unsigned x, unsigned& nloc, unsigned& nx) {
    const unsigned G = gridDim.x * gridDim.y * gridDim.z;
    unsigned sum, cnt, mine, sp = 0u;
    for (;;) {
        sum = 0u; cnt = 0u; mine = 0u;
#pragma unroll
        for (unsigned j = 0; j < 16; ++j) { const unsigned c = xb_ld(&bar[XB_XCNT(j)]); sum += c; cnt += (c > 0u) ? 1u : 0u; mine = (j == x) ? c : mine; }
        if (sum == G) break;
        __builtin_amdgcn_s_sleep(1);
        if ((++sp & 255u) == 0u) { if (xb_ld(&bar[XB_TMO])) break; if (sp > XB_SPIN_CAP) { atomicAdd(&bar[XB_TMO], 1u); break; } }
    }
    nloc = mine > 0u ? mine : 1u; nx = cnt > 0u ? cnt : 1u;
}

__device__ __forceinline__ void xcd_barrier(const XcdBarrier& b) {
    asm volatile("s_waitcnt vmcnt(0)" ::: "memory");
    __syncthreads();
    if (threadIdx.x == 0) {
        unsigned* bar = b.bar;
        __builtin_amdgcn_s_waitcnt(0);
        unsigned nloc = b.st[0], nx = b.st[1];
        if (nloc == 0u) { xcd_barrier_complete(bar, b.x, nloc, nx); b.st[0] = nloc; b.st[1] = nx; }
        const unsigned old = xb_add(&bar[XB_XSUB(b.x)], 1u);
        const unsigned gen = old / nloc;
        if (old + 1u == (gen + 1u) * nloc) {
            __builtin_amdgcn_fence(__ATOMIC_RELEASE, "agent");
            asm volatile("s_waitcnt vmcnt(0)" ::: "memory");
            const unsigned og = xb_add(&bar[XB_TOP], 1u);
            const unsigned tg = og / nx;
            if (og + 1u == (tg + 1u) * nx) xb_add(&bar[XB_TOPGEN], 1u);
            else XB_SPIN(xb_ld(&bar[XB_TOPGEN]) == tg, bar);
            __builtin_amdgcn_fence(__ATOMIC_ACQUIRE, "agent");
            xb_add(&bar[XB_XGEN(b.x)], 1u);
            asm volatile("s_waitcnt vmcnt(0)" ::: "memory");
        } else {
            XB_SPIN(xb_ld(&bar[XB_XGEN(b.x)]) == gen, bar);
            __builtin_amdgcn_fence(__ATOMIC_ACQUIRE, "agent");
            asm volatile("s_waitcnt vmcnt(0)" ::: "memory");
        }
    }
    __syncthreads();
}

constexpr int NWAVES = 8;
constexpr int BATCH = 2, SEQ = 4096, M = BATCH * SEQ, D = 2048;
constexpr int NPW = 11784;
constexpr int NP = 11776;
constexpr int C_AQ = 0, C_AK = 1536, C_AV = 3072, C_MQK = 4608, C_MV = 5632, C_MO = 6656, C_GATE = 7680;
constexpr int NE = 32, DFF = 1408, ECAP = 8192, MAXT = 96, NT1 = DFF / 128  , NT2 = D / 256  ;
constexpr float LN_EPS = 1e-5f, ALPHA = 1.189207115002721f, QSCALE = 0.08838834764831845f;
constexpr size_t MiB = 1u << 20;
constexpr size_t WS_CTL = 0, CTL_ZERO_BYTES = 1 * MiB;
constexpr size_t WS_WIN = 2 * MiB, WS_WPA = 48 * MiB, WS_WPM = 50 * MiB, WS_WOUT = 54 * MiB, WS_WGU = 62 * MiB, WS_WD = 414 * MiB;
constexpr size_t WS_HB = 590 * MiB, WS_STATS = 622 * MiB, WS_MIF = 622 * MiB + 512 * 1024, WS_PROJ = 623 * MiB;
constexpr size_t WS_ATTO = 807 * MiB, WS_LSE = 831 * MiB, WS_ATT = 832 * MiB, WS_QKC = 840 * MiB, WS_NUM = 856 * MiB, WS_DEN = 888 * MiB, WS_MT = 888 * MiB + 512 * 1024;
constexpr size_t WS_HM = 889 * MiB, WS_TMP = 905 * MiB, WS_MERGED = 969 * MiB, WS_H1 = 1001 * MiB, WS_H1B = 1065 * MiB, WS_TOKLIST = 1097 * MiB, WS_TOKINFO = 1098 * MiB;
constexpr size_t WS_ACT = WS_PROJ, WS_YS = 689 * MiB;
constexpr size_t WS_KVT = 1099 * MiB, WS_CPREV = 1163 * MiB, WS_MSC = 1195 * MiB;
constexpr size_t WS_WRT = 1196 * MiB;
constexpr size_t WS_END = 1200 * MiB;
static_assert(WS_WIN + (size_t)NP * D * 2 <= WS_WPA && WS_WGU + (size_t)NE * 2 * DFF * D * 2 <= WS_WD && WS_WD + (size_t)NE * D * DFF * 2 <= WS_HB, "weights map");
static_assert(WS_PROJ + (size_t)M * NP * 2 <= WS_ATTO && WS_ACT + (size_t)MAXT * 256 * DFF * 2 <= WS_YS && WS_YS + (size_t)MAXT * 256 * D * 2 <= WS_ATTO, "activation map");
constexpr int CW_TMO = 0, CW_CODE = 1, CW_BAR = 4096, CW_CNT = 65536, CW_Q = 66560;
constexpr int RING_OFF = 0, RING_BYTES = 131072, LDSCTL_OFF = RING_BYTES, MISC_OFF = LDSCTL_OFF + 320, TS_OFF = LDSCTL_OFF + 512, CNT_OFF = LDSCTL_OFF + 768, GATE_OFF = LDSCTL_OFF + 1024, QSLOT_OFF = LDSCTL_OFF + 1536;
constexpr int LDS_BYTES = 147456;

struct Frame { LAS unsigned char* lds; gu32* ctl; int tid, lane, wave, vcu, G; unsigned char* ws; };

__device__ __forceinline__ float wave_sum(float v) {
#pragma unroll
    for (int o = 1; o < 64; o <<= 1) v += __shfl_xor(v, o);
    return v;
}
__device__ __forceinline__ float wave_max(float v) {
#pragma unroll
    for (int o = 1; o < 64; o <<= 1) v = fmaxf(v, __shfl_xor(v, o));
    return v;
}
__device__ __forceinline__ float bflo(unsigned w) { return __uint_as_float(w << 16); }
__device__ __forceinline__ float bfhi(unsigned w) { return __uint_as_float(w & 0xffff0000u); }
__device__ __forceinline__ float sigm(float x) { return 1.0f / (1.0f + __expf(-x)); }

typedef short s16x4 __attribute__((ext_vector_type(4)));
__device__ __forceinline__ bf16x8 frag_tr(const LAS unsigned char* img, int pitch, int k0, int n0, int lane) {
    const int i = lane & 15, g = lane >> 4;
    const LAS unsigned char* p = img + (k0 + 8 * g + (i >> 2)) * pitch + (n0 + 4 * (i & 3)) * 2;
    const s16x4 a = __builtin_amdgcn_ds_read_tr16_b64_v4i16((LAS s16x4*)p), b = __builtin_amdgcn_ds_read_tr16_b64_v4i16((LAS s16x4*)(p + 4 * pitch));
    return (bf16x8){a[0], a[1], a[2], a[3], b[0], b[1], b[2], b[3]};
}
constexpr int TR_PITCH = 144;
__device__ __forceinline__ void tr_item(const float* W, int ldw, int k0, int c0, bf16* WT, size_t drow0, int Kd, LAS unsigned char* scr, int lane) {
    const int kr = lane >> 4, nc = (lane & 15) * 4;
    f32x4 v[16];
#pragma unroll
    for (int j = 0; j < 16; ++j) v[j] = *(const f32x4*)(W + (size_t)(k0 + 4 * j + kr) * ldw + c0 + nc);
#pragma unroll
    for (int j = 0; j < 16; ++j) *(LAS unsigned long long*)(scr + (4 * j + kr) * TR_PITCH + nc * 2) = (unsigned long long)pk2(v[j][0], v[j][1]) | ((unsigned long long)pk2(v[j][2], v[j][3]) << 32);
    LDS_WAIT(); asm volatile("" ::: "memory");
    const int i = lane & 15, g = lane >> 4;
#pragma unroll
    for (int kk = 0; kk < 2; ++kk)
#pragma unroll
        for (int nn = 0; nn < 4; ++nn) { const bf16x8 f = frag_tr(scr, TR_PITCH, 32 * kk, 16 * nn, lane);
            *(bf16x8*)(WT + (drow0 + 16 * nn + i) * Kd + k0 + 32 * kk + 8 * g) = f; }
    LDS_WAIT(); asm volatile("" ::: "memory");
}
constexpr int I_WINA = 32 * 120, I_WINB = 32 * 64, I_WPA = 8 * 32, I_WPM = 16 * 32, I_WOUT = 32 * 32, I_EXP = NE * 32 * 22, I_DN = NE * 22 * 32;
constexpr int I_EARLY = I_WINA + I_WINB + I_WPA + I_WPM + I_WOUT, I_MOE = 2 * I_EXP + I_DN;

__device__ __forceinline__ void p0_prologue(Frame& F, const float* x, const float* lng, const float* lnb, const float* w_in, const float* if_bias, const float* wpa, const float* wpm, const float* wout,
                                            const float* wrg, const float* wre) {
    unsigned char* ws = F.ws;
    LAS unsigned char* scr = F.lds + RING_OFF + F.wave * 16384;
    const int gw = F.vcu * NWAVES + F.wave, NGW = F.G * NWAVES;
    for (int it0 = gw; it0 < I_EARLY; it0 += NGW) {
        int it = it0;
        if (it < I_WINA) { const int kb = it / 120, nb = it % 120; tr_item(w_in, NPW, 64 * kb, 64 * nb, (bf16*)(ws + WS_WIN), (size_t)64 * nb, D, scr, F.lane); continue; } it -= I_WINA;
        if (it < I_WINB) { const int kb = it / 64, nb = it % 64; tr_item(w_in, NPW, 64 * kb, 7688 + 64 * nb, (bf16*)(ws + WS_WIN), (size_t)7680 + 64 * nb, D, scr, F.lane); continue; } it -= I_WINB;
        if (it < I_WPA) { const int kb = it / 32, nb = it % 32; tr_item(wpa, D, 64 * kb, 64 * nb, (bf16*)(ws + WS_WPA), (size_t)64 * nb, 512, scr, F.lane); continue; } it -= I_WPA;
        if (it < I_WPM) { const int kb = it / 32, nb = it % 32; tr_item(wpm, D, 64 * kb, 64 * nb, (bf16*)(ws + WS_WPM), (size_t)64 * nb, 1024, scr, F.lane); continue; } it -= I_WPM;
        { const int kb = it / 32, nb = it % 32; tr_item(wout, D, 64 * kb, 64 * nb, (bf16*)(ws + WS_WOUT), (size_t)64 * nb, D, scr, F.lane); }
    }
    {
        bf16* WRH = (bf16*)(ws + WS_WRT); bf16* WRL = WRH + 48 * D; const int gt = F.vcu * (NWAVES * 64) + F.tid, NT = F.G * NWAVES * 64;
        for (int idx = gt; idx < 48 * D; idx += NT) { const int e = idx / D, k = idx % D; const float w = e < 32 ? wre[(size_t)k * 32 + e] : (e < 36 ? wrg[(size_t)k * 4 + (e - 32)] : 0.f);
            const unsigned hi = f2bf(w); WRH[idx] = (bf16)hi; WRL[idx] = (bf16)f2bf(w - __uint_as_float(hi << 16)); } }
    __syncthreads();
    LAS float* wif = (LAS float*)(F.lds + RING_OFF);
    for (int k = F.tid; k < D; k += NWAVES * 64) { const f32x4 a = *(const f32x4*)(w_in + (size_t)k * NPW + 7680), b = *(const f32x4*)(w_in + (size_t)k * NPW + 7684);
        *(LAS f32x4*)(wif + k * 8) = a; *(LAS f32x4*)(wif + k * 8 + 4) = b; }
    __syncthreads();
    bf16* HB = (bf16*)(ws + WS_HB); float* STATS = (float*)(ws + WS_STATS); float* MIF = (float*)(ws + WS_MIF);
    for (int m = gw; m < M; m += NGW) {
        const f32x4* xr = (const f32x4*)(x + (size_t)m * D) + F.lane;
        f32x4 v[8]; float s = 0.f;
#pragma unroll
        for (int j = 0; j < 8; ++j) { v[j] = xr[64 * j]; s += (v[j][0] + v[j][1]) + (v[j][2] + v[j][3]); }
        const float mean = wave_sum(s) * (1.f / D); float s2 = 0.f;
#pragma unroll
        for (int j = 0; j < 8; ++j) { const f32x4 d = v[j] - mean; s2 += (d[0] * d[0] + d[1] * d[1]) + (d[2] * d[2] + d[3] * d[3]); }
        const float rstd = rsqrtf(wave_sum(s2) * (1.f / D) + LN_EPS);
        float a[8];
#pragma unroll
        for (int i = 0; i < 8; ++i) a[i] = 0.f;
        unsigned long long* o8 = (unsigned long long*)(HB + (size_t)m * D) + F.lane;
#pragma unroll
        for (int j = 0; j < 8; ++j) { const int k0 = 4 * F.lane + 256 * j; const f32x4 g4 = *(const f32x4*)(lng + k0), b4 = *(const f32x4*)(lnb + k0);
            const f32x4 hv = (v[j] - mean) * rstd * g4 + b4;
            o8[64 * j] = (unsigned long long)pk2(hv[0], hv[1]) | ((unsigned long long)pk2(hv[2], hv[3]) << 32);
#pragma unroll
            for (int c = 0; c < 4; ++c) { const f32x4 w0 = *(const LAS f32x4*)(wif + (k0 + c) * 8), w1 = *(const LAS f32x4*)(wif + (k0 + c) * 8 + 4);
                a[0] += hv[c] * w0[0]; a[1] += hv[c] * w0[1]; a[2] += hv[c] * w0[2]; a[3] += hv[c] * w0[3]; a[4] += hv[c] * w1[0]; a[5] += hv[c] * w1[1]; a[6] += hv[c] * w1[2]; a[7] += hv[c] * w1[3]; }
            asm volatile("" ::: "memory"); }
#pragma unroll
        for (int i = 0; i < 8; ++i) a[i] = wave_sum(a[i]);
        if (F.lane == 0) { STATS[2 * m] = mean; STATS[2 * m + 1] = rstd;
#pragma unroll
            for (int i = 0; i < 8; ++i) MIF[(size_t)m * 8 + i] = a[i] + if_bias[i]; }
    }
}


struct TrItem { const float* src; bf16* dst; int ldw, Kd; };
__device__ __forceinline__ TrItem moe_item(int it, unsigned char* ws, const float* wgate, const float* wup, const float* wdown) {
    TrItem t;
    if (it < 2 * I_EXP) { const int up = it >= I_EXP ? 1 : 0; if (up) it -= I_EXP; const int e = it / 704, r = it % 704, kb = r / 22, nb = r % 22, j0 = 64 * nb;
        t.src = (up ? wup : wgate) + (size_t)e * D * DFF + (size_t)(64 * kb) * DFF + j0; t.ldw = DFF; t.Kd = D;
        t.dst = (bf16*)(ws + WS_WGU) + ((size_t)e * 2816 + (size_t)(j0 / 128) * 256 + (j0 % 128) + 128 * up) * D + 64 * kb; }
    else { it -= 2 * I_EXP; const int e = it / 704, r = it % 704, kb = r / 32, nb = r % 32;
        t.src = wdown + (size_t)e * DFF * D + (size_t)(64 * kb) * D + 64 * nb; t.ldw = D; t.Kd = DFF;
        t.dst = (bf16*)(ws + WS_WD) + ((size_t)e * D + 64 * nb) * DFF + 64 * kb; }
    return t;
}
__device__ __forceinline__ void tr_load(f32x4 (&v)[16], const TrItem& t, int lane) {
    const int kr = lane >> 4, nc = (lane & 15) * 4;
#pragma unroll
    for (int j = 0; j < 16; ++j) v[j] = __builtin_nontemporal_load((const f32x4*)(t.src + (size_t)(4 * j + kr) * t.ldw + nc));
}
__device__ __forceinline__ void tr_store(const f32x4 (&v)[16], const TrItem& t, LAS unsigned char* scr, int lane) {
    const int kr = lane >> 4, nc = (lane & 15) * 4;
#pragma unroll
    for (int j = 0; j < 16; ++j) *(LAS unsigned long long*)(scr + (4 * j + kr) * TR_PITCH + nc * 2) = (unsigned long long)pk2(v[j][0], v[j][1]) | ((unsigned long long)pk2(v[j][2], v[j][3]) << 32);
    LDS_WAIT(); asm volatile("" ::: "memory");
    const int i = lane & 15, g = lane >> 4;
#pragma unroll
    for (int kk = 0; kk < 2; ++kk)
#pragma unroll
        for (int nn = 0; nn < 4; ++nn) { const bf16x8 f = frag_tr(scr, TR_PITCH, 32 * kk, 16 * nn, lane);
            __builtin_nontemporal_store(f, (bf16x8*)(t.dst + (size_t)(16 * nn + i) * t.Kd + 32 * kk + 8 * g)); }
    LDS_WAIT(); asm volatile("" ::: "memory");
}
__device__ __forceinline__ void moe_convert(Frame& F, int conv, int nconv, const float* wgate, const float* wup, const float* wdown) {
    unsigned char* ws = F.ws;
    LAS unsigned char* scr = F.lds + RING_OFF + F.wave * 16384;
    const int step = nconv * NWAVES; int it = conv * NWAVES + F.wave;
    if (it >= I_MOE) return;
    f32x4 va[16], vb[16];
    TrItem ta = moe_item(it, ws, wgate, wup, wdown), tb = ta;
    tr_load(va, ta, F.lane);
    for (;;) {
        const bool hb = (it + step) < I_MOE;
        if (hb) { tb = moe_item(it + step, ws, wgate, wup, wdown); tr_load(vb, tb, F.lane); }
        tr_store(va, ta, scr, F.lane);
        if (!hb) break;
        const bool ha = (it + 2 * step) < I_MOE;
        if (ha) { ta = moe_item(it + 2 * step, ws, wgate, wup, wdown); tr_load(va, ta, F.lane); }
        tr_store(vb, tb, scr, F.lane);
        if (!ha) break;
        it += 2 * step;
    }
}
struct QueueOrder {
    int nM, nN, nwg, x; gu32* qctr; volatile LAS int* slot;
    __device__ __forceinline__ void init(int M_, int N_, int bx, gu32* q, volatile LAS int* s) { nM = M_ / 256; nN = N_ / 256; nwg = nM * nN; x = bx & 7; qctr = q; slot = s; }
    __device__ __forceinline__ bool next(int i, pg8::Unit& u) const {
        if (threadIdx.x < 64) { int off = 0; if (threadIdx.x == 0) off = (int)__hip_atomic_fetch_add(qctr + 64 * x, 1u, RLX_AGENT);
            off = __builtin_amdgcn_readfirstlane(off); if (threadIdx.x == 0) slot[i & 1] = off; asm volatile("s_waitcnt lgkmcnt(0)" ::: "memory"); }
        asm volatile("" ::: "memory"); __builtin_amdgcn_s_barrier(); asm volatile("" ::: "memory");
        const int off = slot[i & 1], q = nwg / 8;
        if (off >= q) return false;
        const int wgid = x * q + off, nig = pg8::WGM * nN, gid = wgid / nig, fm = gid * pg8::WGM, gsz = (nM - fm) < pg8::WGM ? (nM - fm) : pg8::WGM;
        u.pm = fm + ((wgid % nig) % gsz); u.pn = (wgid % nig) / gsz; u.e = 0; u.r0 = 0; return true;
    }
    __device__ __forceinline__ int arow(const pg8::Unit& u, int r) const { return u.pm * 256 + r; }
    __device__ __forceinline__ void a_ready(const pg8::Unit&) const {}
    __device__ __forceinline__ void done(const pg8::Unit&) const {}
};
__device__ __forceinline__ float alibi_slope(int h) {
    switch (h) { case 0: return 0.70710678118654752f; case 1: return 0.5f; case 2: return 0.35355339059327379f; case 3: return 0.25f; case 4: return 0.17677669529663689f; case 5: return 0.125f;
        case 6: return 0.088388347648318447f; case 7: return 0.0625f; case 8: return 0.03125f; case 9: return 0.015625f; case 10: return 0.0078125f; default: return 0.00390625f; }
}
__device__ __forceinline__ void attn_naive(Frame& F) {
    const bf16* PROJ = (const bf16*)(F.ws + WS_PROJ); bf16* ATTO = (bf16*)(F.ws + WS_ATTO); float* LSE = (float*)(F.ws + WS_LSE);
    LAS float* pbuf = (LAS float*)(F.lds + RING_OFF) + F.wave * 256;
    const int gw = F.vcu * NWAVES + F.wave, NGW = F.G * NWAVES;
    for (int it = gw; it < M * 12; it += NGW) {
        const int h = it / M, m = it % M, t = m % SEQ, g = h >> 2, r = (g == 0) ? 1 : (g == 1 ? 4 : 16);
        const float slope = alibi_slope(h);
        const bf16* qp = PROJ + (size_t)m * NP + C_AQ + h * 128;
        float sc[3];
#pragma unroll
        for (int jj = 0; jj < 3; ++jj) {
            const int j = F.lane + 64 * jj; const bool valid = (j <= 128) && (t - j * r >= 0);
            float dot = 0.f;
            if (valid) { const bf16* kp = PROJ + (size_t)(m - j * r) * NP + C_AK + h * 128;
#pragma unroll 4
                for (int c = 0; c < 16; ++c) { const v4u qv = *(const v4u*)(qp + 8 * c), kv = *(const v4u*)(kp + 8 * c);
                    dot += bflo(qv.x) * bflo(kv.x) + bfhi(qv.x) * bfhi(kv.x) + bflo(qv.y) * bflo(kv.y) + bfhi(qv.y) * bfhi(kv.y) + bflo(qv.z) * bflo(kv.z) + bfhi(qv.z) * bfhi(kv.z) + bflo(qv.w) * bflo(kv.w) + bfhi(qv.w) * bfhi(kv.w); } }
            sc[jj] = valid ? dot * QSCALE - slope * (float)(j * r) : -INFINITY;
        }
        const float mx = wave_max(fmaxf(fmaxf(sc[0], sc[1]), sc[2]));
        float ps = 0.f;
#pragma unroll
        for (int jj = 0; jj < 3; ++jj) { const float p = (sc[jj] == -INFINITY) ? 0.f : __expf(sc[jj] - mx); ps += p; pbuf[F.lane + 64 * jj] = p; }
        const float l = wave_sum(ps);
        LDS_WAIT(); asm volatile("" ::: "memory");
        const int nk = ((t / r) < 128 ? (t / r) : 128) + 1;
        float o0 = 0.f, o1 = 0.f;
        const bf16* vp = PROJ + (size_t)m * NP + C_AV + h * 128 + 2 * F.lane;
        for (int j = 0; j < nk; ++j) { const float p = pbuf[j]; const unsigned w = *(const unsigned*)(vp - (size_t)j * r * NP); o0 += p * bflo(w); o1 += p * bfhi(w); }
        const float il = 1.f / l;
        *(unsigned*)(ATTO + (size_t)m * 1536 + h * 128 + 2 * F.lane) = pk2(o0 * il, o1 * il);
        if (F.lane == 0) LSE[(size_t)m * 12 + h] = mx + __logf(l);
        LDS_WAIT(); asm volatile("" ::: "memory");
    }
}
__device__ __forceinline__ void conv_qk(Frame& F, const float* conv_w, const float* conv_b) {
    const bf16* PROJ = (const bf16*)(F.ws + WS_PROJ); bf16* QKC = (bf16*)(F.ws + WS_QKC);
    const int gt = F.vcu * (NWAVES * 64) + F.tid, NT = F.G * NWAVES * 64;
    for (int idx = gt; idx < M * 128; idx += NT) {
        const int m = idx >> 7, c8 = (idx & 127) * 8, t = m % SEQ;
        float acc[8];
#pragma unroll
        for (int i = 0; i < 8; ++i) acc[i] = conv_b[c8 + i];
#pragma unroll
        for (int j = 0; j < 4; ++j) { const int tt = t - 3 + j; if (tt < 0) continue;
            const v4u w = *(const v4u*)(PROJ + (size_t)(m - 3 + j) * NP + C_MQK + c8);
            const f32x4 c0 = *(const f32x4*)(conv_w + j * 1024 + c8), c1 = *(const f32x4*)(conv_w + j * 1024 + c8 + 4);
            acc[0] += c0[0] * bflo(w.x); acc[1] += c0[1] * bfhi(w.x); acc[2] += c0[2] * bflo(w.y); acc[3] += c0[3] * bfhi(w.y);
            acc[4] += c1[0] * bflo(w.z); acc[5] += c1[1] * bfhi(w.z); acc[6] += c1[2] * bflo(w.w); acc[7] += c1[3] * bfhi(w.w); }
#pragma unroll
        for (int i = 0; i < 8; ++i) acc[i] = acc[i] * sigm(acc[i]);
        v4u o; o.x = pk2(acc[0], acc[1]); o.y = pk2(acc[2], acc[3]); o.z = pk2(acc[4], acc[5]); o.w = pk2(acc[6], acc[7]);
        *(v4u*)(QKC + (size_t)m * 1024 + c8) = o;
    }
}

__device__ __forceinline__ float log_sigmoid(float x) { return fminf(x, 0.f) - log1pf(__expf(-fabsf(x))); }
__device__ __forceinline__ void mlstm_naive(Frame& F, int bh) {
    const int b = bh >> 2, h = bh & 3;
    const bf16* PROJ = (const bf16*)(F.ws + WS_PROJ); const bf16* QKC = (const bf16*)(F.ws + WS_QKC); const float* MIF = (const float*)(F.ws + WS_MIF);
    float* NUM = (float*)(F.ws + WS_NUM); float* DEN = (float*)(F.ws + WS_DEN); float* MT = (float*)(F.ws + WS_MT);
    LAS float* qs = (LAS float*)(F.lds + RING_OFF); LAS float* ks = qs + 64 * 128; LAS bf16* vs = (LAS bf16*)(ks + 64 * 128);
    LAS float* gi = (LAS float*)(F.lds + GATE_OFF); LAS float* gf = gi + 64;
    float C[128];
#pragma unroll
    for (int d = 0; d < 128; ++d) C[d] = 0.f;
    float mst = 0.f;
    for (int c = 0; c < SEQ / 64; ++c) {
        __syncthreads();
        const size_t row0 = (size_t)b * SEQ + (size_t)c * 64;
        for (int idx = F.tid; idx < 64 * 32; idx += NWAVES * 64) { const int s = idx >> 5, c8 = idx & 31;
            const bf16* src = QKC + (row0 + s) * 1024 + (c8 < 16 ? h * 128 + c8 * 8 : 512 + h * 128 + (c8 - 16) * 8);
            const v4u w = *(const v4u*)src; const float sc = c8 < 16 ? QSCALE : 1.f;
            LAS float* dst = (c8 < 16 ? qs + s * 128 + c8 * 8 : ks + s * 128 + (c8 - 16) * 8);
            *(LAS f32x4*)dst = (f32x4){bflo(w.x) * sc, bfhi(w.x) * sc, bflo(w.y) * sc, bfhi(w.y) * sc}; *(LAS f32x4*)(dst + 4) = (f32x4){bflo(w.z) * sc, bfhi(w.z) * sc, bflo(w.w) * sc, bfhi(w.w) * sc};
            *(LAS v4u*)(vs + s * 256 + c8 * 8) = *(const v4u*)(PROJ + (row0 + s) * NP + C_MV + h * 256 + c8 * 8); }
        if (F.tid < 64) { gi[F.tid] = MIF[(row0 + F.tid) * 8 + h]; gf[F.tid] = log_sigmoid(MIF[(row0 + F.tid) * 8 + 4 + h]); }
        __syncthreads();
        if (F.tid <= 256) {
            for (int s = 0; s < 64; ++s) {
                const float lf = gf[s], ip = gi[s];
                const float mn = fmaxf(lf + mst, ip), fg = __expf(lf + mst - mn), ig = __expf(ip - mn); mst = mn;
                const float vv = (F.tid < 256) ? __uint_as_float((unsigned)vs[s * 256 + (F.tid & 255)] << 16) : 1.f;
                const float a = ig * vv; float num = 0.f;
#pragma unroll
                for (int d4 = 0; d4 < 32; ++d4) { const f32x4 kk = *(const LAS f32x4*)(ks + s * 128 + 4 * d4), qq = *(const LAS f32x4*)(qs + s * 128 + 4 * d4);
#pragma unroll
                    for (int e = 0; e < 4; ++e) { C[4 * d4 + e] = fg * C[4 * d4 + e] + a * kk[e]; num += C[4 * d4 + e] * qq[e]; } }
                if (F.tid < 256) NUM[(row0 + s) * 1024 + h * 256 + F.tid] = num; else { DEN[(row0 + s) * 4 + h] = num; MT[(row0 + s) * 4 + h] = mn; }
            }
        }
    }
}
__device__ __forceinline__ void attn_merge(Frame& F, int first_wg) {
    const bf16* ATTO = (const bf16*)(F.ws + WS_ATTO); const float* LSE = (const float*)(F.ws + WS_LSE); bf16* ATT = (bf16*)(F.ws + WS_ATT);
    const int gt = (F.vcu - first_wg) * (NWAVES * 64) + F.tid, NT = (F.G - first_wg) * NWAVES * 64;
    for (int idx = gt; idx < M * 64; idx += NT) {
        const int m = idx >> 6, r = idx & 63, j = r >> 4, d8 = (r & 15) * 8;
        const float l0 = LSE[(size_t)m * 12 + j], l1 = LSE[(size_t)m * 12 + 4 + j], l2 = LSE[(size_t)m * 12 + 8 + j], mx = fmaxf(fmaxf(l0, l1), l2);
        float e0 = __expf(l0 - mx), e1 = __expf(l1 - mx), e2 = __expf(l2 - mx); const float inv = 1.f / (e0 + e1 + e2); e0 *= inv; e1 *= inv; e2 *= inv;
        const v4u a = *(const v4u*)(ATTO + (size_t)m * 1536 + j * 128 + d8), b = *(const v4u*)(ATTO + (size_t)m * 1536 + 512 + j * 128 + d8), c = *(const v4u*)(ATTO + (size_t)m * 1536 + 1024 + j * 128 + d8);
        v4u o;
        o.x = pk2(e0 * bflo(a.x) + e1 * bflo(b.x) + e2 * bflo(c.x), e0 * bfhi(a.x) + e1 * bfhi(b.x) + e2 * bfhi(c.x));
        o.y = pk2(e0 * bflo(a.y) + e1 * bflo(b.y) + e2 * bflo(c.y), e0 * bfhi(a.y) + e1 * bfhi(b.y) + e2 * bfhi(c.y));
        o.z = pk2(e0 * bflo(a.z) + e1 * bflo(b.z) + e2 * bflo(c.z), e0 * bfhi(a.z) + e1 * bfhi(b.z) + e2 * bfhi(c.z));
        o.w = pk2(e0 * bflo(a.w) + e1 * bflo(b.w) + e2 * bflo(c.w), e0 * bfhi(a.w) + e1 * bfhi(b.w) + e2 * bfhi(c.w));
        *(v4u*)(ATT + (size_t)m * 512 + j * 128 + d8) = o;
    }
}
__device__ __forceinline__ void mlstm_post(Frame& F, const float* norm_w) {
    const bf16* PROJ = (const bf16*)(F.ws + WS_PROJ); const float* NUM = (const float*)(F.ws + WS_NUM); const float* DEN = (const float*)(F.ws + WS_DEN); const float* MT = (const float*)(F.ws + WS_MT);
    bf16* HM = (bf16*)(F.ws + WS_HM);
    const int gw = F.vcu * NWAVES + F.wave, NGW = F.G * NWAVES;
    for (int it = gw; it < M * 4; it += NGW) {
        const int m = it >> 2, h = it & 3;
        const f32x4 nv = *(const f32x4*)(NUM + (size_t)m * 1024 + h * 256 + 4 * F.lane);
        const float den = DEN[(size_t)m * 4 + h], mt = MT[(size_t)m * 4 + h];
        const float dn = 1.f / fmaxf(fabsf(den), __expf(-mt));
        const f32x4 hv = nv * dn;
        const float mean = wave_sum((hv[0] + hv[1]) + (hv[2] + hv[3])) * (1.f / 256.f);
        const f32x4 dv = hv - mean;
        const float var = wave_sum((dv[0] * dv[0] + dv[1] * dv[1]) + (dv[2] * dv[2] + dv[3] * dv[3])) * (1.f / 256.f);
        const float rs = rsqrtf(var + LN_EPS);
        const f32x4 nw = *(const f32x4*)(norm_w + h * 256 + 4 * F.lane);
        const unsigned long long ow = *(const unsigned long long*)(PROJ + (size_t)m * NP + C_MO + h * 256 + 4 * F.lane);
        const unsigned w0 = (unsigned)ow, w1 = (unsigned)(ow >> 32);
        const float y0 = dv[0] * rs * nw[0] * sigm(bflo(w0)), y1 = dv[1] * rs * nw[1] * sigm(bfhi(w0)), y2 = dv[2] * rs * nw[2] * sigm(bflo(w1)), y3 = dv[3] * rs * nw[3] * sigm(bfhi(w1));
        *(unsigned long long*)(HM + (size_t)m * 1024 + h * 256 + 4 * F.lane) = (unsigned long long)pk2(y0, y1) | ((unsigned long long)pk2(y2, y3) << 32);
    }
}

__device__ __forceinline__ bf16x8 frag_g(const bf16* base, size_t pitch, int r0, int k0, int lane) { return *(const bf16x8*)(base + (size_t)(r0 + (lane & 15)) * pitch + k0 + 8 * (lane >> 4)); }
__device__ __forceinline__ float scan_add(float v, int lane) {
#pragma unroll
    for (int o = 1; o < 64; o <<= 1) { const float t = __shfl_up(v, o); if (lane >= o) v += t; }
    return v;
}
__device__ __forceinline__ float scan_max(float v, int lane) {
#pragma unroll
    for (int o = 1; o < 64; o <<= 1) { const float t = __shfl_up(v, o); if (lane >= o) v = fmaxf(v, t); }
    return v;
}
constexpr int VIMG_PITCH = 528, KIMG_PITCH = 272, QKIMG_PITCH = 144;
constexpr int L_VIMG = 0, L_KIMG = 33792, L_WK = 51200;
constexpr int L_QKIMG = 33792, L_GS = 43008, L_MX = 43264, L_BS = 43520, L_STAT = 43776;
__device__ __forceinline__ void mlstm_m1(Frame& F) {
    const bf16* PROJ = (const bf16*)(F.ws + WS_PROJ); const bf16* QKC = (const bf16*)(F.ws + WS_QKC); const float* MIF = (const float*)(F.ws + WS_MIF);
    float* KVT = (float*)(F.ws + WS_KVT); float* MLOC = (float*)(F.ws + WS_MSC); float* BLAST = MLOC + 1024; float* NLOC = (float*)(F.ws + WS_MSC + 65536);
    LAS unsigned char* Vimg = F.lds + L_VIMG; LAS unsigned char* Kimg = F.lds + L_KIMG; LAS float* wkL = (LAS float*)(F.lds + L_WK);
    for (int item = F.vcu; item < 512; item += F.G) {
        const int bh = item >> 6, c = item & 63, b = bh >> 2, h = bh & 3; const size_t row0 = (size_t)b * SEQ + (size_t)c * 64;
        __syncthreads();
        if (F.wave == 0) { const float lf = log_sigmoid(MIF[(row0 + F.lane) * 8 + 4 + h]), ip = MIF[(row0 + F.lane) * 8 + h];
            const float bs = scan_add(lf, F.lane), bl = __shfl(bs, 63), wl = bl - bs + ip, ml = wave_max(wl);
            wkL[F.lane] = __expf(wl - ml);
            if (F.lane == 0) { MLOC[item] = ml; BLAST[item] = bl; } }
        for (int idx = F.tid; idx < 2048; idx += NWAVES * 64) { const int s = idx >> 5, c8 = idx & 31;
            *(LAS v4u*)(Vimg + s * VIMG_PITCH + c8 * 16) = *(const v4u*)(PROJ + (row0 + s) * NP + C_MV + h * 256 + c8 * 8); }
        __syncthreads();
        for (int idx = F.tid; idx < 1024; idx += NWAVES * 64) { const int s = idx >> 4, c8 = idx & 15; const float wk = wkL[s];
            const v4u w = *(const v4u*)(QKC + (row0 + s) * 1024 + 512 + h * 128 + c8 * 8); v4u o;
            o.x = pk2(bflo(w.x) * wk, bfhi(w.x) * wk); o.y = pk2(bflo(w.y) * wk, bfhi(w.y) * wk); o.z = pk2(bflo(w.z) * wk, bfhi(w.z) * wk); o.w = pk2(bflo(w.w) * wk, bfhi(w.w) * wk);
            *(LAS v4u*)(Kimg + s * KIMG_PITCH + c8 * 16) = o; }
        __syncthreads();
        if (F.tid < 128) { float a = 0.f;
#pragma unroll 8
            for (int s = 0; s < 64; ++s) a += __uint_as_float((unsigned)(*(const LAS bf16*)(Kimg + s * KIMG_PITCH + F.tid * 2)) << 16);
            NLOC[(size_t)item * 128 + F.tid] = a; }
        f32x4 acc[2][8];
#pragma unroll
        for (int r = 0; r < 2; ++r)
#pragma unroll
            for (int ct = 0; ct < 8; ++ct) acc[r][ct] = (f32x4){0.f, 0.f, 0.f, 0.f};
#pragma unroll
        for (int ks = 0; ks < 2; ++ks) {
            const bf16x8 a0 = frag_tr(Vimg, VIMG_PITCH, 32 * ks, 32 * F.wave, F.lane), a1 = frag_tr(Vimg, VIMG_PITCH, 32 * ks, 32 * F.wave + 16, F.lane);
#pragma unroll
            for (int ct = 0; ct < 8; ++ct) { const bf16x8 bb = frag_tr(Kimg, KIMG_PITCH, 32 * ks, 16 * ct, F.lane);
                acc[0][ct] = __builtin_amdgcn_mfma_f32_16x16x32_bf16(a0, bb, acc[0][ct], 0, 0, 0); acc[1][ct] = __builtin_amdgcn_mfma_f32_16x16x32_bf16(a1, bb, acc[1][ct], 0, 0, 0); } }
        const int i = F.lane & 15, g = F.lane >> 4;
#pragma unroll
        for (int r = 0; r < 2; ++r)
#pragma unroll
            for (int ct = 0; ct < 8; ++ct)
#pragma unroll
                for (int q = 0; q < 4; ++q) KVT[((size_t)item * 256 + 32 * F.wave + 16 * r + 4 * g + q) * 128 + 16 * ct + i] = acc[r][ct][q];
    }
}
__device__ __forceinline__ void mlstm_m2(Frame& F) {
    const float* KVT = (const float*)(F.ws + WS_KVT); bf16* CPREV = (bf16*)(F.ws + WS_CPREV);
    const float* MLOC = (const float*)(F.ws + WS_MSC); const float* BLAST = MLOC + 1024; float* MPREV = (float*)(F.ws + WS_MSC) + 2048;
    const float* NLOC = (const float*)(F.ws + WS_MSC + 65536); float* NPREV = (float*)(F.ws + WS_MSC + 524288);
    const int gt = F.vcu * (NWAVES * 64) + F.tid, NT = F.G * NWAVES * 64;
    for (int p = gt; p < 8 * 256 * 64; p += NT) {
        const int bh = p >> 14, rem = p & 16383, v = rem >> 6, d2 = (rem & 63) * 2;
        float c0 = 0.f, c1 = 0.f, m = 0.f;
#pragma unroll 4
        for (int c = 0; c < 64; ++c) { const int item = bh * 64 + c; const size_t off = ((size_t)item * 256 + v) * 128 + d2;
            *(unsigned*)(CPREV + off) = pk2(c0, c1);
            const float2 kv = *(const float2*)(KVT + off);
            const float ml = MLOC[item], bl = BLAST[item], mn = fmaxf(bl + m, ml), dec = __expf(bl + m - mn), sc = __expf(ml - mn); m = mn;
            c0 = dec * c0 + sc * kv.x; c1 = dec * c1 + sc * kv.y; }
    }
    if (gt < 8 * 128) { const int bh = gt >> 7, d = gt & 127; float n = 0.f, m = 0.f;
        for (int c = 0; c < 64; ++c) { const int item = bh * 64 + c;
            NPREV[(size_t)item * 128 + d] = n; if (d == 0) MPREV[item] = m;
            const float ml = MLOC[item], bl = BLAST[item], mn = fmaxf(bl + m, ml), dec = __expf(bl + m - mn), sc = __expf(ml - mn); m = mn;
            n = dec * n + sc * NLOC[(size_t)item * 128 + d]; } }
}
__device__ __forceinline__ void mlstm_m3(Frame& F, const float* norm_w) {
    const bf16* PROJ = (const bf16*)(F.ws + WS_PROJ); const bf16* QKC = (const bf16*)(F.ws + WS_QKC); const float* MIF = (const float*)(F.ws + WS_MIF);
    const bf16* CPREV = (const bf16*)(F.ws + WS_CPREV); const float* MPREV = (const float*)(F.ws + WS_MSC) + 2048; const float* NPREV = (const float*)(F.ws + WS_MSC + 524288);
    bf16* HM = (bf16*)(F.ws + WS_HM);
    LAS unsigned char* Vimg = F.lds + L_VIMG; LAS unsigned char* QKimg = F.lds + L_QKIMG;
    LAS float* gsL = (LAS float*)(F.lds + L_GS); LAS float* mxL = (LAS float*)(F.lds + L_MX); LAS float* bsL = (LAS float*)(F.lds + L_BS); LAS float* stL = (LAS float*)(F.lds + L_STAT);
    const int i = F.lane & 15, g = F.lane >> 4, rt = F.wave & 3, ch = F.wave >> 2;
    for (int item = F.vcu; item < 512; item += F.G) {
        const int bh = item >> 6, c = item & 63, b = bh >> 2, h = bh & 3; const size_t row0 = (size_t)b * SEQ + (size_t)c * 64;
        __syncthreads();
        const float mprev = MPREV[item];
        if (F.wave == 0) { const float lf = log_sigmoid(MIF[(row0 + F.lane) * 8 + 4 + h]), ip = MIF[(row0 + F.lane) * 8 + h];
            const float bs = scan_add(lf, F.lane), gv = ip - bs, pm = scan_max(gv, F.lane);
            gsL[F.lane] = gv; mxL[F.lane] = fmaxf(mprev, pm); bsL[F.lane] = bs; }
        for (int idx = F.tid; idx < 2048; idx += NWAVES * 64) { const int s = idx >> 5, c8 = idx & 31;
            *(LAS v4u*)(Vimg + s * VIMG_PITCH + c8 * 16) = *(const v4u*)(PROJ + (row0 + s) * NP + C_MV + h * 256 + c8 * 8); }
        bf16x8 qf[4];
#pragma unroll
        for (int ks = 0; ks < 4; ++ks) qf[ks] = frag_g(QKC + h * 128, 1024, (int)row0 + 16 * rt, 32 * ks, F.lane);
        __syncthreads();
#pragma unroll
        for (int cc = 0; cc < 2; ++cc) { const int ct = 2 * ch + cc; f32x4 sv = (f32x4){0.f, 0.f, 0.f, 0.f};
            if (ct <= rt) {
#pragma unroll
                for (int ks = 0; ks < 4; ++ks) { const bf16x8 kf = frag_g(QKC + 512 + h * 128, 1024, (int)row0 + 16 * ct, 32 * ks, F.lane); sv = __builtin_amdgcn_mfma_f32_16x16x32_bf16(qf[ks], kf, sv, 0, 0, 0); } }
            const int sidx = 16 * ct + i; const float gsv = gsL[sidx];
#pragma unroll
            for (int q = 0; q < 4; ++q) { const int l = 16 * rt + 4 * g + q; const float val = (sidx <= l) ? sv[q] * QSCALE * __expf(gsv - mxL[l]) : 0.f;
                *(LAS bf16*)(QKimg + l * QKIMG_PITCH + sidx * 2) = (bf16)f2bf(val); } }
        __syncthreads();
        bf16x8 pf[2];
#pragma unroll
        for (int ks = 0; ks < 2; ++ks) pf[ks] = *(const LAS bf16x8*)(QKimg + (16 * rt + i) * QKIMG_PITCH + (32 * ks + 8 * g) * 2);
        f32x4 accs = (f32x4){0.f, 0.f, 0.f, 0.f}, accn = (f32x4){0.f, 0.f, 0.f, 0.f};
        { const bf16x8 ones = (bf16x8){0x3F80, 0x3F80, 0x3F80, 0x3F80, 0x3F80, 0x3F80, 0x3F80, 0x3F80};
#pragma unroll
          for (int ks = 0; ks < 2; ++ks) accs = __builtin_amdgcn_mfma_f32_16x16x32_bf16(pf[ks], ones, accs, 0, 0, 0);
#pragma unroll
          for (int ks = 0; ks < 4; ++ks) { const float* np = NPREV + (size_t)item * 128 + 32 * ks + 8 * g; const f32x4 n0 = *(const f32x4*)np, n1 = *(const f32x4*)(np + 4);
              union { bf16x8 v; unsigned u[4]; } nf; nf.u[0] = pk2(n0[0], n0[1]); nf.u[1] = pk2(n0[2], n0[3]); nf.u[2] = pk2(n1[0], n1[1]); nf.u[3] = pk2(n1[2], n1[3]);
              accn = __builtin_amdgcn_mfma_f32_16x16x32_bf16(qf[ks], nf.v, accn, 0, 0, 0); } }
        f32x4 a1[8], a2[8];
#pragma unroll
        for (int ct = 0; ct < 8; ++ct) { a1[ct] = (f32x4){0.f, 0.f, 0.f, 0.f}; a2[ct] = (f32x4){0.f, 0.f, 0.f, 0.f}; }
        const bf16* cp = CPREV + (size_t)item * 256 * 128;
#pragma unroll
        for (int ct = 0; ct < 8; ++ct) { const int vcol = 128 * ch + 16 * ct;
#pragma unroll
            for (int ks = 0; ks < 4; ++ks) { const bf16x8 cf = frag_g(cp, 128, vcol, 32 * ks, F.lane); a1[ct] = __builtin_amdgcn_mfma_f32_16x16x32_bf16(qf[ks], cf, a1[ct], 0, 0, 0); }
#pragma unroll
            for (int ks = 0; ks < 2; ++ks) { const bf16x8 vf = frag_tr(Vimg, VIMG_PITCH, 32 * ks, vcol, F.lane); a2[ct] = __builtin_amdgcn_mfma_f32_16x16x32_bf16(pf[ks], vf, a2[ct], 0, 0, 0); } }
        float s1[4], s2[4];
#pragma unroll
        for (int q = 0; q < 4; ++q) { const int l = 16 * rt + 4 * g + q; const float mx = mxL[l], wi = __expf(mprev - mx) * QSCALE, mt = bsL[l] + mx;
            const float den = wi * accn[q] + accs[q], dn = 1.f / fmaxf(fabsf(den), __expf(-mt)); float a = 0.f, bq = 0.f;
#pragma unroll
            for (int ct = 0; ct < 8; ++ct) { const float hv = (wi * a1[ct][q] + a2[ct][q]) * dn; a1[ct][q] = hv; a += hv; bq += hv * hv; }
            a += __shfl_xor(a, 1); a += __shfl_xor(a, 2); a += __shfl_xor(a, 4); a += __shfl_xor(a, 8);
            bq += __shfl_xor(bq, 1); bq += __shfl_xor(bq, 2); bq += __shfl_xor(bq, 4); bq += __shfl_xor(bq, 8);
            s1[q] = a; s2[q] = bq;
            if (i == 0) { stL[(l * 2 + ch) * 2] = a; stL[(l * 2 + ch) * 2 + 1] = bq; } }
        __syncthreads();
#pragma unroll
        for (int q = 0; q < 4; ++q) { const int l = 16 * rt + 4 * g + q; const float sa = stL[(l * 2) * 2] + stL[(l * 2 + 1) * 2], qa = stL[(l * 2) * 2 + 1] + stL[(l * 2 + 1) * 2 + 1];
            const float mean = sa * (1.f / 256.f), var = qa * (1.f / 256.f) - mean * mean, rs = rsqrtf(fmaxf(var, 0.f) + LN_EPS);
            const size_t m = row0 + l;
#pragma unroll
            for (int ct = 0; ct < 8; ++ct) { const int v = 128 * ch + 16 * ct + i;
                const float og = __uint_as_float((unsigned)PROJ[m * NP + C_MO + h * 256 + v] << 16);
                HM[m * 1024 + h * 256 + v] = (bf16)f2bf((a1[ct][q] - mean) * rs * norm_w[h * 256 + v] * sigm(og)); } }
        (void)s1; (void)s2;
    }
}

__device__ __forceinline__ bf16x8 frag_vt(const LAS unsigned char* Vimg, int row0a, int row0b, int dcol0, int lane) {
    const int i = lane & 15, g = lane >> 4, q = i >> 2, gi = (dcol0 >> 2) + (i & 3);
    const int ra = row0a + 4 * g + q, rb = row0b + 4 * g + q;
    const s16x4 a = __builtin_amdgcn_ds_read_tr16_b64_v4i16((LAS s16x4*)(Vimg + ra * 256 + ((gi ^ ((ra & 7) << 2)) << 3)));
    const s16x4 b = __builtin_amdgcn_ds_read_tr16_b64_v4i16((LAS s16x4*)(Vimg + rb * 256 + ((gi ^ ((rb & 7) << 2)) << 3)));
    return (bf16x8){a[0], a[1], a[2], a[3], b[0], b[1], b[2], b[3]};
}
__device__ __forceinline__ void attn_mfma(Frame& F) {
    const bf16* PROJ = (const bf16*)(F.ws + WS_PROJ); bf16* ATTO = (bf16*)(F.ws + WS_ATTO); float* LSE = (float*)(F.ws + WS_LSE);
    LAS unsigned char* Vimg = F.lds + RING_OFF;
    const int i = F.lane & 15, g = F.lane >> 4, w = F.wave;
    for (int it = F.vcu; it < 768; it += F.G) {
        const int grp = it >> 8, r1 = it & 255, b = r1 >> 7, hh = (r1 >> 5) & 3, rest = r1 & 31;
        const int rd = grp == 0 ? 1 : (grp == 1 ? 4 : 16), nb = 32 / rd, p = rest / nb, n = rest % nb, h = grp * 4 + hh;
        const float sl = alibi_slope(h) * (float)rd;
        const size_t tok0 = (size_t)b * SEQ + p;
        __syncthreads();
        for (int idx = F.tid; idx < 4096; idx += NWAVES * 64) { const int ki = idx >> 4, cj = idx & 15, u = (n - 1) * 128 + ki; v4u val = (v4u){0u, 0u, 0u, 0u};
            if (u >= 0) val = *(const v4u*)(PROJ + (tok0 + (size_t)u * rd) * NP + C_AV + h * 128 + cj * 8);
            *(LAS v4u*)(Vimg + ki * 256 + ((cj ^ ((ki & 7) << 1)) << 4)) = val; }
        const int qi = 16 * w + i; const size_t qtok = tok0 + (size_t)(128 * n + qi) * rd;
        bf16x8 qf[4];
#pragma unroll
        for (int ks = 0; ks < 4; ++ks) qf[ks] = *(const bf16x8*)(PROJ + qtok * NP + C_AQ + h * 128 + 32 * ks + 8 * g);
        f32x4 sv[10];
#pragma unroll
        for (int j = 0; j < 9; ++j) { sv[j] = (f32x4){0.f, 0.f, 0.f, 0.f}; int u = (n - 1) * 128 + 16 * (w + j) + i; u = u < 0 ? 0 : u;
            const bf16* kp = PROJ + (tok0 + (size_t)u * rd) * NP + C_AK + h * 128 + 8 * g;
#pragma unroll
            for (int ks = 0; ks < 4; ++ks) { const bf16x8 kf = *(const bf16x8*)(kp + 32 * ks); sv[j] = __builtin_amdgcn_mfma_f32_16x16x32_bf16(kf, qf[ks], sv[j], 0, 0, 0); } }
        sv[9] = (f32x4){0.f, 0.f, 0.f, 0.f};
        float mx = -INFINITY;
#pragma unroll
        for (int j = 0; j < 9; ++j)
#pragma unroll
            for (int q = 0; q < 4; ++q) { const int ki = 16 * (w + j) + 4 * g + q, delta = 128 + qi - ki; const bool valid = delta >= 0 && delta <= 128 && (n > 0 || ki >= 128);
                const float s = valid ? sv[j][q] * QSCALE - sl * (float)delta : -INFINITY; sv[j][q] = s; mx = fmaxf(mx, s); }
        mx = fmaxf(mx, __shfl_xor(mx, 16)); mx = fmaxf(mx, __shfl_xor(mx, 32));
        float l = 0.f;
#pragma unroll
        for (int j = 0; j < 9; ++j)
#pragma unroll
            for (int q = 0; q < 4; ++q) { const float pv = (sv[j][q] == -INFINITY) ? 0.f : __expf(sv[j][q] - mx); sv[j][q] = pv; l += pv; }
        l += __shfl_xor(l, 16); l += __shfl_xor(l, 32);
        bf16x8 pf[5];
#pragma unroll
        for (int st = 0; st < 5; ++st) { union { bf16x8 v; unsigned u[4]; } t; t.u[0] = pk2(sv[2 * st][0], sv[2 * st][1]); t.u[1] = pk2(sv[2 * st][2], sv[2 * st][3]);
            t.u[2] = pk2(sv[2 * st + 1][0], sv[2 * st + 1][1]); t.u[3] = pk2(sv[2 * st + 1][2], sv[2 * st + 1][3]); pf[st] = t.v; }
        __syncthreads();
        f32x4 o[8];
#pragma unroll
        for (int dt = 0; dt < 8; ++dt) o[dt] = (f32x4){0.f, 0.f, 0.f, 0.f};
#pragma unroll
        for (int st = 0; st < 5; ++st) { const int T0 = w + 2 * st, T1 = (T0 + 1) > 15 ? 15 : (T0 + 1);
#pragma unroll
            for (int dt = 0; dt < 8; ++dt) { const bf16x8 vf = frag_vt(Vimg, 16 * T0, 16 * T1, 16 * dt, F.lane); o[dt] = __builtin_amdgcn_mfma_f32_16x16x32_bf16(vf, pf[st], o[dt], 0, 0, 0); } }
        const float il = 1.f / l;
#pragma unroll
        for (int dt = 0; dt < 8; ++dt)
            *(unsigned long long*)(ATTO + qtok * 1536 + h * 128 + 16 * dt + 4 * g) = (unsigned long long)pk2(o[dt][0] * il, o[dt][1] * il) | ((unsigned long long)pk2(o[dt][2] * il, o[dt][3] * il) << 32);
        if (g == 0) LSE[qtok * 12 + h] = mx + __logf(l);
    }
}
__device__ __forceinline__ void ln1_router(Frame& F, const float* g1, const float* b1, const float* brg, const float* bre) {
    const float* PRE = (const float*)(F.ws + WS_TMP); float* H1 = (float*)(F.ws + WS_H1); bf16* H1B = (bf16*)(F.ws + WS_H1B);
    const bf16* WRH = (const bf16*)(F.ws + WS_WRT); const bf16* WRL = WRH + 48 * D;
    int* TOKLIST = (int*)(F.ws + WS_TOKLIST); int* TOKINFO = (int*)(F.ws + WS_TOKINFO);
    LAS float* part = (LAS float*)(F.lds + RING_OFF);
    const int i = F.lane & 15, g = F.lane >> 4;
    for (int R0 = 32 * F.vcu; R0 < M; R0 += 32 * F.G) {
        __syncthreads();
        for (int rr = 0; rr < 4; ++rr) { const int m = R0 + 4 * F.wave + rr;
            const f32x4* xr = (const f32x4*)(PRE + (size_t)m * D) + F.lane;
            f32x4 v[8]; float s = 0.f;
#pragma unroll
            for (int j = 0; j < 8; ++j) { v[j] = xr[64 * j]; s += (v[j][0] + v[j][1]) + (v[j][2] + v[j][3]); }
            const float mean = wave_sum(s) * (1.f / D); float s2 = 0.f;
#pragma unroll
            for (int j = 0; j < 8; ++j) { const f32x4 d = v[j] - mean; s2 += (d[0] * d[0] + d[1] * d[1]) + (d[2] * d[2] + d[3] * d[3]); }
            const float rstd = rsqrtf(wave_sum(s2) * (1.f / D) + LN_EPS);
            f32x4* h1r = (f32x4*)(H1 + (size_t)m * D) + F.lane; unsigned long long* o8 = (unsigned long long*)(H1B + (size_t)m * D) + F.lane;
#pragma unroll
            for (int j = 0; j < 8; ++j) { const int k0 = 4 * F.lane + 256 * j; const f32x4 g4 = *(const f32x4*)(g1 + k0), b4 = *(const f32x4*)(b1 + k0);
                const f32x4 hv = (v[j] - mean) * rstd * g4 + b4;
                h1r[64 * j] = hv; o8[64 * j] = (unsigned long long)pk2(hv[0], hv[1]) | ((unsigned long long)pk2(hv[2], hv[3]) << 32); } }
        VM_WAIT(); __syncthreads();
        { const int rtile = F.wave & 1, kq = F.wave >> 1; f32x4 acc[3];
#pragma unroll
          for (int ct = 0; ct < 3; ++ct) acc[ct] = (f32x4){0.f, 0.f, 0.f, 0.f};
          const float* hp = H1 + (size_t)(R0 + 16 * rtile + i) * D + 512 * kq + 8 * g;
#pragma unroll 4
          for (int ks = 0; ks < 16; ++ks) { const f32x4 x0 = *(const f32x4*)(hp + 32 * ks), x1 = *(const f32x4*)(hp + 32 * ks + 4);
              union { bf16x8 v; unsigned u[4]; } ah, al;
              ah.u[0] = pk2(x0[0], x0[1]); ah.u[1] = pk2(x0[2], x0[3]); ah.u[2] = pk2(x1[0], x1[1]); ah.u[3] = pk2(x1[2], x1[3]);
              al.u[0] = pk2(x0[0] - bflo(ah.u[0]), x0[1] - bfhi(ah.u[0])); al.u[1] = pk2(x0[2] - bflo(ah.u[1]), x0[3] - bfhi(ah.u[1]));
              al.u[2] = pk2(x1[0] - bflo(ah.u[2]), x1[1] - bfhi(ah.u[2])); al.u[3] = pk2(x1[2] - bflo(ah.u[3]), x1[3] - bfhi(ah.u[3]));
#pragma unroll
              for (int ct = 0; ct < 3; ++ct) { const size_t wo = (size_t)(16 * ct + i) * D + 512 * kq + 32 * ks + 8 * g;
                  const bf16x8 bh = *(const bf16x8*)(WRH + wo), bl = *(const bf16x8*)(WRL + wo);
                  acc[ct] = __builtin_amdgcn_mfma_f32_16x16x32_bf16(ah.v, bh, acc[ct], 0, 0, 0);
                  acc[ct] = __builtin_amdgcn_mfma_f32_16x16x32_bf16(al.v, bh, acc[ct], 0, 0, 0);
                  acc[ct] = __builtin_amdgcn_mfma_f32_16x16x32_bf16(ah.v, bl, acc[ct], 0, 0, 0); } }
#pragma unroll
          for (int ct = 0; ct < 3; ++ct)
#pragma unroll
              for (int q = 0; q < 4; ++q) part[(kq * 32 + 16 * rtile + 4 * g + q) * 48 + 16 * ct + i] = acc[ct][q]; }
        __syncthreads();
        if (F.tid < 32) { const int m = R0 + F.tid;
            float ae[32], ag[4];
#pragma unroll
            for (int e = 0; e < 32; ++e) ae[e] = ((part[(0 * 32 + F.tid) * 48 + e] + part[(1 * 32 + F.tid) * 48 + e]) + (part[(2 * 32 + F.tid) * 48 + e] + part[(3 * 32 + F.tid) * 48 + e])) + bre[e];
#pragma unroll
            for (int e = 0; e < 4; ++e) ag[e] = ((part[(0 * 32 + F.tid) * 48 + 32 + e] + part[(1 * 32 + F.tid) * 48 + 32 + e]) + (part[(2 * 32 + F.tid) * 48 + 32 + e] + part[(3 * 32 + F.tid) * 48 + 32 + e])) + brg[e];
            int grp = 0; float gm = ag[0];
#pragma unroll
            for (int e = 1; e < 4; ++e) if (ag[e] > gm) { gm = ag[e]; grp = e; }
            float gs = 0.f;
#pragma unroll
            for (int e = 0; e < 4; ++e) gs += __expf(ag[e] - gm);
            const float gwt = 1.f / gs;
            float el[8];
#pragma unroll
            for (int e = 0; e < 8; ++e) el[e] = grp == 0 ? ae[e] : (grp == 1 ? ae[8 + e] : (grp == 2 ? ae[16 + e] : ae[24 + e]));
            int i1 = 0; float v1 = el[0];
#pragma unroll
            for (int e = 1; e < 8; ++e) if (el[e] > v1) { v1 = el[e]; i1 = e; }
            int i2 = 0; float v2 = -INFINITY;
#pragma unroll
            for (int e = 0; e < 8; ++e) if (e != i1 && el[e] > v2) { v2 = el[e]; i2 = e; }
            const float ex = __expf(v2 - v1), p1 = 1.f / (1.f + ex), p2 = ex * p1;
            const int e1 = grp * 8 + i1, e2 = grp * 8 + i2;
            const int pos1 = (int)__hip_atomic_fetch_add(F.ctl + CW_CNT + 16 * e1, 1u, RLX_AGENT), pos2 = (int)__hip_atomic_fetch_add(F.ctl + CW_CNT + 16 * e2, 1u, RLX_AGENT);
            TOKLIST[e1 * ECAP + pos1] = m; TOKLIST[e2 * ECAP + pos2] = m;
            int* ti = TOKINFO + (size_t)m * 8; ti[0] = e1; ti[1] = pos1; ti[2] = e2; ti[3] = pos2; ti[4] = __float_as_int(gwt * p1); ti[5] = __float_as_int(gwt * p2);
        }
    }
}
struct MoeOrder {
    const LAS int* TS; const LAS int* CN; const int* toklist; int NT, G, c, U; bool gather;
    __device__ __forceinline__ void init(const LAS int* ts, const LAS int* cn, const int* tl, int nt, int G_, int c_, bool ga) { TS = ts; CN = cn; toklist = tl; NT = nt; G = G_; c = c_; U = ts[NE] * nt; gather = ga; }
    __device__ __forceinline__ bool next(int i, pg8::Unit& u) const {
        const int x = c & 7, r = c >> 3, W = G >> 3;
        const int lo = (int)(((long)U * x) >> 3), hi = (int)(((long)U * (x + 1)) >> 3);
        const int L = lo + r + i * W; if (L >= hi) return false;
        int e = 0;
#pragma unroll 1
        for (int k = 1; k < NE; ++k) if (L >= TS[k] * NT) e = k;
        const int ne = TS[e + 1] - TS[e], loc = L - TS[e] * NT, n_t = loc / ne, m_t = loc % ne;
        u.pm = TS[e] + m_t; u.pn = e * NT + n_t; u.e = e; u.r0 = m_t * 256; return true;
    }
    __device__ __forceinline__ int arow(const pg8::Unit& u, int r) const {
        if (!gather) return u.pm * 256 + r;
        int idx = u.r0 + r; const int cn = CN[u.e]; idx = idx < cn ? idx : cn - 1;
        return toklist[u.e * ECAP + idx];
    }
    __device__ __forceinline__ void a_ready(const pg8::Unit&) const {}
    __device__ __forceinline__ void done(const pg8::Unit&) const {}
};
__device__ __forceinline__ void moe_tables(Frame& F) {
    LAS int* TS = (LAS int*)(F.lds + TS_OFF); LAS int* CN = (LAS int*)(F.lds + CNT_OFF);
    if (F.tid < NE) CN[F.tid] = (int)__hip_atomic_load(F.ctl + CW_CNT + 16 * F.tid, RLX_AGENT);
    __syncthreads();
    if (F.tid == 0) { int acc = 0; for (int e = 0; e < NE; ++e) { TS[e] = acc; acc += (CN[e] + 255) >> 8; } TS[NE] = acc; }
    __syncthreads();
}
__device__ __forceinline__ void final_ln(Frame& F, const float* g2, const float* b2, float* out) {
    const float* H1 = (const float*)(F.ws + WS_H1); const bf16* YS = (const bf16*)(F.ws + WS_YS); const int* TOKINFO = (const int*)(F.ws + WS_TOKINFO);
    const LAS int* TS = (const LAS int*)(F.lds + TS_OFF);
    const int gw = F.vcu * NWAVES + F.wave, NGW = F.G * NWAVES;
    for (int m = gw; m < M; m += NGW) {
        const int* ti = TOKINFO + (size_t)m * 8;
        const int e1 = ti[0], p1 = ti[1], e2 = ti[2], p2 = ti[3]; const float w1 = __int_as_float(ti[4]), w2 = __int_as_float(ti[5]);
        const size_t sl1 = (size_t)TS[e1] * 256 + p1, sl2 = (size_t)TS[e2] * 256 + p2;
        const f32x4* hr = (const f32x4*)(H1 + (size_t)m * D) + F.lane;
        const unsigned long long* y1 = (const unsigned long long*)(YS + sl1 * D) + F.lane; const unsigned long long* y2 = (const unsigned long long*)(YS + sl2 * D) + F.lane;
        f32x4 v[8]; float s = 0.f;
#pragma unroll
        for (int j = 0; j < 8; ++j) { const f32x4 hv = hr[64 * j]; const unsigned long long a = y1[64 * j], b = y2[64 * j];
            const unsigned a0 = (unsigned)a, a1 = (unsigned)(a >> 32), b0 = (unsigned)b, b1 = (unsigned)(b >> 32);
            f32x4 y; y[0] = w1 * bflo(a0) + w2 * bflo(b0); y[1] = w1 * bfhi(a0) + w2 * bfhi(b0); y[2] = w1 * bflo(a1) + w2 * bflo(b1); y[3] = w1 * bfhi(a1) + w2 * bfhi(b1);
            v[j] = hv * ALPHA + y; s += (v[j][0] + v[j][1]) + (v[j][2] + v[j][3]); }
        const float mean = wave_sum(s) * (1.f / D); float s2 = 0.f;
#pragma unroll
        for (int j = 0; j < 8; ++j) { const f32x4 d = v[j] - mean; s2 += (d[0] * d[0] + d[1] * d[1]) + (d[2] * d[2] + d[3] * d[3]); }
        const float rstd = rsqrtf(wave_sum(s2) * (1.f / D) + LN_EPS);
        f32x4* orow = (f32x4*)(out + (size_t)m * D) + F.lane;
#pragma unroll
        for (int j = 0; j < 8; ++j) { const int k0 = 4 * F.lane + 256 * j; const f32x4 g4 = *(const f32x4*)(g2 + k0), b4 = *(const f32x4*)(b2 + k0);
            orow[64 * j] = (v[j] - mean) * rstd * g4 + b4; }
    }
}

#ifndef SKIPMASK
#define SKIPMASK 0
#endif
#ifndef ATTN_NAIVE
#define ATTN_NAIVE 0
#endif
#ifndef NCONV_PER_XCD
#define NCONV_PER_XCD 16
#endif
#ifndef MLSTM_NAIVE
#define MLSTM_NAIVE 0
#endif
#ifndef DUPMASK
#define DUPMASK 0
#endif
constexpr int N_PHASES = 12;
struct Args { const float* in[22]; float* out; unsigned char* ws; int ph_lo, ph_hi, li, pad; };
__global__ void __launch_bounds__(NWAVES * 64, 2) fwd_kernel(Args args) {
    extern __shared__ __attribute__((aligned(16))) unsigned char lds[];
    Frame F;
    F.lds = (LAS unsigned char*)lds;
    F.tid = threadIdx.x; F.lane = F.tid & 63; F.wave = __builtin_amdgcn_readfirstlane(F.tid >> 6);
    F.G = gridDim.x; { const int bx = blockIdx.x; F.vcu = (F.G % 8 == 0) ? (bx % 8) * (F.G / 8) + bx / 8 : bx; }
    F.ws = args.ws; F.ctl = (gu32*)(args.ws + WS_CTL);
    for (int u = F.tid; u < (LDS_BYTES - LDSCTL_OFF) / 4; u += NWAVES * 64) ((LAS unsigned*)(F.lds + LDSCTL_OFF))[u] = 0u;
    __syncthreads();
    XcdBarrier bar = xcd_barrier_post((unsigned*)(F.ctl + CW_BAR) + args.li * XCD_BAR_WORDS, (volatile LAS unsigned*)(F.lds + MISC_OFF) + 8);
    const int lo = args.ph_lo, hi = args.ph_hi;
#define IN(k) (lo <= (k) && (k) < hi && !(SKIPMASK & (1 << (k))))
#define REP(k) for (int rep_ = 0; rep_ < ((DUPMASK >> (k)) & 1) + 1; ++rep_)
#define SEAM(k) do { if (lo <= (k) && (k) + 1 < hi) xcd_barrier(bar); } while (0)
    unsigned char* ws = args.ws;
    if (IN(0)) REP(0) { p0_prologue(F, args.in[0], args.in[1], args.in[2], args.in[3], args.in[6], args.in[8], args.in[9], args.in[10], args.in[13], args.in[15]); __syncthreads(); }
    SEAM(0);
    if (IN(1)) {
        const int bx = (int)blockIdx.x, rank = bx >> 3;
        if (NCONV_PER_XCD > 0 && (rank % (32 / NCONV_PER_XCD)) == (32 / NCONV_PER_XCD) - 1) {
            moe_convert(F, (bx & 7) * NCONV_PER_XCD + rank / (32 / NCONV_PER_XCD), 8 * NCONV_PER_XCD, args.in[17], args.in[18], args.in[19]); __syncthreads(); }
        pg8::Gemm g{(const bf16*)(ws + WS_HB), (const bf16*)(ws + WS_WIN), M, NP, D};
        QueueOrder S; S.init(M, NP, bx, F.ctl + CW_Q, (volatile LAS int*)(F.lds + QSLOT_OFF));
        pg8::EpiBf16 E{(bf16*)(ws + WS_PROJ), NP};
        pg8::gemm_phase<pg8::EpiBf16, QueueOrder, true, true>(F.lds + RING_OFF, g, S, E); }
    SEAM(1);
#if ATTN_NAIVE
    if (IN(2)) REP(2) { conv_qk(F, args.in[4], args.in[5]); attn_naive(F); }
#else
    if (IN(2)) REP(2) { conv_qk(F, args.in[4], args.in[5]); attn_mfma(F); }
#endif
    SEAM(2);
#if MLSTM_NAIVE
    if (IN(3)) { if (F.vcu < 8) mlstm_naive(F, F.vcu); else attn_merge(F, 8); }
    SEAM(3);
    if (IN(4)) { mlstm_post(F, args.in[7]); }
    SEAM(4);
    SEAM(5);
#else
    if (IN(3)) REP(3) { mlstm_m1(F); attn_merge(F, 0); }
    SEAM(3);
    if (IN(4)) REP(4) { mlstm_m2(F); }
    SEAM(4);
    if (IN(5)) REP(5) { mlstm_m3(F, args.in[7]); }
    SEAM(5);
#endif
    if (IN(6)) REP(6) {
        { pg8::Gemm g{(const bf16*)(ws + WS_ATT), (const bf16*)(ws + WS_WPA), M, D, 512}; pg8::StaticOrder S; S.init(M, D, F.G, (int)blockIdx.x);
          pg8::EpiGateA E{(float*)(ws + WS_TMP), D, (const bf16*)(ws + WS_PROJ) + C_GATE, NP};
          pg8::gemm_phase<pg8::EpiGateA, pg8::StaticOrder, true, true>(F.lds + RING_OFF, g, S, E); }
        { pg8::Gemm g{(const bf16*)(ws + WS_HM), (const bf16*)(ws + WS_WPM), M, D, 1024}; pg8::StaticOrder S; S.init(M, D, F.G, (int)blockIdx.x);
          pg8::EpiGateB E{(bf16*)(ws + WS_MERGED), (const float*)(ws + WS_TMP), D, (const bf16*)(ws + WS_PROJ) + C_GATE + D, NP};
          pg8::gemm_phase<pg8::EpiGateB, pg8::StaticOrder, true, true>(F.lds + RING_OFF, g, S, E); }
    }
    SEAM(6);
    if (IN(7)) REP(7) { pg8::Gemm g{(const bf16*)(ws + WS_MERGED), (const bf16*)(ws + WS_WOUT), M, D, D}; pg8::StaticOrder S; S.init(M, D, F.G, (int)blockIdx.x);
        pg8::EpiResid E{(float*)(ws + WS_TMP), D, args.in[0], (const float*)(ws + WS_STATS), args.in[1], args.in[2], ALPHA};
        pg8::gemm_phase<pg8::EpiResid, pg8::StaticOrder, true, true>(F.lds + RING_OFF, g, S, E); }
    SEAM(7);
    if (IN(8)) { ln1_router(F, args.in[11], args.in[12], args.in[14], args.in[16]); }
    SEAM(8);
    if (IN(9) || IN(10) || IN(11)) moe_tables(F);
    if (IN(9)) REP(9) { pg8::Gemm g{(const bf16*)(ws + WS_H1B), (const bf16*)(ws + WS_WGU), M, NE * 2 * DFF, D};
        MoeOrder S; S.init((const LAS int*)(F.lds + TS_OFF), (const LAS int*)(F.lds + CNT_OFF), (const int*)(ws + WS_TOKLIST), NT1, F.G, (int)blockIdx.x, true);
        pg8::EpiSwiGlu E{(bf16*)(ws + WS_ACT), DFF, NT1};
        pg8::gemm_phase<pg8::EpiSwiGlu, MoeOrder, true, true>(F.lds + RING_OFF, g, S, E); }
    SEAM(9);
    if (IN(10)) REP(10) { pg8::Gemm g{(const bf16*)(ws + WS_ACT), (const bf16*)(ws + WS_WD), MAXT * 256, NE * D, DFF};
        MoeOrder S; S.init((const LAS int*)(F.lds + TS_OFF), (const LAS int*)(F.lds + CNT_OFF), (const int*)(ws + WS_TOKLIST), NT2, F.G, (int)blockIdx.x, false);
        pg8::EpiBf16Grp E{(bf16*)(ws + WS_YS), D, NT2};
        pg8::gemm_phase<pg8::EpiBf16Grp, MoeOrder, true, true>(F.lds + RING_OFF, g, S, E); }
    SEAM(10);
    if (IN(11)) REP(11) { final_ln(F, args.in[20], args.in[21], args.out); }
#undef IN
#undef SEAM
#undef REP
}

#ifndef MK_PER_PHASE
#define MK_PER_PHASE 0
#endif
extern "C" void kernel_launch(void* const* d_in, const int* in_sizes, int n_in, void* d_out, int out_size, void* d_ws, size_t ws_size, hipStream_t stream) {
    static int grid = 0;
    if (grid == 0) {
        if (n_in != 22 || out_size != M * D || ws_size < WS_END) { fprintf(stderr, "kernel_launch: unexpected problem: n_in %d out %d ws %zu\n", n_in, out_size, ws_size); grid = -1; return; }
        int dev = 0, cus = 0, per_cu = 0;
        if (hipGetDevice(&dev) != hipSuccess || hipDeviceGetAttribute(&cus, hipDeviceAttributeMultiprocessorCount, dev) != hipSuccess) { grid = -1; return; }
        if (hipFuncSetAttribute((const void*)fwd_kernel, hipFuncAttributeMaxDynamicSharedMemorySize, LDS_BYTES) != hipSuccess) { fprintf(stderr, "kernel_launch: hipFuncSetAttribute failed\n"); grid = -1; return; }
        if (hipOccupancyMaxActiveBlocksPerMultiprocessor(&per_cu, (const void*)fwd_kernel, NWAVES * 64, LDS_BYTES) != hipSuccess || per_cu < 1)
            fprintf(stderr, "kernel_launch: note: occupancy query reports %d workgroups per CU\n", per_cu);
        (void)hipGetLastError();
        grid = cus - (cus % 8);
        if (grid < 16) grid = 16;
    }
    if (grid < 0) return;
    (void)hipMemsetAsync((char*)d_ws + WS_CTL, 0, CTL_ZERO_BYTES, stream);
    Args a{};
    for (int i = 0; i < 22; ++i) a.in[i] = (const float*)d_in[i];
    a.out = (float*)d_out; a.ws = (unsigned char*)d_ws; a.pad = 0;
#if MK_PER_PHASE
    for (int p = 0; p < N_PHASES; ++p) { a.ph_lo = p; a.ph_hi = p + 1; a.li = p; hipLaunchKernelGGL(fwd_kernel, dim3(grid), dim3(NWAVES * 64), LDS_BYTES, stream, a); }
#else
    a.ph_lo = 0; a.ph_hi = N_PHASES; a.li = 0;
    hipLaunchKernelGGL(fwd_kernel, dim3(grid), dim3(NWAVES * 64), LDS_BYTES, stream, a);
#endif
}
```

```cpp
#include <hip/hip_runtime.h>
#include <cstdio>
#include <cstdint>
namespace pg8 {
#define PG8_LAS __attribute__((address_space(3)))
typedef unsigned short bf16_t;
typedef short bf16x8 __attribute__((ext_vector_type(8)));
typedef float f32x4 __attribute__((ext_vector_type(4)));
typedef unsigned u32x4 __attribute__((ext_vector_type(4)));
constexpr int BM = 256, BK = 64, HALF = 128, HTB = HALF * BK * 2  , STAGE_BYTES = 8 * HTB, NXCD = 8, WGM = 8;

__host__ __device__ __forceinline__ int lds_byte(int r, int c) { const int st = (r >> 4) * 2 + (c >> 5), rr = r & 15, cc = c & 31, ob = rr * 64 + cc * 2; return st * 1024 + (ob ^ (((ob >> 9) & 1) << 5)); }
__host__ __device__ __forceinline__ void stage_rc(int b, int& R, int& C) { const int st = b / 1024, sb = b % 1024, swz = sb ^ (((sb >> 9) & 1) << 5); R = (st >> 1) * 16 + swz / 64; C = (st & 1) * 32 + (swz % 64) / 2; }
__host__ __device__ __forceinline__ int perm32(int rho) { const int n = rho >> 4, i = rho & 15; return 8 * (i >> 2) + 4 * n + (i & 3); }

struct Unit { int pm, pn, e, r0, half; };
struct Gemm { const bf16_t* A; const bf16_t* Bt; int M, N, K; };

struct StaticOrder {
    int nM, nN, nwg, G, c;
    __host__ __device__ void init(int M, int N, int G_, int c_) { nM = M / BM; nN = N / BM; nwg = nM * nN; G = G_; c = c_; }
    __host__ __device__ bool next(int i, Unit& u) const {
        const long L = (long)i * G + c; if (L >= nwg) return false;
        int wgid = (int)L; { const int q = nwg / NXCD, r = nwg % NXCD, xcd = wgid % NXCD, off = wgid / NXCD; wgid = (xcd < r ? xcd * (q + 1) : r * (q + 1) + (xcd - r) * q) + off; }
        const int nig = WGM * nN, gid = wgid / nig, fm = gid * WGM, gsz = (nM - fm) < WGM ? (nM - fm) : WGM;
        u.pm = fm + ((wgid % nig) % gsz); u.pn = (wgid % nig) / gsz; u.e = 0; u.r0 = 0; u.half = 0; return true;
    }
    __device__ __forceinline__ int arow(const Unit& u, int r) const { return u.pm * BM + r; }
    __device__ __forceinline__ void a_ready(const Unit&) const {}
    __device__ __forceinline__ void done(const Unit&) const {}
};

__device__ __forceinline__ unsigned cvt_pk_bf16(float lo, float hi) { unsigned r; asm volatile("v_cvt_pk_bf16_f32 %0, %1, %2" : "=v"(r) : "v"(lo), "v"(hi)); return r; }
__device__ __forceinline__ float bf_lo(unsigned w) { return __uint_as_float(w << 16); }
__device__ __forceinline__ float bf_hi(unsigned w) { return __uint_as_float(w & 0xffff0000u); }
__device__ __forceinline__ float sigmoidf_(float x) { return 1.0f / (1.0f + __expf(-x)); }

struct EpiBf16 {
    static constexpr bool PERM = true, AFTER_DRAIN = false; static constexpr int MID_T = -1;
    bf16_t* O; int ldc;
    __device__ __forceinline__ void operator()(const f32x4 (&acc)[2][2][4][2], const Unit& u, int wr, int wc, int fr, int fq) const {
        const int row0 = u.pm * BM + wr * 64 + fr; const int col0 = u.pn * BM + wc * 32 + 8 * fq;
#pragma unroll
        for (int ai = 0; ai < 2; ++ai)
#pragma unroll
            for (int m = 0; m < 4; ++m) { bf16_t* rowp = O + (size_t)(row0 + ai * HALF + m * 16) * ldc + col0;
#pragma unroll
                for (int bj = 0; bj < 2; ++bj) { const f32x4 v0 = acc[ai][bj][m][0], v1 = acc[ai][bj][m][1];
                    u32x4 w; w.x = cvt_pk_bf16(v0[0], v0[1]); w.y = cvt_pk_bf16(v0[2], v0[3]); w.z = cvt_pk_bf16(v1[0], v1[1]); w.w = cvt_pk_bf16(v1[2], v1[3]);
                    *(u32x4*)(rowp + bj * HALF) = w; } }
    }
};
struct EpiBf16Grp {
    static constexpr bool PERM = true, AFTER_DRAIN = false; static constexpr int MID_T = -1;
    bf16_t* O; int ldc; int ntn;
    __device__ __forceinline__ void operator()(const f32x4 (&acc)[2][2][4][2], const Unit& u, int wr, int wc, int fr, int fq) const {
        const int row0 = u.pm * BM + wr * 64 + fr; const int col0 = (u.pn % ntn) * BM + wc * 32 + 8 * fq;
#pragma unroll
        for (int ai = 0; ai < 2; ++ai)
#pragma unroll
            for (int m = 0; m < 4; ++m) { bf16_t* rowp = O + (size_t)(row0 + ai * HALF + m * 16) * ldc + col0;
#pragma unroll
                for (int bj = 0; bj < 2; ++bj) { const f32x4 v0 = acc[ai][bj][m][0], v1 = acc[ai][bj][m][1];
                    u32x4 w; w.x = cvt_pk_bf16(v0[0], v0[1]); w.y = cvt_pk_bf16(v0[2], v0[3]); w.z = cvt_pk_bf16(v1[0], v1[1]); w.w = cvt_pk_bf16(v1[2], v1[3]);
                    *(u32x4*)(rowp + bj * HALF) = w; } }
    }
};
struct EpiMerge {
    static constexpr bool PERM = true, AFTER_DRAIN = false; static constexpr int MID_T = 8;
    bf16_t* O; int ldc; const bf16_t* G; int ldg;
    __device__ __forceinline__ void mid(f32x4 (&acc)[2][2][4][2], const Unit& u, int wr, int wc, int fr, int fq) const {
        unsigned goff = (unsigned)(u.pm * BM + wr * 64 + fr) * (unsigned)ldg + (unsigned)(u.pn * BM + wc * 32 + 8 * fq);
        asm volatile("" : "+v"(goff));
        const bf16_t* gp = G + goff;
#define PG8_RATIO(av, mv) ((1.f + __expf(-fmaxf(mv, -30.f))) / (1.f + __expf(-(av))))
#define PG8_GADDR(i) (gp + (size_t)((((i) >> 3) & 1) * HALF + (((i) >> 1) & 3) * 16) * ldg + ((i) & 1) * HALF)
        u32x4 ga[4], gm[4];
#pragma unroll
        for (int i = 0; i < 4; ++i) { ga[i] = *(const u32x4*)PG8_GADDR(i); gm[i] = *(const u32x4*)(PG8_GADDR(i) + ldc); }
        asm volatile("" ::: "memory");
#pragma unroll
        for (int i = 0; i < 16; ++i) { const int ai = (i >> 3) & 1, m = (i >> 1) & 3, bj = i & 1, cb = i & 3;
            const u32x4 a = ga[cb], g = gm[cb];
            acc[ai][bj][m][0][0] *= PG8_RATIO(bf_lo(a.x), bf_lo(g.x)); acc[ai][bj][m][0][1] *= PG8_RATIO(bf_hi(a.x), bf_hi(g.x));
            acc[ai][bj][m][0][2] *= PG8_RATIO(bf_lo(a.y), bf_lo(g.y)); acc[ai][bj][m][0][3] *= PG8_RATIO(bf_hi(a.y), bf_hi(g.y));
            acc[ai][bj][m][1][0] *= PG8_RATIO(bf_lo(a.z), bf_lo(g.z)); acc[ai][bj][m][1][1] *= PG8_RATIO(bf_hi(a.z), bf_hi(g.z));
            acc[ai][bj][m][1][2] *= PG8_RATIO(bf_lo(a.w), bf_lo(g.w)); acc[ai][bj][m][1][3] *= PG8_RATIO(bf_hi(a.w), bf_hi(g.w));
            if (i + 4 < 16) { ga[cb] = *(const u32x4*)PG8_GADDR(i + 4); gm[cb] = *(const u32x4*)(PG8_GADDR(i + 4) + ldc); }
            asm volatile("" : "+v"(acc[ai][bj][m][0]), "+v"(acc[ai][bj][m][1]) :: "memory"); }
#undef PG8_RATIO
#undef PG8_GADDR
    }
    __device__ __forceinline__ void operator()(const f32x4 (&acc)[2][2][4][2], const Unit& u, int wr, int wc, int fr, int fq) const {
        const int row0 = u.pm * BM + wr * 64 + fr; const int col0 = u.pn * BM + wc * 32 + 8 * fq;
#pragma unroll
        for (int ai = 0; ai < 2; ++ai)
#pragma unroll
            for (int m = 0; m < 4; ++m) { const size_t r = (size_t)(row0 + ai * HALF + m * 16);
#pragma unroll
                for (int bj = 0; bj < 2; ++bj) { const u32x4 gm = *(const u32x4*)(G + r * ldg + ldc + col0 + bj * HALF);
                    const f32x4 v0 = acc[ai][bj][m][0], v1 = acc[ai][bj][m][1];
                    const float s0 = sigmoidf_(fmaxf(bf_lo(gm.x), -30.f)), s1 = sigmoidf_(fmaxf(bf_hi(gm.x), -30.f)), s2 = sigmoidf_(fmaxf(bf_lo(gm.y), -30.f)), s3 = sigmoidf_(fmaxf(bf_hi(gm.y), -30.f));
                    const float s4 = sigmoidf_(fmaxf(bf_lo(gm.z), -30.f)), s5 = sigmoidf_(fmaxf(bf_hi(gm.z), -30.f)), s6 = sigmoidf_(fmaxf(bf_lo(gm.w), -30.f)), s7 = sigmoidf_(fmaxf(bf_hi(gm.w), -30.f));
                    u32x4 w; w.x = cvt_pk_bf16(v0[0] * s0, v0[1] * s1); w.y = cvt_pk_bf16(v0[2] * s2, v0[3] * s3); w.z = cvt_pk_bf16(v1[0] * s4, v1[1] * s5); w.w = cvt_pk_bf16(v1[2] * s6, v1[3] * s7);
                    *(u32x4*)(O + r * ldc + col0 + bj * HALF) = w; } }
    }
};
struct EpiResid {
    static constexpr bool PERM = false, AFTER_DRAIN = false; static constexpr int MID_T = -1;
    float* P; int ldc; const float* X; const float* stats; const float* g; const float* b; float alpha;
    __device__ __forceinline__ void operator()(const f32x4 (&acc)[2][2][4][2], const Unit& u, int wr, int wc, int fr, int fq) const {
        const int row0 = u.pm * BM + wr * 64 + fr, col0 = u.pn * BM + wc * 32 + 4 * fq;
        f32x4 gv[2][2], bv[2][2];
#pragma unroll
        for (int bj = 0; bj < 2; ++bj)
#pragma unroll
            for (int n = 0; n < 2; ++n) { gv[bj][n] = *(const f32x4*)(g + col0 + bj * HALF + n * 16); bv[bj][n] = *(const f32x4*)(b + col0 + bj * HALF + n * 16); }
#pragma unroll
        for (int ai = 0; ai < 2; ++ai)
#pragma unroll
            for (int m = 0; m < 4; ++m) { const size_t r = (size_t)(row0 + ai * HALF + m * 16); const float mu = stats[2 * r], rs = stats[2 * r + 1];
#pragma unroll
                for (int bj = 0; bj < 2; ++bj)
#pragma unroll
                    for (int n = 0; n < 2; ++n) { const size_t off = r * ldc + col0 + bj * HALF + n * 16; const f32x4 xv = *(const f32x4*)(X + off);
                        *(f32x4*)(P + off) = ((xv - mu) * rs * gv[bj][n] + bv[bj][n]) * alpha + acc[ai][bj][m][n]; } }
    }
};
struct EpiSwiGlu {
    static constexpr bool PERM = true, AFTER_DRAIN = false; static constexpr int MID_T = -1;
    bf16_t* O; int ldc; int ntn;
    __device__ __forceinline__ void operator()(const f32x4 (&acc)[2][2][4][2], const Unit& u, int wr, int wc, int fr, int fq) const {
        const int row0 = u.pm * BM + wr * 64 + fr; const int col0 = (u.pn % ntn) * HALF + wc * 32 + 8 * fq;
#pragma unroll
        for (int ai = 0; ai < 2; ++ai)
#pragma unroll
            for (int m = 0; m < 4; ++m) { bf16_t* rowp = O + (size_t)(row0 + ai * HALF + m * 16) * ldc + col0;
                float o[8];
#pragma unroll
                for (int n = 0; n < 2; ++n)
#pragma unroll
                    for (int j = 0; j < 4; ++j) { const float gt = acc[ai][0][m][n][j], up = acc[ai][1][m][n][j]; o[4 * n + j] = gt * sigmoidf_(gt) * up; }
                u32x4 w; w.x = cvt_pk_bf16(o[0], o[1]); w.y = cvt_pk_bf16(o[2], o[3]); w.z = cvt_pk_bf16(o[4], o[5]); w.w = cvt_pk_bf16(o[6], o[7]);
                *(u32x4*)rowp = w; }
    }
};

template <class Epi, class Sched, bool ALIGN_EPI = false, bool SP2 = false>
__device__ __forceinline__ void gemm_phase(PG8_LAS unsigned char* lds, const Gemm g, const Sched& S, const Epi& E) {
    const int tid = threadIdx.x, wid = __builtin_amdgcn_readfirstlane(tid >> 6), lane = tid & 63, wr = wid >> 2, wc = wid & 3, fr = lane & 15, fq = lane >> 4;
    const int K = g.K, nt = K / BK;
    int Rs[2], Cs[2]; unsigned voffB[2];
#pragma unroll
    for (int i = 0; i < 2; ++i) { int R, C; stage_rc(tid * 16 + i * 8192, R, C); const int Rb = Epi::PERM ? ((R & ~31) + perm32(R & 31)) : R;
        Rs[i] = R; Cs[i] = C; voffB[i] = (unsigned)(Rb * K + C) * 2u; }
    const size_t kstep = (size_t)(BK * 2);
    const size_t hstep = (size_t)HALF * K * 2;
    const size_t tstep = 2 * hstep;
    const unsigned ldsw = (unsigned)wid * 1024u;
    const int aoff = lds_byte(wr * 64 + fr, fq * 8), boff = lds_byte(wc * 32 + fr, fq * 8);
#define PG8_SA(b, h) (((b) * 2 + (h)) * HTB)
#define PG8_SB(b, h) ((4 + (b) * 2 + (h)) * HTB)
#define PG8_STAGE(bufoff, gbase, voff) do { _Pragma("unroll") for (int _i = 0; _i < 2; ++_i) \
        __builtin_amdgcn_global_load_lds((const unsigned*)((const char*)(gbase) + (voff)[_i]), (PG8_LAS unsigned*)(lds + (bufoff) + ldsw + _i * 8192), 16, 0, 0); } while (0)
#define PG8_LDA(dst, b, h) do { _Pragma("unroll") for (int m = 0; m < 4; ++m) _Pragma("unroll") for (int k = 0; k < 2; ++k) dst[m][k] = *(const PG8_LAS bf16x8*)(lds + PG8_SA(b, h) + aoff + m * 2048 + k * 1024); } while (0)
#define PG8_LDB(dst, b, h) do { _Pragma("unroll") for (int n = 0; n < 2; ++n) _Pragma("unroll") for (int k = 0; k < 2; ++k) dst[n][k] = *(const PG8_LAS bf16x8*)(lds + PG8_SB(b, h) + boff + n * 2048 + k * 1024); } while (0)
#define PG8_MMA(ai, bj, At, Bt) do { __builtin_amdgcn_s_setprio(1); _Pragma("unroll") for (int m = 0; m < 4; ++m) _Pragma("unroll") for (int n = 0; n < 2; ++n) _Pragma("unroll") for (int k = 0; k < 2; ++k) \
        acc[ai][bj][m][n] = __builtin_amdgcn_mfma_f32_16x16x32_bf16(Bt[n][k], At[m][k], acc[ai][bj][m][n], 0, 0, 0); __builtin_amdgcn_s_setprio(0); } while (0)
#define PG8_WAIT_V(n) asm volatile("s_waitcnt vmcnt(" #n ")" ::: "memory")
#define PG8_WAIT_L(n) asm volatile("s_waitcnt lgkmcnt(" #n ")" ::: "memory")
#define PG8_BAR __builtin_amdgcn_s_barrier()
#define PG8_SCHED __builtin_amdgcn_sched_barrier(0)
#define PG8_AOFF(dst, u) do { _Pragma("unroll") for (int _h = 0; _h < 2; ++_h) _Pragma("unroll") for (int _i = 0; _i < 2; ++_i) \
        dst[_h][_i] = ((unsigned)S.arow(u, _h * HALF + Rs[_i]) * (unsigned)K + (unsigned)Cs[_i]) * 2u; } while (0)
    Unit cur, nxt; int ui = 0;
    if (!S.next(0, cur)) return;
    f32x4 acc[2][2][4][2];
#pragma unroll
    for (int a = 0; a < 2; ++a)
#pragma unroll
        for (int b = 0; b < 2; ++b)
#pragma unroll
            for (int m = 0; m < 4; ++m)
#pragma unroll
                for (int n = 0; n < 2; ++n) acc[a][b][m][n] = (f32x4){0.f, 0.f, 0.f, 0.f};
    bf16x8 At[4][2], B0[2][2], B1[2][2];
    unsigned vA[2][2], nvA[2][2];
    PG8_AOFF(vA, cur);
    const char* const cA = (const char*)g.A; const char* cB = (const char*)g.Bt + (size_t)cur.pn * tstep;
    S.a_ready(cur);
    if constexpr (SP2) {
        PG8_STAGE(PG8_SB(0, 0), cB, voffB); PG8_STAGE(PG8_SB(0, 1), cB + hstep, voffB); PG8_STAGE(PG8_SA(0, 0), cA, vA[0]); PG8_STAGE(PG8_SA(0, 1), cA, vA[1]);
        if (wr == 1) PG8_BAR;
        PG8_WAIT_V(2); PG8_BAR;
        PG8_STAGE(PG8_SB(1, 0), cB + kstep, voffB); PG8_STAGE(PG8_SA(1, 0), cA + kstep, vA[0]); PG8_STAGE(PG8_SB(1, 1), cB + hstep + kstep, voffB);
        PG8_WAIT_V(6); PG8_BAR;
    } else {
        PG8_STAGE(PG8_SB(0, 0), cB, voffB); PG8_STAGE(PG8_SA(0, 0), cA, vA[0]); PG8_STAGE(PG8_SB(0, 1), cB + hstep, voffB); PG8_STAGE(PG8_SA(0, 1), cA, vA[1]);
        if (wr == 1) PG8_BAR;
        PG8_WAIT_V(4); PG8_BAR;
        PG8_STAGE(PG8_SB(1, 0), cB + kstep, voffB); PG8_STAGE(PG8_SA(1, 0), cA + kstep, vA[0]); PG8_STAGE(PG8_SB(1, 1), cB + hstep + kstep, voffB);
        PG8_WAIT_V(6); PG8_BAR;
    }
    for (;;) {
        const bool has_next = S.next(ui + 1, nxt);
        const char* nB = has_next ? (const char*)g.Bt + (size_t)nxt.pn * tstep : cB;
        if (has_next) { PG8_AOFF(nvA, nxt); } else {
#pragma unroll
            for (int h = 0; h < 2; ++h)
#pragma unroll
                for (int i = 0; i < 2; ++i) nvA[h][i] = vA[h][i]; }
        for (int t = 0; t < nt; t += 2) {
            const bool last = (t == nt - 2);
            const char* a1 = cA + (size_t)(t + 1) * kstep;
            const char* a2 = last ? cA : cA + (size_t)(t + 2) * kstep; const char* b2 = last ? nB : cB + (size_t)(t + 2) * kstep;
            const char* a3 = a2 + kstep; const char* b3 = b2 + kstep;
            unsigned w0[2], w1[2];
            w0[0] = last ? nvA[0][0] : vA[0][0]; w0[1] = last ? nvA[0][1] : vA[0][1]; w1[0] = last ? nvA[1][0] : vA[1][0]; w1[1] = last ? nvA[1][1] : vA[1][1];
            if (last && has_next) S.a_ready(nxt);
            if constexpr (Epi::MID_T >= 0) { if (t == Epi::MID_T) { PG8_SCHED; E.mid(acc, cur, wr, wc, fr, fq); PG8_SCHED; } }
            if constexpr (SP2) {
            PG8_LDB(B0, 0, 0); PG8_LDB(B1, 0, 1); PG8_SCHED; PG8_LDA(At, 0, 0); PG8_STAGE(PG8_SA(1, 1), a1, vA[1]);
            PG8_WAIT_V(8); PG8_WAIT_L(0); PG8_BAR; PG8_MMA(0, 0, At, B0); PG8_MMA(0, 1, At, B1); PG8_BAR; PG8_SCHED;
            PG8_LDA(At, 0, 1); PG8_STAGE(PG8_SB(0, 0), b2, voffB); PG8_STAGE(PG8_SB(0, 1), b2 + hstep, voffB); PG8_STAGE(PG8_SA(0, 0), a2, w0);
            PG8_WAIT_V(8); PG8_WAIT_L(0); PG8_BAR; if (!cur.half) { PG8_MMA(1, 0, At, B0); PG8_MMA(1, 1, At, B1); } PG8_BAR; PG8_SCHED;
            PG8_LDB(B0, 1, 0); PG8_LDB(B1, 1, 1); PG8_SCHED; PG8_LDA(At, 1, 0); PG8_STAGE(PG8_SA(0, 1), a2, w1);
            PG8_WAIT_V(8); PG8_WAIT_L(0); PG8_BAR; PG8_MMA(0, 0, At, B0); PG8_MMA(0, 1, At, B1); PG8_BAR; PG8_SCHED;
            PG8_LDA(At, 1, 1); PG8_STAGE(PG8_SB(1, 0), b3, voffB); PG8_STAGE(PG8_SB(1, 1), b3 + hstep, voffB); PG8_STAGE(PG8_SA(1, 0), a3, w0);
            PG8_WAIT_V(8); PG8_WAIT_L(0); PG8_BAR; if (!cur.half) { PG8_MMA(1, 0, At, B0); PG8_MMA(1, 1, At, B1); } PG8_BAR; PG8_SCHED;
            } else {
            PG8_LDB(B0, 0, 0); PG8_SCHED; PG8_LDA(At, 0, 0); PG8_STAGE(PG8_SA(1, 1), a1, vA[1]);
            PG8_WAIT_L(8); PG8_BAR; PG8_WAIT_L(0); PG8_MMA(0, 0, At, B0); PG8_BAR; PG8_SCHED;
            PG8_LDB(B1, 0, 1); PG8_STAGE(PG8_SB(0, 0), b2, voffB);
            PG8_BAR; PG8_WAIT_L(0); PG8_MMA(0, 1, At, B1); PG8_BAR;
            PG8_LDA(At, 0, 1); PG8_STAGE(PG8_SA(0, 0), a2, w0);
            PG8_BAR; PG8_WAIT_L(0); PG8_MMA(1, 0, At, B0); PG8_BAR; PG8_SCHED;
            PG8_STAGE(PG8_SB(0, 1), b2 + hstep, voffB);
            PG8_WAIT_V(6); PG8_BAR; PG8_MMA(1, 1, At, B1); PG8_BAR;
            PG8_LDB(B0, 1, 0); PG8_SCHED; PG8_LDA(At, 1, 0); PG8_STAGE(PG8_SA(0, 1), a2, w1);
            PG8_WAIT_L(8); PG8_BAR; PG8_WAIT_L(0); PG8_MMA(0, 0, At, B0); PG8_BAR; PG8_SCHED;
            PG8_LDB(B1, 1, 1); PG8_STAGE(PG8_SB(1, 0), b3, voffB);
            PG8_BAR; PG8_WAIT_L(0); PG8_MMA(0, 1, At, B1); PG8_BAR;
            PG8_LDA(At, 1, 1); PG8_STAGE(PG8_SA(1, 0), a3, w0);
            PG8_BAR; PG8_WAIT_L(0); PG8_MMA(1, 0, At, B0); PG8_BAR; PG8_SCHED;
            PG8_STAGE(PG8_SB(1, 1), b3 + hstep, voffB);
            PG8_WAIT_V(6); PG8_BAR; PG8_MMA(1, 1, At, B1); PG8_BAR;
            }
        }
        if constexpr (ALIGN_EPI) { if (wr == 0) PG8_BAR; }
        E(acc, cur, wr, wc, fr, fq); S.done(cur);
        if (!has_next) break;
#pragma unroll
        for (int a = 0; a < 2; ++a)
#pragma unroll
            for (int b = 0; b < 2; ++b)
#pragma unroll
                for (int m = 0; m < 4; ++m)
#pragma unroll
                    for (int n = 0; n < 2; ++n) acc[a][b][m][n] = (f32x4){0.f, 0.f, 0.f, 0.f};
        cur = nxt; cB = nB; ++ui;
#pragma unroll
        for (int h = 0; h < 2; ++h)
#pragma unroll
            for (int i = 0; i < 2; ++i) vA[h][i] = nvA[h][i];
        if constexpr (ALIGN_EPI) { if (wr == 1) PG8_BAR; }
    }
    PG8_WAIT_V(0);
    if constexpr (!ALIGN_EPI) { if (wr == 0) PG8_BAR; }
    PG8_BAR;
#undef PG8_SA
#undef PG8_SB
#undef PG8_STAGE
#undef PG8_LDA
#undef PG8_LDB
#undef PG8_MMA
#undef PG8_WAIT_V
#undef PG8_WAIT_L
#undef PG8_BAR
#undef PG8_SCHED
#undef PG8_AOFF
}
}
#define GAS __attribute__((address_space(1)))
#define LAS __attribute__((address_space(3)))
typedef unsigned short bf16;
typedef unsigned v4u __attribute__((ext_vector_type(4)));
typedef float f32x4 __attribute__((ext_vector_type(4)));
typedef short bf16x8 __attribute__((ext_vector_type(8)));
typedef GAS unsigned gu32;
typedef GAS unsigned long long gu64;
#define RLX_AGENT __ATOMIC_RELAXED, __HIP_MEMORY_SCOPE_AGENT
#define LDS_WAIT() asm volatile("s_waitcnt lgkmcnt(0)" ::: "memory")
#define VM_WAIT() asm volatile("s_waitcnt vmcnt(0)" ::: "memory")
__device__ __forceinline__ unsigned long long rt() { return __builtin_amdgcn_s_memrealtime(); }
__device__ __forceinline__ unsigned f2bf(float f) { unsigned u = __builtin_bit_cast(unsigned, f); return (u + 0x7fffu + ((u >> 16) & 1u)) >> 16; }
__device__ __forceinline__ unsigned pk2(float lo, float hi) { return f2bf(lo) | (f2bf(hi) << 16); }

#define XB_TMO      128
#define XB_XCNT(j)  (256  + 64 * (j))
#define XB_XSUB(j)  (1280 + 64 * (j))
#define XB_XGEN(j)  (2304 + 64 * (j))
#define XB_TOP      3328
#define XB_TOPGEN   3392
#define XCD_BAR_WORDS 3456
#define XB_SPIN_CAP (1u << 22)

__device__ __forceinline__ unsigned xb_ld(unsigned* p)              { return __hip_atomic_load(p, __ATOMIC_RELAXED, __HIP_MEMORY_SCOPE_AGENT); }
__device__ __forceinline__ unsigned xb_add(unsigned* p, unsigned v) { return __hip_atomic_fetch_add(p, v, __ATOMIC_RELAXED, __HIP_MEMORY_SCOPE_AGENT); }
__device__ __forceinline__ unsigned xb_xcc_id() { return (unsigned)__builtin_amdgcn_s_getreg((3 << 11) | 20) & 0xFu; }
#define XB_SPIN(cond, bar) do { unsigned _sp = 0; while (cond) { __builtin_amdgcn_s_sleep(1); \
    if ((++_sp & 255u) == 0u) { if (xb_ld(&(bar)[XB_TMO])) break; if (_sp > XB_SPIN_CAP) { atomicAdd(&(bar)[XB_TMO], 1u); break; } } } } while (0)

struct XcdBarrier {
    unsigned* bar; unsigned x;
    volatile LAS unsigned* st;
};

__device__ __forceinline__ XcdBarrier xcd_barrier_post(unsigned* bar, volatile LAS unsigned* st) {
    XcdBarrier b; b.bar = bar; b.x = xb_xcc_id(); b.st = st;
    if (threadIdx.x == 0) (void)xb_add(&bar[XB_XCNT(b.x)], 1u);
    return b;
}
__device__ __forceinline__ void xcd_barrier_complete(unsigned* bar, unsigned x, unsigned& nloc, unsigned& nx) {
    const unsigned G = gridDim.x * gridDim.y * gridDim.z;
    unsigned sum, cnt, mine, sp = 0u;
    for (;;) {
        sum = 0u; cnt = 0u; mine = 0u;
#pragma unroll
        for (unsigned j = 0; j < 16; ++j) { const unsigned c = xb_ld(&bar[XB_XCNT(j)]); sum += c; cnt += (c > 0u) ? 1u : 0u; mine = (j == x) ? c : mine; }
        if (sum == G) break;
        __builtin_amdgcn_s_sleep(1);
        if ((++sp & 255u) == 0u) { if (xb_ld(&bar[XB_TMO])) break; if (sp > XB_SPIN_CAP) { atomicAdd(&bar[XB_TMO], 1u); break; } }
    }
    nloc = mine > 0u ? mine : 1u; nx = cnt > 0u ? cnt : 1u;
}

__device__ __forceinline__ void xcd_barrier(const XcdBarrier& b) {
    asm volatile("s_waitcnt vmcnt(0)" ::: "memory");
    __syncthreads();
    if (threadIdx.x == 0) {
        unsigned* bar = b.bar;
        __builtin_amdgcn_s_waitcnt(0);
        unsigned nloc = b.st[0], nx = b.st[1];
        if (nloc == 0u) { xcd_barrier_complete(bar, b.x, nloc, nx); b.st[0] = nloc; b.st[1] = nx; }
        const unsigned old = xb_add(&bar[XB_XSUB(b.x)], 1u);
        const unsigned gen = old / nloc;
        if (old + 1u == (gen + 1u) * nloc) {
            __builtin_amdgcn_fence(__ATOMIC_RELEASE, "agent");
            asm volatile("s_waitcnt vmcnt(0)" ::: "memory");
            const unsigned og = xb_add(&bar[XB_TOP], 1u);
            const unsigned tg = og / nx;
            if (og + 1u == (tg + 1u) * nx) xb_add(&bar[XB_TOPGEN], 1u);
            else XB_SPIN(xb_ld(&bar[XB_TOPGEN]) == tg, bar);
            __builtin_amdgcn_fence(__ATOMIC_ACQUIRE, "agent");
            xb_add(&bar[XB_XGEN(b.x)], 1u);
            asm volatile("s_waitcnt vmcnt(0)" ::: "memory");
        } else {
            XB_SPIN(xb_ld(&bar[XB_XGEN(b.x)]) == gen, bar);
            __builtin_amdgcn_fence(__ATOMIC_ACQUIRE, "agent");
            asm volatile("s_waitcnt vmcnt(0)" ::: "memory");
        }
    }
    __syncthreads();
}

constexpr int NWAVES = 8;
constexpr int BATCH = 2, SEQ = 4096, M = BATCH * SEQ, D = 2048;
constexpr int NPW = 11784;
constexpr int NP = 11776;
constexpr int C_AQ = 0, C_AK = 1536, C_AV = 3072, C_MQK = 4608, C_MV = 5632, C_MO = 6656, C_GATE = 7680;
constexpr int NE = 32, DFF = 1408, ECAP = 8192, MAXT = 96, NT1 = DFF / 128  , NT2 = D / 256  ;
constexpr float LN_EPS = 1e-5f, ALPHA = 1.189207115002721f, QSCALE = 0.08838834764831845f;
constexpr size_t MiB = 1u << 20;
constexpr size_t WS_CTL = 0, CTL_ZERO_BYTES = 1 * MiB;
constexpr size_t WS_WIN = 2 * MiB, WS_WPA = 48 * MiB, WS_WPM = 50 * MiB, WS_WOUT = 54 * MiB, WS_WGU = 62 * MiB, WS_WD = 414 * MiB;
constexpr size_t WS_HB = 590 * MiB, WS_STATS = 622 * MiB, WS_MIF = 622 * MiB + 512 * 1024, WS_PROJ = 623 * MiB;
constexpr size_t WS_ATTO = 807 * MiB, WS_LSE = 831 * MiB, WS_ATT = 832 * MiB, WS_QKC = 840 * MiB, WS_NUM = 856 * MiB, WS_DEN = 888 * MiB, WS_MT = 888 * MiB + 512 * 1024;
constexpr size_t WS_HM = 889 * MiB, WS_TMP = 905 * MiB, WS_MERGED = 969 * MiB, WS_H1 = 1001 * MiB, WS_H1B = 1065 * MiB, WS_TOKLIST = 1097 * MiB, WS_TOKINFO = 1098 * MiB;
constexpr size_t WS_ACT = WS_PROJ, WS_YS = 689 * MiB;
constexpr size_t WS_KVT = 1099 * MiB, WS_CPREV = 1163 * MiB, WS_MSC = 1195 * MiB;
constexpr size_t WS_WRT = 1196 * MiB;
constexpr size_t WS_AH = 1200 * MiB;
constexpr size_t WS_END = 1224 * MiB;
static_assert(WS_WIN + (size_t)NP * D * 2 <= WS_WPA && WS_WGU + (size_t)NE * 2 * DFF * D * 2 <= WS_WD && WS_WD + (size_t)NE * D * DFF * 2 <= WS_HB, "weights map");
static_assert(WS_PROJ + (size_t)M * NP * 2 <= WS_ATTO && WS_ACT + (size_t)MAXT * 256 * DFF * 2 <= WS_YS && WS_YS + (size_t)MAXT * 256 * D * 2 <= WS_ATTO, "activation map");
constexpr int CW_TMO = 0, CW_CODE = 1, CW_BAR = 4096, CW_CNT = 65536, CW_Q = 66560;
constexpr int RING_OFF = 0, RING_BYTES = 131072, LDSCTL_OFF = RING_BYTES, MISC_OFF = LDSCTL_OFF + 320, TS_OFF = LDSCTL_OFF + 512, CNT_OFF = LDSCTL_OFF + 768, GATE_OFF = LDSCTL_OFF + 1024, QSLOT_OFF = LDSCTL_OFF + 1536;
constexpr int LDS_BYTES = 147456;

struct Frame { LAS unsigned char* lds; gu32* ctl; int tid, lane, wave, vcu, G; unsigned char* ws; };

__device__ __forceinline__ float wave_sum(float v) {
#pragma unroll
    for (int o = 1; o < 64; o <<= 1) v += __shfl_xor(v, o);
    return v;
}
__device__ __forceinline__ float wave_max(float v) {
#pragma unroll
    for (int o = 1; o < 64; o <<= 1) v = fmaxf(v, __shfl_xor(v, o));
    return v;
}
__device__ __forceinline__ float bflo(unsigned w) { return __uint_as_float(w << 16); }
__device__ __forceinline__ float bfhi(unsigned w) { return __uint_as_float(w & 0xffff0000u); }
__device__ __forceinline__ float sigm(float x) { return 1.0f / (1.0f + __expf(-x)); }

typedef short s16x4 __attribute__((ext_vector_type(4)));
__device__ __forceinline__ bf16x8 frag_tr(const LAS unsigned char* img, int pitch, int k0, int n0, int lane) {
    const int i = lane & 15, g = lane >> 4;
    const LAS unsigned char* p = img + (k0 + 8 * g + (i >> 2)) * pitch + (n0 + 4 * (i & 3)) * 2;
    const s16x4 a = __builtin_amdgcn_ds_read_tr16_b64_v4i16((LAS s16x4*)p), b = __builtin_amdgcn_ds_read_tr16_b64_v4i16((LAS s16x4*)(p + 4 * pitch));
    return (bf16x8){a[0], a[1], a[2], a[3], b[0], b[1], b[2], b[3]};
}
constexpr int TR_PITCH = 144;
__device__ __forceinline__ void tr_item(const float* W, int ldw, int k0, int c0, bf16* WT, size_t drow0, int Kd, LAS unsigned char* scr, int lane, int dk = 0) {
    const int kr = lane >> 4, nc = (lane & 15) * 4;
    f32x4 v[16];
#pragma unroll
    for (int j = 0; j < 16; ++j) v[j] = *(const f32x4*)(W + (size_t)(k0 + 4 * j + kr) * ldw + c0 + nc);
#pragma unroll
    for (int j = 0; j < 16; ++j) *(LAS unsigned long long*)(scr + (4 * j + kr) * TR_PITCH + nc * 2) = (unsigned long long)pk2(v[j][0], v[j][1]) | ((unsigned long long)pk2(v[j][2], v[j][3]) << 32);
    LDS_WAIT(); asm volatile("" ::: "memory");
    const int i = lane & 15, g = lane >> 4;
#pragma unroll
    for (int kk = 0; kk < 2; ++kk)
#pragma unroll
        for (int nn = 0; nn < 4; ++nn) { const bf16x8 f = frag_tr(scr, TR_PITCH, 32 * kk, 16 * nn, lane);
            *(bf16x8*)(WT + (drow0 + 16 * nn + i) * Kd + dk + k0 + 32 * kk + 8 * g) = f; }
    LDS_WAIT(); asm volatile("" ::: "memory");
}
constexpr int I_WINA = 32 * 120, I_WINB = 32 * 64, I_WPA = 8 * 32, I_WPM = 16 * 32, I_WOUT = 32 * 32, I_EXP = NE * 32 * 22, I_DN = NE * 22 * 32;
constexpr int I_EARLY = I_WINA + I_WINB + I_WPA + I_WPM + I_WOUT, I_MOE = 2 * I_EXP + I_DN;

__device__ __forceinline__ void p0_prologue(Frame& F, const float* x, const float* lng, const float* lnb, const float* w_in, const float* if_bias, const float* wpa, const float* wpm, const float* wout,
                                            const float* wrg, const float* wre) {
    unsigned char* ws = F.ws;
    LAS unsigned char* scr = F.lds + RING_OFF + F.wave * 16384;
    const int gw = F.vcu * NWAVES + F.wave, NGW = F.G * NWAVES;
    for (int it0 = gw; it0 < I_EARLY; it0 += NGW) {
        int it = it0;
        if (it < I_WINA) { const int kb = it / 120, nb = it % 120; tr_item(w_in, NPW, 64 * kb, 64 * nb, (bf16*)(ws + WS_WIN), (size_t)64 * nb, D, scr, F.lane); continue; } it -= I_WINA;
        if (it < I_WINB) { const int kb = it / 64, nb = it % 64; tr_item(w_in, NPW, 64 * kb, 7688 + 64 * nb, (bf16*)(ws + WS_WIN), (size_t)7680 + 64 * nb, D, scr, F.lane); continue; } it -= I_WINB;
        if (it < I_WPA) { const int kb = it / 32, nb = it % 32; tr_item(wpa, D, 64 * kb, 64 * nb, (bf16*)(ws + WS_WPA), (size_t)64 * nb, 1536, scr, F.lane, 0); continue; } it -= I_WPA;
        if (it < I_WPM) { const int kb = it / 32, nb = it % 32; tr_item(wpm, D, 64 * kb, 64 * nb, (bf16*)(ws + WS_WPA), (size_t)64 * nb, 1536, scr, F.lane, 512); continue; } it -= I_WPM;
        { const int kb = it / 32, nb = it % 32; tr_item(wout, D, 64 * kb, 64 * nb, (bf16*)(ws + WS_WOUT), (size_t)64 * nb, D, scr, F.lane); }
    }
    {
        bf16* WRH = (bf16*)(ws + WS_WRT); bf16* WRL = WRH + 48 * D; const int gt = F.vcu * (NWAVES * 64) + F.tid, NT = F.G * NWAVES * 64;
        for (int idx = gt; idx < 48 * D; idx += NT) { const int e = idx / D, k = idx % D; const float w = e < 32 ? wre[(size_t)k * 32 + e] : (e < 36 ? wrg[(size_t)k * 4 + (e - 32)] : 0.f);
            const unsigned hi = f2bf(w); WRH[idx] = (bf16)hi; WRL[idx] = (bf16)f2bf(w - __uint_as_float(hi << 16)); } }
    __syncthreads();
    LAS float* wif = (LAS float*)(F.lds + RING_OFF);
    for (int k = F.tid; k < D; k += NWAVES * 64) { const f32x4 a = *(const f32x4*)(w_in + (size_t)k * NPW + 7680), b = *(const f32x4*)(w_in + (size_t)k * NPW + 7684);
        *(LAS f32x4*)(wif + k * 8) = a; *(LAS f32x4*)(wif + k * 8 + 4) = b; }
    __syncthreads();
    bf16* HB = (bf16*)(ws + WS_HB); float* STATS = (float*)(ws + WS_STATS); float* MIF = (float*)(ws + WS_MIF);
    for (int m = gw; m < M; m += NGW) {
        const f32x4* xr = (const f32x4*)(x + (size_t)m * D) + F.lane;
        f32x4 v[8]; float s = 0.f;
#pragma unroll
        for (int j = 0; j < 8; ++j) { v[j] = xr[64 * j]; s += (v[j][0] + v[j][1]) + (v[j][2] + v[j][3]); }
        const float mean = wave_sum(s) * (1.f / D); float s2 = 0.f;
#pragma unroll
        for (int j = 0; j < 8; ++j) { const f32x4 d = v[j] - mean; s2 += (d[0] * d[0] + d[1] * d[1]) + (d[2] * d[2] + d[3] * d[3]); }
        const float rstd = rsqrtf(wave_sum(s2) * (1.f / D) + LN_EPS);
        float a[8];
#pragma unroll
        for (int i = 0; i < 8; ++i) a[i] = 0.f;
        unsigned long long* o8 = (unsigned long long*)(HB + (size_t)m * D) + F.lane;
#pragma unroll
        for (int j = 0; j < 8; ++j) { const int k0 = 4 * F.lane + 256 * j; const f32x4 g4 = *(const f32x4*)(lng + k0), b4 = *(const f32x4*)(lnb + k0);
            const f32x4 hv = (v[j] - mean) * rstd * g4 + b4;
            o8[64 * j] = (unsigned long long)pk2(hv[0], hv[1]) | ((unsigned long long)pk2(hv[2], hv[3]) << 32);
#pragma unroll
            for (int c = 0; c < 4; ++c) { const f32x4 w0 = *(const LAS f32x4*)(wif + (k0 + c) * 8), w1 = *(const LAS f32x4*)(wif + (k0 + c) * 8 + 4);
                a[0] += hv[c] * w0[0]; a[1] += hv[c] * w0[1]; a[2] += hv[c] * w0[2]; a[3] += hv[c] * w0[3]; a[4] += hv[c] * w1[0]; a[5] += hv[c] * w1[1]; a[6] += hv[c] * w1[2]; a[7] += hv[c] * w1[3]; }
            asm volatile("" ::: "memory"); }
#pragma unroll
        for (int i = 0; i < 8; ++i) a[i] = wave_sum(a[i]);
        if (F.lane == 0) { STATS[2 * m] = mean; STATS[2 * m + 1] = rstd;
#pragma unroll
            for (int i = 0; i < 8; ++i) MIF[(size_t)m * 8 + i] = a[i] + if_bias[i]; }
    }
}


struct TrItem { const float* src; bf16* dst; int ldw, Kd; };
__device__ __forceinline__ TrItem moe_item(int it, unsigned char* ws, const float* wgate, const float* wup, const float* wdown) {
    TrItem t;
    if (it < 2 * I_EXP) { const int up = it >= I_EXP ? 1 : 0; if (up) it -= I_EXP; const int e = it / 704, r = it % 704, kb = r / 22, nb = r % 22, j0 = 64 * nb;
        t.src = (up ? wup : wgate) + (size_t)e * D * DFF + (size_t)(64 * kb) * DFF + j0; t.ldw = DFF; t.Kd = D;
        t.dst = (bf16*)(ws + WS_WGU) + ((size_t)e * 2816 + (size_t)(j0 / 128) * 256 + (j0 % 128) + 128 * up) * D + 64 * kb; }
    else { it -= 2 * I_EXP; const int e = it / 704, r = it % 704, kb = r / 32, nb = r % 32;
        t.src = wdown + (size_t)e * DFF * D + (size_t)(64 * kb) * D + 64 * nb; t.ldw = D; t.Kd = DFF;
        t.dst = (bf16*)(ws + WS_WD) + ((size_t)e * D + 64 * nb) * DFF + 64 * kb; }
    return t;
}
__device__ __forceinline__ void tr_load(f32x4 (&v)[16], const TrItem& t, int lane) {
    const int kr = lane >> 4, nc = (lane & 15) * 4;
#pragma unroll
    for (int j = 0; j < 16; ++j) v[j] = __builtin_nontemporal_load((const f32x4*)(t.src + (size_t)(4 * j + kr) * t.ldw + nc));
}
__device__ __forceinline__ void tr_store(const f32x4 (&v)[16], const TrItem& t, LAS unsigned char* scr, int lane) {
    const int kr = lane >> 4, nc = (lane & 15) * 4;
#pragma unroll
    for (int j = 0; j < 16; ++j) *(LAS unsigned long long*)(scr + (4 * j + kr) * TR_PITCH + nc * 2) = (unsigned long long)pk2(v[j][0], v[j][1]) | ((unsigned long long)pk2(v[j][2], v[j][3]) << 32);
    LDS_WAIT(); asm volatile("" ::: "memory");
    const int i = lane & 15, g = lane >> 4;
#pragma unroll
    for (int kk = 0; kk < 2; ++kk)
#pragma unroll
        for (int nn = 0; nn < 4; ++nn) { const bf16x8 f = frag_tr(scr, TR_PITCH, 32 * kk, 16 * nn, lane);
            __builtin_nontemporal_store(f, (bf16x8*)(t.dst + (size_t)(16 * nn + i) * t.Kd + 32 * kk + 8 * g)); }
    LDS_WAIT(); asm volatile("" ::: "memory");
}
__device__ __forceinline__ void moe_convert(Frame& F, int conv, int nconv, const float* wgate, const float* wup, const float* wdown) {
    unsigned char* ws = F.ws;
    LAS unsigned char* scr = F.lds + RING_OFF + F.wave * 16384;
    const int step = nconv * NWAVES; int it = conv * NWAVES + F.wave;
    if (it >= I_MOE) return;
    f32x4 va[16], vb[16];
    TrItem ta = moe_item(it, ws, wgate, wup, wdown), tb = ta;
    tr_load(va, ta, F.lane);
    for (;;) {
        const bool hb = (it + step) < I_MOE;
        if (hb) { tb = moe_item(it + step, ws, wgate, wup, wdown); tr_load(vb, tb, F.lane); }
        tr_store(va, ta, scr, F.lane);
        if (!hb) break;
        const bool ha = (it + 2 * step) < I_MOE;
        if (ha) { ta = moe_item(it + 2 * step, ws, wgate, wup, wdown); tr_load(va, ta, F.lane); }
        tr_store(vb, tb, scr, F.lane);
        if (!ha) break;
        it += 2 * step;
    }
}
struct QueueOrder {
    int nM, nN, nwg, x; gu32* qctr; volatile LAS int* slot;
    __device__ __forceinline__ void init(int M_, int N_, int bx, gu32* q, volatile LAS int* s) { nM = M_ / 256; nN = N_ / 256; nwg = nM * nN; x = bx & 7; qctr = q; slot = s; }
    __device__ __forceinline__ bool next(int i, pg8::Unit& u) const {
        if (threadIdx.x < 64) { int off = 0; if (threadIdx.x == 0) off = (int)__hip_atomic_fetch_add(qctr + 64 * x, 1u, RLX_AGENT);
            off = __builtin_amdgcn_readfirstlane(off); if (threadIdx.x == 0) slot[i & 1] = off; asm volatile("s_waitcnt lgkmcnt(0)" ::: "memory"); }
        asm volatile("" ::: "memory"); __builtin_amdgcn_s_barrier(); asm volatile("" ::: "memory");
        const int off = slot[i & 1], q = nwg / 8;
        if (off >= q) return false;
        const int wgid = x * q + off, nig = pg8::WGM * nN, gid = wgid / nig, fm = gid * pg8::WGM, gsz = (nM - fm) < pg8::WGM ? (nM - fm) : pg8::WGM;
        u.pm = fm + ((wgid % nig) % gsz); u.pn = (wgid % nig) / gsz; u.e = 0; u.r0 = 0; u.half = 0; return true;
    }
    __device__ __forceinline__ int arow(const pg8::Unit& u, int r) const { return u.pm * 256 + r; }
    __device__ __forceinline__ void a_ready(const pg8::Unit&) const {}
    __device__ __forceinline__ void done(const pg8::Unit&) const {}
};
__device__ __forceinline__ float alibi_slope(int h) {
    switch (h) { case 0: return 0.70710678118654752f; case 1: return 0.5f; case 2: return 0.35355339059327379f; case 3: return 0.25f; case 4: return 0.17677669529663689f; case 5: return 0.125f;
        case 6: return 0.088388347648318447f; case 7: return 0.0625f; case 8: return 0.03125f; case 9: return 0.015625f; case 10: return 0.0078125f; default: return 0.00390625f; }
}
__device__ __forceinline__ void attn_naive(Frame& F) {
    const bf16* PROJ = (const bf16*)(F.ws + WS_PROJ); bf16* ATTO = (bf16*)(F.ws + WS_ATTO); float* LSE = (float*)(F.ws + WS_LSE);
    LAS float* pbuf = (LAS float*)(F.lds + RING_OFF) + F.wave * 256;
    const int gw = F.vcu * NWAVES + F.wave, NGW = F.G * NWAVES;
    for (int it = gw; it < M * 12; it += NGW) {
        const int h = it / M, m = it % M, t = m % SEQ, g = h >> 2, r = (g == 0) ? 1 : (g == 1 ? 4 : 16);
        const float slope = alibi_slope(h);
        const bf16* qp = PROJ + (size_t)m * NP + C_AQ + h * 128;
        float sc[3];
#pragma unroll
        for (int jj = 0; jj < 3; ++jj) {
            const int j = F.lane + 64 * jj; const bool valid = (j <= 128) && (t - j * r >= 0);
            float dot = 0.f;
            if (valid) { const bf16* kp = PROJ + (size_t)(m - j * r) * NP + C_AK + h * 128;
#pragma unroll 4
                for (int c = 0; c < 16; ++c) { const v4u qv = *(const v4u*)(qp + 8 * c), kv = *(const v4u*)(kp + 8 * c);
                    dot += bflo(qv.x) * bflo(kv.x) + bfhi(qv.x) * bfhi(kv.x) + bflo(qv.y) * bflo(kv.y) + bfhi(qv.y) * bfhi(kv.y) + bflo(qv.z) * bflo(kv.z) + bfhi(qv.z) * bfhi(kv.z) + bflo(qv.w) * bflo(kv.w) + bfhi(qv.w) * bfhi(kv.w); } }
            sc[jj] = valid ? dot * QSCALE - slope * (float)(j * r) : -INFINITY;
        }
        const float mx = wave_max(fmaxf(fmaxf(sc[0], sc[1]), sc[2]));
        float ps = 0.f;
#pragma unroll
        for (int jj = 0; jj < 3; ++jj) { const float p = (sc[jj] == -INFINITY) ? 0.f : __expf(sc[jj] - mx); ps += p; pbuf[F.lane + 64 * jj] = p; }
        const float l = wave_sum(ps);
        LDS_WAIT(); asm volatile("" ::: "memory");
        const int nk = ((t / r) < 128 ? (t / r) : 128) + 1;
        float o0 = 0.f, o1 = 0.f;
        const bf16* vp = PROJ + (size_t)m * NP + C_AV + h * 128 + 2 * F.lane;
        for (int j = 0; j < nk; ++j) { const float p = pbuf[j]; const unsigned w = *(const unsigned*)(vp - (size_t)j * r * NP); o0 += p * bflo(w); o1 += p * bfhi(w); }
        const float il = 1.f / l;
        *(unsigned*)(ATTO + (size_t)m * 1536 + h * 128 + 2 * F.lane) = pk2(o0 * il, o1 * il);
        if (F.lane == 0) LSE[(size_t)m * 12 + h] = mx + __logf(l);
        LDS_WAIT(); asm volatile("" ::: "memory");
    }
}
__device__ __forceinline__ void conv_qk(Frame& F, const float* conv_w, const float* conv_b) {
    const bf16* PROJ = (const bf16*)(F.ws + WS_PROJ); bf16* QKC = (bf16*)(F.ws + WS_QKC);
    const int gt = F.vcu * (NWAVES * 64) + F.tid, NT = F.G * NWAVES * 64;
    for (int idx = gt; idx < M * 128; idx += NT) {
        const int m = idx >> 7, c8 = (idx & 127) * 8, t = m % SEQ;
        float acc[8];
#pragma unroll
        for (int i = 0; i < 8; ++i) acc[i] = conv_b[c8 + i];
#pragma unroll
        for (int j = 0; j < 4; ++j) { const int tt = t - 3 + j; if (tt < 0) continue;
            const v4u w = *(const v4u*)(PROJ + (size_t)(m - 3 + j) * NP + C_MQK + c8);
            const f32x4 c0 = *(const f32x4*)(conv_w + j * 1024 + c8), c1 = *(const f32x4*)(conv_w + j * 1024 + c8 + 4);
            acc[0] += c0[0] * bflo(w.x); acc[1] += c0[1] * bfhi(w.x); acc[2] += c0[2] * bflo(w.y); acc[3] += c0[3] * bfhi(w.y);
            acc[4] += c1[0] * bflo(w.z); acc[5] += c1[1] * bfhi(w.z); acc[6] += c1[2] * bflo(w.w); acc[7] += c1[3] * bfhi(w.w); }
#pragma unroll
        for (int i = 0; i < 8; ++i) acc[i] = acc[i] * sigm(acc[i]);
        v4u o; o.x = pk2(acc[0], acc[1]); o.y = pk2(acc[2], acc[3]); o.z = pk2(acc[4], acc[5]); o.w = pk2(acc[6], acc[7]);
        *(v4u*)(QKC + (size_t)m * 1024 + c8) = o;
    }
}

__device__ __forceinline__ float log_sigmoid(float x) { return fminf(x, 0.f) - log1pf(__expf(-fabsf(x))); }
__device__ __forceinline__ void mlstm_naive(Frame& F, int bh) {
    const int b = bh >> 2, h = bh & 3;
    const bf16* PROJ = (const bf16*)(F.ws + WS_PROJ); const bf16* QKC = (const bf16*)(F.ws + WS_QKC); const float* MIF = (const float*)(F.ws + WS_MIF);
    float* NUM = (float*)(F.ws + WS_NUM); float* DEN = (float*)(F.ws + WS_DEN); float* MT = (float*)(F.ws + WS_MT);
    LAS float* qs = (LAS float*)(F.lds + RING_OFF); LAS float* ks = qs + 64 * 128; LAS bf16* vs = (LAS bf16*)(ks + 64 * 128);
    LAS float* gi = (LAS float*)(F.lds + GATE_OFF); LAS float* gf = gi + 64;
    float C[128];
#pragma unroll
    for (int d = 0; d < 128; ++d) C[d] = 0.f;
    float mst = 0.f;
    for (int c = 0; c < SEQ / 64; ++c) {
        __syncthreads();
        const size_t row0 = (size_t)b * SEQ + (size_t)c * 64;
        for (int idx = F.tid; idx < 64 * 32; idx += NWAVES * 64) { const int s = idx >> 5, c8 = idx & 31;
            const bf16* src = QKC + (row0 + s) * 1024 + (c8 < 16 ? h * 128 + c8 * 8 : 512 + h * 128 + (c8 - 16) * 8);
            const v4u w = *(const v4u*)src; const float sc = c8 < 16 ? QSCALE : 1.f;
            LAS float* dst = (c8 < 16 ? qs + s * 128 + c8 * 8 : ks + s * 128 + (c8 - 16) * 8);
            *(LAS f32x4*)dst = (f32x4){bflo(w.x) * sc, bfhi(w.x) * sc, bflo(w.y) * sc, bfhi(w.y) * sc}; *(LAS f32x4*)(dst + 4) = (f32x4){bflo(w.z) * sc, bfhi(w.z) * sc, bflo(w.w) * sc, bfhi(w.w) * sc};
            *(LAS v4u*)(vs + s * 256 + c8 * 8) = *(const v4u*)(PROJ + (row0 + s) * NP + C_MV + h * 256 + c8 * 8); }
        if (F.tid < 64) { gi[F.tid] = MIF[(row0 + F.tid) * 8 + h]; gf[F.tid] = log_sigmoid(MIF[(row0 + F.tid) * 8 + 4 + h]); }
        __syncthreads();
        if (F.tid <= 256) {
            for (int s = 0; s < 64; ++s) {
                const float lf = gf[s], ip = gi[s];
                const float mn = fmaxf(lf + mst, ip), fg = __expf(lf + mst - mn), ig = __expf(ip - mn); mst = mn;
                const float vv = (F.tid < 256) ? __uint_as_float((unsigned)vs[s * 256 + (F.tid & 255)] << 16) : 1.f;
                const float a = ig * vv; float num = 0.f;
#pragma unroll
                for (int d4 = 0; d4 < 32; ++d4) { const f32x4 kk = *(const LAS f32x4*)(ks + s * 128 + 4 * d4), qq = *(const LAS f32x4*)(qs + s * 128 + 4 * d4);
#pragma unroll
                    for (int e = 0; e < 4; ++e) { C[4 * d4 + e] = fg * C[4 * d4 + e] + a * kk[e]; num += C[4 * d4 + e] * qq[e]; } }
                if (F.tid < 256) NUM[(row0 + s) * 1024 + h * 256 + F.tid] = num; else { DEN[(row0 + s) * 4 + h] = num; MT[(row0 + s) * 4 + h] = mn; }
            }
        }
    }
}
__device__ __forceinline__ void attn_merge(Frame& F, int first_wg) {
    const bf16* ATTO = (const bf16*)(F.ws + WS_ATTO); const float* LSE = (const float*)(F.ws + WS_LSE); bf16* ATT = (bf16*)(F.ws + WS_AH);
    const int gt = (F.vcu - first_wg) * (NWAVES * 64) + F.tid, NT = (F.G - first_wg) * NWAVES * 64;
    for (int idx = gt; idx < M * 64; idx += NT) {
        const int m = idx >> 6, r = idx & 63, j = r >> 4, d8 = (r & 15) * 8;
        const float l0 = LSE[(size_t)m * 12 + j], l1 = LSE[(size_t)m * 12 + 4 + j], l2 = LSE[(size_t)m * 12 + 8 + j], mx = fmaxf(fmaxf(l0, l1), l2);
        float e0 = __expf(l0 - mx), e1 = __expf(l1 - mx), e2 = __expf(l2 - mx); const float inv = 1.f / (e0 + e1 + e2); e0 *= inv; e1 *= inv; e2 *= inv;
        const v4u a = *(const v4u*)(ATTO + (size_t)m * 1536 + j * 128 + d8), b = *(const v4u*)(ATTO + (size_t)m * 1536 + 512 + j * 128 + d8), c = *(const v4u*)(ATTO + (size_t)m * 1536 + 1024 + j * 128 + d8);
        v4u o;
        o.x = pk2(e0 * bflo(a.x) + e1 * bflo(b.x) + e2 * bflo(c.x), e0 * bfhi(a.x) + e1 * bfhi(b.x) + e2 * bfhi(c.x));
        o.y = pk2(e0 * bflo(a.y) + e1 * bflo(b.y) + e2 * bflo(c.y), e0 * bfhi(a.y) + e1 * bfhi(b.y) + e2 * bfhi(c.y));
        o.z = pk2(e0 * bflo(a.z) + e1 * bflo(b.z) + e2 * bflo(c.z), e0 * bfhi(a.z) + e1 * bfhi(b.z) + e2 * bfhi(c.z));
        o.w = pk2(e0 * bflo(a.w) + e1 * bflo(b.w) + e2 * bflo(c.w), e0 * bfhi(a.w) + e1 * bfhi(b.w) + e2 * bfhi(c.w));
        *(v4u*)(ATT + (size_t)m * 1536 + j * 128 + d8) = o;
    }
}
__device__ __forceinline__ void mlstm_post(Frame& F, const float* norm_w) {
    const bf16* PROJ = (const bf16*)(F.ws + WS_PROJ); const float* NUM = (const float*)(F.ws + WS_NUM); const float* DEN = (const float*)(F.ws + WS_DEN); const float* MT = (const float*)(F.ws + WS_MT);
    bf16* HM = (bf16*)(F.ws + WS_AH);
    const int gw = F.vcu * NWAVES + F.wave, NGW = F.G * NWAVES;
    for (int it = gw; it < M * 4; it += NGW) {
        const int m = it >> 2, h = it & 3;
        const f32x4 nv = *(const f32x4*)(NUM + (size_t)m * 1024 + h * 256 + 4 * F.lane);
        const float den = DEN[(size_t)m * 4 + h], mt = MT[(size_t)m * 4 + h];
        const float dn = 1.f / fmaxf(fabsf(den), __expf(-mt));
        const f32x4 hv = nv * dn;
        const float mean = wave_sum((hv[0] + hv[1]) + (hv[2] + hv[3])) * (1.f / 256.f);
        const f32x4 dv = hv - mean;
        const float var = wave_sum((dv[0] * dv[0] + dv[1] * dv[1]) + (dv[2] * dv[2] + dv[3] * dv[3])) * (1.f / 256.f);
        const float rs = rsqrtf(var + LN_EPS);
        const f32x4 nw = *(const f32x4*)(norm_w + h * 256 + 4 * F.lane);
        const unsigned long long ow = *(const unsigned long long*)(PROJ + (size_t)m * NP + C_MO + h * 256 + 4 * F.lane);
        const unsigned w0 = (unsigned)ow, w1 = (unsigned)(ow >> 32);
        const float y0 = dv[0] * rs * nw[0] * sigm(bflo(w0)), y1 = dv[1] * rs * nw[1] * sigm(bfhi(w0)), y2 = dv[2] * rs * nw[2] * sigm(bflo(w1)), y3 = dv[3] * rs * nw[3] * sigm(bfhi(w1));
        *(unsigned long long*)(HM + (size_t)m * 1536 + 512 + h * 256 + 4 * F.lane) = (unsigned long long)pk2(y0, y1) | ((unsigned long long)pk2(y2, y3) << 32);
    }
}

__device__ __forceinline__ bf16x8 frag_g(const bf16* base, size_t pitch, int r0, int k0, int lane) { return *(const bf16x8*)(base + (size_t)(r0 + (lane & 15)) * pitch + k0 + 8 * (lane >> 4)); }
__device__ __forceinline__ float scan_add(float v, int lane) {
#pragma unroll
    for (int o = 1; o < 64; o <<= 1) { const float t = __shfl_up(v, o); if (lane >= o) v += t; }
    return v;
}
__device__ __forceinline__ float scan_max(float v, int lane) {
#pragma unroll
    for (int o = 1; o < 64; o <<= 1) { const float t = __shfl_up(v, o); if (lane >= o) v = fmaxf(v, t); }
    return v;
}
constexpr int VIMG_PITCH = 528, KIMG_PITCH = 272, QKIMG_PITCH = 144;
constexpr int L_VIMG = 0, L_KIMG = 33792, L_WK = 51200;
constexpr int L_QKIMG = 33792, L_GS = 43008, L_MX = 43264, L_BS = 43520, L_STAT = 43776;
__device__ __forceinline__ void mlstm_m1(Frame& F) {
    const bf16* PROJ = (const bf16*)(F.ws + WS_PROJ); const bf16* QKC = (const bf16*)(F.ws + WS_QKC); const float* MIF = (const float*)(F.ws + WS_MIF);
    float* KVT = (float*)(F.ws + WS_KVT); float* MLOC = (float*)(F.ws + WS_MSC); float* BLAST = MLOC + 1024; float* NLOC = (float*)(F.ws + WS_MSC + 65536);
    LAS unsigned char* Vimg = F.lds + L_VIMG; LAS unsigned char* Kimg = F.lds + L_KIMG; LAS float* wkL = (LAS float*)(F.lds + L_WK);
    for (int item = F.vcu; item < 512; item += F.G) {
        const int bh = item >> 6, c = item & 63, b = bh >> 2, h = bh & 3; const size_t row0 = (size_t)b * SEQ + (size_t)c * 64;
        __syncthreads();
        if (F.wave == 0) { const float lf = log_sigmoid(MIF[(row0 + F.lane) * 8 + 4 + h]), ip = MIF[(row0 + F.lane) * 8 + h];
            const float bs = scan_add(lf, F.lane), bl = __shfl(bs, 63), wl = bl - bs + ip, ml = wave_max(wl);
            wkL[F.lane] = __expf(wl - ml);
            if (F.lane == 0) { MLOC[item] = ml; BLAST[item] = bl; } }
        for (int idx = F.tid; idx < 2048; idx += NWAVES * 64) { const int s = idx >> 5, c8 = idx & 31;
            *(LAS v4u*)(Vimg + s * VIMG_PITCH + c8 * 16) = *(const v4u*)(PROJ + (row0 + s) * NP + C_MV + h * 256 + c8 * 8); }
        __syncthreads();
        for (int idx = F.tid; idx < 1024; idx += NWAVES * 64) { const int s = idx >> 4, c8 = idx & 15; const float wk = wkL[s];
            const v4u w = *(const v4u*)(QKC + (row0 + s) * 1024 + 512 + h * 128 + c8 * 8); v4u o;
            o.x = pk2(bflo(w.x) * wk, bfhi(w.x) * wk); o.y = pk2(bflo(w.y) * wk, bfhi(w.y) * wk); o.z = pk2(bflo(w.z) * wk, bfhi(w.z) * wk); o.w = pk2(bflo(w.w) * wk, bfhi(w.w) * wk);
            *(LAS v4u*)(Kimg + s * KIMG_PITCH + c8 * 16) = o; }
        __syncthreads();
        if (F.tid < 128) { float a = 0.f;
#pragma unroll 8
            for (int s = 0; s < 64; ++s) a += __uint_as_float((unsigned)(*(const LAS bf16*)(Kimg + s * KIMG_PITCH + F.tid * 2)) << 16);
            NLOC[(size_t)item * 128 + F.tid] = a; }
        f32x4 acc[2][8];
#pragma unroll
        for (int r = 0; r < 2; ++r)
#pragma unroll
            for (int ct = 0; ct < 8; ++ct) acc[r][ct] = (f32x4){0.f, 0.f, 0.f, 0.f};
#pragma unroll
        for (int ks = 0; ks < 2; ++ks) {
            const bf16x8 a0 = frag_tr(Vimg, VIMG_PITCH, 32 * ks, 32 * F.wave, F.lane), a1 = frag_tr(Vimg, VIMG_PITCH, 32 * ks, 32 * F.wave + 16, F.lane);
#pragma unroll
            for (int ct = 0; ct < 8; ++ct) { const bf16x8 bb = frag_tr(Kimg, KIMG_PITCH, 32 * ks, 16 * ct, F.lane);
                acc[0][ct] = __builtin_amdgcn_mfma_f32_16x16x32_bf16(a0, bb, acc[0][ct], 0, 0, 0); acc[1][ct] = __builtin_amdgcn_mfma_f32_16x16x32_bf16(a1, bb, acc[1][ct], 0, 0, 0); } }
        const int i = F.lane & 15, g = F.lane >> 4;
#pragma unroll
        for (int r = 0; r < 2; ++r)
#pragma unroll
            for (int ct = 0; ct < 8; ++ct)
#pragma unroll
                for (int q = 0; q < 4; ++q) KVT[((size_t)item * 256 + 32 * F.wave + 16 * r + 4 * g + q) * 128 + 16 * ct + i] = acc[r][ct][q];
    }
}
__device__ __forceinline__ void mlstm_m2(Frame& F) {
    const float* KVT = (const float*)(F.ws + WS_KVT); bf16* CPREV = (bf16*)(F.ws + WS_CPREV);
    const float* MLOC = (const float*)(F.ws + WS_MSC); const float* BLAST = MLOC + 1024; float* MPREV = (float*)(F.ws + WS_MSC) + 2048;
    const float* NLOC = (const float*)(F.ws + WS_MSC + 65536); float* NPREV = (float*)(F.ws + WS_MSC + 524288);
    const int gt = F.vcu * (NWAVES * 64) + F.tid, NT = F.G * NWAVES * 64;
    for (int p = gt; p < 8 * 256 * 64; p += NT) {
        const int bh = p >> 14, rem = p & 16383, v = rem >> 6, d2 = (rem & 63) * 2;
        float c0 = 0.f, c1 = 0.f, m = 0.f;
#pragma unroll 4
        for (int c = 0; c < 64; ++c) { const int item = bh * 64 + c; const size_t off = ((size_t)item * 256 + v) * 128 + d2;
            *(unsigned*)(CPREV + off) = pk2(c0, c1);
            const float2 kv = *(const float2*)(KVT + off);
            const float ml = MLOC[item], bl = BLAST[item], mn = fmaxf(bl + m, ml), dec = __expf(bl + m - mn), sc = __expf(ml - mn); m = mn;
            c0 = dec * c0 + sc * kv.x; c1 = dec * c1 + sc * kv.y; }
    }
    if (gt < 8 * 128) { const int bh = gt >> 7, d = gt & 127; float n = 0.f, m = 0.f;
        for (int c = 0; c < 64; ++c) { const int item = bh * 64 + c;
            NPREV[(size_t)item * 128 + d] = n; if (d == 0) MPREV[item] = m;
            const float ml = MLOC[item], bl = BLAST[item], mn = fmaxf(bl + m, ml), dec = __expf(bl + m - mn), sc = __expf(ml - mn); m = mn;
            n = dec * n + sc * NLOC[(size_t)item * 128 + d]; } }
}
__device__ __forceinline__ void mlstm_m3(Frame& F, const float* norm_w) {
    const bf16* PROJ = (const bf16*)(F.ws + WS_PROJ); const bf16* QKC = (const bf16*)(F.ws + WS_QKC); const float* MIF = (const float*)(F.ws + WS_MIF);
    const bf16* CPREV = (const bf16*)(F.ws + WS_CPREV); const float* MPREV = (const float*)(F.ws + WS_MSC) + 2048; const float* NPREV = (const float*)(F.ws + WS_MSC + 524288);
    bf16* HM = (bf16*)(F.ws + WS_AH);
    LAS unsigned char* Vimg = F.lds + L_VIMG; LAS unsigned char* QKimg = F.lds + L_QKIMG;
    LAS float* gsL = (LAS float*)(F.lds + L_GS); LAS float* mxL = (LAS float*)(F.lds + L_MX); LAS float* bsL = (LAS float*)(F.lds + L_BS); LAS float* stL = (LAS float*)(F.lds + L_STAT);
    const int i = F.lane & 15, g = F.lane >> 4, rt = F.wave & 3, ch = F.wave >> 2;
    for (int item = F.vcu; item < 512; item += F.G) {
        const int bh = item >> 6, c = item & 63, b = bh >> 2, h = bh & 3; const size_t row0 = (size_t)b * SEQ + (size_t)c * 64;
        __syncthreads();
        const float mprev = MPREV[item];
        if (F.wave == 0) { const float lf = log_sigmoid(MIF[(row0 + F.lane) * 8 + 4 + h]), ip = MIF[(row0 + F.lane) * 8 + h];
            const float bs = scan_add(lf, F.lane), gv = ip - bs, pm = scan_max(gv, F.lane);
            gsL[F.lane] = gv; mxL[F.lane] = fmaxf(mprev, pm); bsL[F.lane] = bs; }
        for (int idx = F.tid; idx < 2048; idx += NWAVES * 64) { const int s = idx >> 5, c8 = idx & 31;
            *(LAS v4u*)(Vimg + s * VIMG_PITCH + c8 * 16) = *(const v4u*)(PROJ + (row0 + s) * NP + C_MV + h * 256 + c8 * 8); }
        bf16x8 qf[4];
#pragma unroll
        for (int ks = 0; ks < 4; ++ks) qf[ks] = frag_g(QKC + h * 128, 1024, (int)row0 + 16 * rt, 32 * ks, F.lane);
        __syncthreads();
#pragma unroll
        for (int cc = 0; cc < 2; ++cc) { const int ct = 2 * ch + cc; f32x4 sv = (f32x4){0.f, 0.f, 0.f, 0.f};
            if (ct <= rt) {
#pragma unroll
                for (int ks = 0; ks < 4; ++ks) { const bf16x8 kf = frag_g(QKC + 512 + h * 128, 1024, (int)row0 + 16 * ct, 32 * ks, F.lane); sv = __builtin_amdgcn_mfma_f32_16x16x32_bf16(qf[ks], kf, sv, 0, 0, 0); } }
            const int sidx = 16 * ct + i; const float gsv = gsL[sidx];
#pragma unroll
            for (int q = 0; q < 4; ++q) { const int l = 16 * rt + 4 * g + q; const float val = (sidx <= l) ? sv[q] * QSCALE * __expf(gsv - mxL[l]) : 0.f;
                *(LAS bf16*)(QKimg + l * QKIMG_PITCH + sidx * 2) = (bf16)f2bf(val); } }
        __syncthreads();
        bf16x8 pf[2];
#pragma unroll
        for (int ks = 0; ks < 2; ++ks) pf[ks] = *(const LAS bf16x8*)(QKimg + (16 * rt + i) * QKIMG_PITCH + (32 * ks + 8 * g) * 2);
        f32x4 accs = (f32x4){0.f, 0.f, 0.f, 0.f}, accn = (f32x4){0.f, 0.f, 0.f, 0.f};
        { const bf16x8 ones = (bf16x8){0x3F80, 0x3F80, 0x3F80, 0x3F80, 0x3F80, 0x3F80, 0x3F80, 0x3F80};
#pragma unroll
          for (int ks = 0; ks < 2; ++ks) accs = __builtin_amdgcn_mfma_f32_16x16x32_bf16(pf[ks], ones, accs, 0, 0, 0);
#pragma unroll
          for (int ks = 0; ks < 4; ++ks) { const float* np = NPREV + (size_t)item * 128 + 32 * ks + 8 * g; const f32x4 n0 = *(const f32x4*)np, n1 = *(const f32x4*)(np + 4);
              union { bf16x8 v; unsigned u[4]; } nf; nf.u[0] = pk2(n0[0], n0[1]); nf.u[1] = pk2(n0[2], n0[3]); nf.u[2] = pk2(n1[0], n1[1]); nf.u[3] = pk2(n1[2], n1[3]);
              accn = __builtin_amdgcn_mfma_f32_16x16x32_bf16(qf[ks], nf.v, accn, 0, 0, 0); } }
        f32x4 a1[8], a2[8];
#pragma unroll
        for (int ct = 0; ct < 8; ++ct) { a1[ct] = (f32x4){0.f, 0.f, 0.f, 0.f}; a2[ct] = (f32x4){0.f, 0.f, 0.f, 0.f}; }
        const bf16* cp = CPREV + (size_t)item * 256 * 128;
#pragma unroll
        for (int ct = 0; ct < 8; ++ct) { const int vcol = 128 * ch + 16 * ct;
#pragma unroll
            for (int ks = 0; ks < 4; ++ks) { const bf16x8 cf = frag_g(cp, 128, vcol, 32 * ks, F.lane); a1[ct] = __builtin_amdgcn_mfma_f32_16x16x32_bf16(qf[ks], cf, a1[ct], 0, 0, 0); }
#pragma unroll
            for (int ks = 0; ks < 2; ++ks) { const bf16x8 vf = frag_tr(Vimg, VIMG_PITCH, 32 * ks, vcol, F.lane); a2[ct] = __builtin_amdgcn_mfma_f32_16x16x32_bf16(pf[ks], vf, a2[ct], 0, 0, 0); } }
        float s1[4], s2[4];
#pragma unroll
        for (int q = 0; q < 4; ++q) { const int l = 16 * rt + 4 * g + q; const float mx = mxL[l], wi = __expf(mprev - mx) * QSCALE, mt = bsL[l] + mx;
            const float den = wi * accn[q] + accs[q], dn = 1.f / fmaxf(fabsf(den), __expf(-mt)); float a = 0.f, bq = 0.f;
#pragma unroll
            for (int ct = 0; ct < 8; ++ct) { const float hv = (wi * a1[ct][q] + a2[ct][q]) * dn; a1[ct][q] = hv; a += hv; bq += hv * hv; }
            a += __shfl_xor(a, 1); a += __shfl_xor(a, 2); a += __shfl_xor(a, 4); a += __shfl_xor(a, 8);
            bq += __shfl_xor(bq, 1); bq += __shfl_xor(bq, 2); bq += __shfl_xor(bq, 4); bq += __shfl_xor(bq, 8);
            s1[q] = a; s2[q] = bq;
            if (i == 0) { stL[(l * 2 + ch) * 2] = a; stL[(l * 2 + ch) * 2 + 1] = bq; } }
        __syncthreads();
#pragma unroll
        for (int q = 0; q < 4; ++q) { const int l = 16 * rt + 4 * g + q; const float sa = stL[(l * 2) * 2] + stL[(l * 2 + 1) * 2], qa = stL[(l * 2) * 2 + 1] + stL[(l * 2 + 1) * 2 + 1];
            const float mean = sa * (1.f / 256.f), var = qa * (1.f / 256.f) - mean * mean, rs = rsqrtf(fmaxf(var, 0.f) + LN_EPS);
            const size_t m = row0 + l;
#pragma unroll
            for (int ct = 0; ct < 8; ++ct) { const int v = 128 * ch + 16 * ct + i;
                const float og = __uint_as_float((unsigned)PROJ[m * NP + C_MO + h * 256 + v] << 16);
                HM[m * 1536 + 512 + h * 256 + v] = (bf16)f2bf((a1[ct][q] - mean) * rs * norm_w[h * 256 + v] * sigm(og)); } }
        (void)s1; (void)s2;
    }
}

__device__ __forceinline__ bf16x8 frag_vt(const LAS unsigned char* Vimg, int row0a, int row0b, int dcol0, int lane) {
    const int i = lane & 15, g = lane >> 4, q = i >> 2, gi = (dcol0 >> 2) + (i & 3);
    const int ra = row0a + 4 * g + q, rb = row0b + 4 * g + q;
    const s16x4 a = __builtin_amdgcn_ds_read_tr16_b64_v4i16((LAS s16x4*)(Vimg + ra * 256 + ((gi ^ ((ra & 7) << 2)) << 3)));
    const s16x4 b = __builtin_amdgcn_ds_read_tr16_b64_v4i16((LAS s16x4*)(Vimg + rb * 256 + ((gi ^ ((rb & 7) << 2)) << 3)));
    return (bf16x8){a[0], a[1], a[2], a[3], b[0], b[1], b[2], b[3]};
}
__device__ __forceinline__ void attn_mfma(Frame& F) {
    const bf16* PROJ = (const bf16*)(F.ws + WS_PROJ); bf16* ATTO = (bf16*)(F.ws + WS_ATTO); float* LSE = (float*)(F.ws + WS_LSE);
    LAS unsigned char* Vimg = F.lds + RING_OFF;
    const int i = F.lane & 15, g = F.lane >> 4, w = F.wave;
    for (int it = F.vcu; it < 768; it += F.G) {
        const int grp = it >> 8, r1 = it & 255, b = r1 >> 7, hh = (r1 >> 5) & 3, rest = r1 & 31;
        const int rd = grp == 0 ? 1 : (grp == 1 ? 4 : 16), nb = 32 / rd, p = rest / nb, n = rest % nb, h = grp * 4 + hh;
        const float sl = alibi_slope(h) * (float)rd;
        const size_t tok0 = (size_t)b * SEQ + p;
        __syncthreads();
        for (int idx = F.tid; idx < 4096; idx += NWAVES * 64) { const int ki = idx >> 4, cj = idx & 15, u = (n - 1) * 128 + ki; v4u val = (v4u){0u, 0u, 0u, 0u};
            if (u >= 0) val = *(const v4u*)(PROJ + (tok0 + (size_t)u * rd) * NP + C_AV + h * 128 + cj * 8);
            *(LAS v4u*)(Vimg + ki * 256 + ((cj ^ ((ki & 7) << 1)) << 4)) = val; }
        const int qi = 16 * w + i; const size_t qtok = tok0 + (size_t)(128 * n + qi) * rd;
        bf16x8 qf[4];
#pragma unroll
        for (int ks = 0; ks < 4; ++ks) qf[ks] = *(const bf16x8*)(PROJ + qtok * NP + C_AQ + h * 128 + 32 * ks + 8 * g);
        f32x4 sv[10];
#pragma unroll
        for (int j = 0; j < 9; ++j) { sv[j] = (f32x4){0.f, 0.f, 0.f, 0.f}; int u = (n - 1) * 128 + 16 * (w + j) + i; u = u < 0 ? 0 : u;
            const bf16* kp = PROJ + (tok0 + (size_t)u * rd) * NP + C_AK + h * 128 + 8 * g;
#pragma unroll
            for (int ks = 0; ks < 4; ++ks) { const bf16x8 kf = *(const bf16x8*)(kp + 32 * ks); sv[j] = __builtin_amdgcn_mfma_f32_16x16x32_bf16(kf, qf[ks], sv[j], 0, 0, 0); } }
        sv[9] = (f32x4){0.f, 0.f, 0.f, 0.f};
        float mx = -INFINITY;
#pragma unroll
        for (int j = 0; j < 9; ++j)
#pragma unroll
            for (int q = 0; q < 4; ++q) { const int ki = 16 * (w + j) + 4 * g + q, delta = 128 + qi - ki; const bool valid = delta >= 0 && delta <= 128 && (n > 0 || ki >= 128);
                const float s = valid ? sv[j][q] * QSCALE - sl * (float)delta : -INFINITY; sv[j][q] = s; mx = fmaxf(mx, s); }
        mx = fmaxf(mx, __shfl_xor(mx, 16)); mx = fmaxf(mx, __shfl_xor(mx, 32));
        float l = 0.f;
#pragma unroll
        for (int j = 0; j < 9; ++j)
#pragma unroll
            for (int q = 0; q < 4; ++q) { const float pv = (sv[j][q] == -INFINITY) ? 0.f : __expf(sv[j][q] - mx); sv[j][q] = pv; l += pv; }
        l += __shfl_xor(l, 16); l += __shfl_xor(l, 32);
        bf16x8 pf[5];
#pragma unroll
        for (int st = 0; st < 5; ++st) { union { bf16x8 v; unsigned u[4]; } t; t.u[0] = pk2(sv[2 * st][0], sv[2 * st][1]); t.u[1] = pk2(sv[2 * st][2], sv[2 * st][3]);
            t.u[2] = pk2(sv[2 * st + 1][0], sv[2 * st + 1][1]); t.u[3] = pk2(sv[2 * st + 1][2], sv[2 * st + 1][3]); pf[st] = t.v; }
        __syncthreads();
        f32x4 o[8];
#pragma unroll
        for (int dt = 0; dt < 8; ++dt) o[dt] = (f32x4){0.f, 0.f, 0.f, 0.f};
#pragma unroll
        for (int st = 0; st < 5; ++st) { const int T0 = w + 2 * st, T1 = (T0 + 1) > 15 ? 15 : (T0 + 1);
#pragma unroll
            for (int dt = 0; dt < 8; ++dt) { const bf16x8 vf = frag_vt(Vimg, 16 * T0, 16 * T1, 16 * dt, F.lane); o[dt] = __builtin_amdgcn_mfma_f32_16x16x32_bf16(vf, pf[st], o[dt], 0, 0, 0); } }
        const float il = 1.f / l;
#pragma unroll
        for (int dt = 0; dt < 8; ++dt)
            *(unsigned long long*)(ATTO + qtok * 1536 + h * 128 + 16 * dt + 4 * g) = (unsigned long long)pk2(o[dt][0] * il, o[dt][1] * il) | ((unsigned long long)pk2(o[dt][2] * il, o[dt][3] * il) << 32);
        if (g == 0) LSE[qtok * 12 + h] = mx + __logf(l);
    }
}
__device__ __forceinline__ void ln1_router(Frame& F, const float* g1, const float* b1, const float* brg, const float* bre) {
    const float* PRE = (const float*)(F.ws + WS_TMP); float* H1 = (float*)(F.ws + WS_H1); bf16* H1B = (bf16*)(F.ws + WS_H1B);
    const bf16* WRH = (const bf16*)(F.ws + WS_WRT); const bf16* WRL = WRH + 48 * D;
    int* TOKLIST = (int*)(F.ws + WS_TOKLIST); int* TOKINFO = (int*)(F.ws + WS_TOKINFO);
    LAS float* part = (LAS float*)(F.lds + RING_OFF);
    const int i = F.lane & 15, g = F.lane >> 4;
    for (int R0 = 32 * F.vcu; R0 < M; R0 += 32 * F.G) {
        __syncthreads();
        for (int rr = 0; rr < 4; ++rr) { const int m = R0 + 4 * F.wave + rr;
            const f32x4* xr = (const f32x4*)(PRE + (size_t)m * D) + F.lane;
            f32x4 v[8]; float s = 0.f;
#pragma unroll
            for (int j = 0; j < 8; ++j) { v[j] = xr[64 * j]; s += (v[j][0] + v[j][1]) + (v[j][2] + v[j][3]); }
            const float mean = wave_sum(s) * (1.f / D); float s2 = 0.f;
#pragma unroll
            for (int j = 0; j < 8; ++j) { const f32x4 d = v[j] - mean; s2 += (d[0] * d[0] + d[1] * d[1]) + (d[2] * d[2] + d[3] * d[3]); }
            const float rstd = rsqrtf(wave_sum(s2) * (1.f / D) + LN_EPS);
            f32x4* h1r = (f32x4*)(H1 + (size_t)m * D) + F.lane; unsigned long long* o8 = (unsigned long long*)(H1B + (size_t)m * D) + F.lane;
#pragma unroll
            for (int j = 0; j < 8; ++j) { const int k0 = 4 * F.lane + 256 * j; const f32x4 g4 = *(const f32x4*)(g1 + k0), b4 = *(const f32x4*)(b1 + k0);
                const f32x4 hv = (v[j] - mean) * rstd * g4 + b4;
                h1r[64 * j] = hv; o8[64 * j] = (unsigned long long)pk2(hv[0], hv[1]) | ((unsigned long long)pk2(hv[2], hv[3]) << 32); } }
        VM_WAIT(); __syncthreads();
        { const int rtile = F.wave & 1, kq = F.wave >> 1; f32x4 acc[3];
#pragma unroll
          for (int ct = 0; ct < 3; ++ct) acc[ct] = (f32x4){0.f, 0.f, 0.f, 0.f};
          const float* hp = H1 + (size_t)(R0 + 16 * rtile + i) * D + 512 * kq + 8 * g;
#pragma unroll 4
          for (int ks = 0; ks < 16; ++ks) { const f32x4 x0 = *(const f32x4*)(hp + 32 * ks), x1 = *(const f32x4*)(hp + 32 * ks + 4);
              union { bf16x8 v; unsigned u[4]; } ah, al;
              ah.u[0] = pk2(x0[0], x0[1]); ah.u[1] = pk2(x0[2], x0[3]); ah.u[2] = pk2(x1[0], x1[1]); ah.u[3] = pk2(x1[2], x1[3]);
              al.u[0] = pk2(x0[0] - bflo(ah.u[0]), x0[1] - bfhi(ah.u[0])); al.u[1] = pk2(x0[2] - bflo(ah.u[1]), x0[3] - bfhi(ah.u[1]));
              al.u[2] = pk2(x1[0] - bflo(ah.u[2]), x1[1] - bfhi(ah.u[2])); al.u[3] = pk2(x1[2] - bflo(ah.u[3]), x1[3] - bfhi(ah.u[3]));
#pragma unroll
              for (int ct = 0; ct < 3; ++ct) { const size_t wo = (size_t)(16 * ct + i) * D + 512 * kq + 32 * ks + 8 * g;
                  const bf16x8 bh = *(const bf16x8*)(WRH + wo), bl = *(const bf16x8*)(WRL + wo);
                  acc[ct] = __builtin_amdgcn_mfma_f32_16x16x32_bf16(ah.v, bh, acc[ct], 0, 0, 0);
                  acc[ct] = __builtin_amdgcn_mfma_f32_16x16x32_bf16(al.v, bh, acc[ct], 0, 0, 0);
                  acc[ct] = __builtin_amdgcn_mfma_f32_16x16x32_bf16(ah.v, bl, acc[ct], 0, 0, 0); } }
#pragma unroll
          for (int ct = 0; ct < 3; ++ct)
#pragma unroll
              for (int q = 0; q < 4; ++q) part[(kq * 32 + 16 * rtile + 4 * g + q) * 48 + 16 * ct + i] = acc[ct][q]; }
        __syncthreads();
        if (F.tid < 32) { const int m = R0 + F.tid;
            float ae[32], ag[4];
#pragma unroll
            for (int e = 0; e < 32; ++e) ae[e] = ((part[(0 * 32 + F.tid) * 48 + e] + part[(1 * 32 + F.tid) * 48 + e]) + (part[(2 * 32 + F.tid) * 48 + e] + part[(3 * 32 + F.tid) * 48 + e])) + bre[e];
#pragma unroll
            for (int e = 0; e < 4; ++e) ag[e] = ((part[(0 * 32 + F.tid) * 48 + 32 + e] + part[(1 * 32 + F.tid) * 48 + 32 + e]) + (part[(2 * 32 + F.tid) * 48 + 32 + e] + part[(3 * 32 + F.tid) * 48 + 32 + e])) + brg[e];
            int grp = 0; float gm = ag[0];
#pragma unroll
            for (int e = 1; e < 4; ++e) if (ag[e] > gm) { gm = ag[e]; grp = e; }
            float gs = 0.f;
#pragma unroll
            for (int e = 0; e < 4; ++e) gs += __expf(ag[e] - gm);
            const float gwt = 1.f / gs;
            float el[8];
#pragma unroll
            for (int e = 0; e < 8; ++e) el[e] = grp == 0 ? ae[e] : (grp == 1 ? ae[8 + e] : (grp == 2 ? ae[16 + e] : ae[24 + e]));
            int i1 = 0; float v1 = el[0];
#pragma unroll
            for (int e = 1; e < 8; ++e) if (el[e] > v1) { v1 = el[e]; i1 = e; }
            int i2 = 0; float v2 = -INFINITY;
#pragma unroll
            for (int e = 0; e < 8; ++e) if (e != i1 && el[e] > v2) { v2 = el[e]; i2 = e; }
            const float ex = __expf(v2 - v1), p1 = 1.f / (1.f + ex), p2 = ex * p1;
            const int e1 = grp * 8 + i1, e2 = grp * 8 + i2;
            const int pos1 = (int)__hip_atomic_fetch_add(F.ctl + CW_CNT + 16 * e1, 1u, RLX_AGENT), pos2 = (int)__hip_atomic_fetch_add(F.ctl + CW_CNT + 16 * e2, 1u, RLX_AGENT);
            TOKLIST[e1 * ECAP + pos1] = m; TOKLIST[e2 * ECAP + pos2] = m;
            int* ti = TOKINFO + (size_t)m * 8; ti[0] = e1; ti[1] = pos1; ti[2] = e2; ti[3] = pos2; ti[4] = __float_as_int(gwt * p1); ti[5] = __float_as_int(gwt * p2);
        }
    }
}
struct MoeOrder {
    const LAS int* TS; const LAS int* CN; const int* toklist; int NT, G, c, U; bool gather;
    __device__ __forceinline__ void init(const LAS int* ts, const LAS int* cn, const int* tl, int nt, int G_, int c_, bool ga) { TS = ts; CN = cn; toklist = tl; NT = nt; G = G_; c = c_; U = ts[NE] * nt; gather = ga; }
    __device__ __forceinline__ bool next(int i, pg8::Unit& u) const {
        const int x = c & 7, r = c >> 3, W = G >> 3;
        const int lo = (int)(((long)U * x) >> 3), hi = (int)(((long)U * (x + 1)) >> 3);
        const int L = lo + r + i * W; if (L >= hi) return false;
        int e = 0;
#pragma unroll 1
        for (int k = 1; k < NE; ++k) if (L >= TS[k] * NT) e = k;
        const int ne = TS[e + 1] - TS[e], loc = L - TS[e] * NT, n_t = loc / ne, m_t = loc % ne;
        u.pm = TS[e] + m_t; u.pn = e * NT + n_t; u.e = e; u.r0 = m_t * 256; u.half = (CN[e] - m_t * 256) <= 128 ? 1 : 0; return true;
    }
    __device__ __forceinline__ int arow(const pg8::Unit& u, int r) const {
        if (!gather) return u.pm * 256 + r;
        int idx = u.r0 + r; const int cn = CN[u.e]; idx = idx < cn ? idx : cn - 1;
        return toklist[u.e * ECAP + idx];
    }
    __device__ __forceinline__ void a_ready(const pg8::Unit&) const {}
    __device__ __forceinline__ void done(const pg8::Unit&) const {}
};
__device__ __forceinline__ void moe_tables(Frame& F) {
    LAS int* TS = (LAS int*)(F.lds + TS_OFF); LAS int* CN = (LAS int*)(F.lds + CNT_OFF);
    if (F.tid < NE) CN[F.tid] = (int)__hip_atomic_load(F.ctl + CW_CNT + 16 * F.tid, RLX_AGENT);
    __syncthreads();
    if (F.tid == 0) { int acc = 0; for (int e = 0; e < NE; ++e) { TS[e] = acc; acc += (CN[e] + 255) >> 8; } TS[NE] = acc; }
    __syncthreads();
}
__device__ __forceinline__ void final_ln(Frame& F, const float* g2, const float* b2, float* out) {
    const float* H1 = (const float*)(F.ws + WS_H1); const bf16* YS = (const bf16*)(F.ws + WS_YS); const int* TOKINFO = (const int*)(F.ws + WS_TOKINFO);
    const LAS int* TS = (const LAS int*)(F.lds + TS_OFF);
    const int gw = F.vcu * NWAVES + F.wave, NGW = F.G * NWAVES;
    for (int m = gw; m < M; m += NGW) {
        const int* ti = TOKINFO + (size_t)m * 8;
        const int e1 = ti[0], p1 = ti[1], e2 = ti[2], p2 = ti[3]; const float w1 = __int_as_float(ti[4]), w2 = __int_as_float(ti[5]);
        const size_t sl1 = (size_t)TS[e1] * 256 + p1, sl2 = (size_t)TS[e2] * 256 + p2;
        const f32x4* hr = (const f32x4*)(H1 + (size_t)m * D) + F.lane;
        const unsigned long long* y1 = (const unsigned long long*)(YS + sl1 * D) + F.lane; const unsigned long long* y2 = (const unsigned long long*)(YS + sl2 * D) + F.lane;
        f32x4 v[8]; float s = 0.f;
#pragma unroll
        for (int j = 0; j < 8; ++j) { const f32x4 hv = hr[64 * j]; const unsigned long long a = y1[64 * j], b = y2[64 * j];
            const unsigned a0 = (unsigned)a, a1 = (unsigned)(a >> 32), b0 = (unsigned)b, b1 = (unsigned)(b >> 32);
            f32x4 y; y[0] = w1 * bflo(a0) + w2 * bflo(b0); y[1] = w1 * bfhi(a0) + w2 * bfhi(b0); y[2] = w1 * bflo(a1) + w2 * bflo(b1); y[3] = w1 * bfhi(a1) + w2 * bfhi(b1);
            v[j] = hv * ALPHA + y; s += (v[j][0] + v[j][1]) + (v[j][2] + v[j][3]); }
        const float mean = wave_sum(s) * (1.f / D); float s2 = 0.f;
#pragma unroll
        for (int j = 0; j < 8; ++j) { const f32x4 d = v[j] - mean; s2 += (d[0] * d[0] + d[1] * d[1]) + (d[2] * d[2] + d[3] * d[3]); }
        const float rstd = rsqrtf(wave_sum(s2) * (1.f / D) + LN_EPS);
        f32x4* orow = (f32x4*)(out + (size_t)m * D) + F.lane;
#pragma unroll
        for (int j = 0; j < 8; ++j) { const int k0 = 4 * F.lane + 256 * j; const f32x4 g4 = *(const f32x4*)(g2 + k0), b4 = *(const f32x4*)(b2 + k0);
            orow[64 * j] = (v[j] - mean) * rstd * g4 + b4; }
    }
}

#ifndef SKIPMASK
#define SKIPMASK 0
#endif
#ifndef ATTN_NAIVE
#define ATTN_NAIVE 0
#endif
#ifndef NCONV_PER_XCD
#define NCONV_PER_XCD 16
#endif
#ifndef MLSTM_NAIVE
#define MLSTM_NAIVE 0
#endif
#ifndef DUP2MASK
#define DUP2MASK 0
#endif
#ifndef DUPMASK
#define DUPMASK 0
#endif
constexpr int N_PHASES = 12;
struct Args { const float* in[22]; float* out; unsigned char* ws; int ph_lo, ph_hi, li, pad; };
__global__ void __launch_bounds__(NWAVES * 64, 2) fwd_kernel(Args args) {
    extern __shared__ __attribute__((aligned(16))) unsigned char lds[];
    Frame F;
    F.lds = (LAS unsigned char*)lds;
    F.tid = threadIdx.x; F.lane = F.tid & 63; F.wave = __builtin_amdgcn_readfirstlane(F.tid >> 6);
    F.G = gridDim.x; { const int bx = blockIdx.x; F.vcu = (F.G % 8 == 0) ? (bx % 8) * (F.G / 8) + bx / 8 : bx; }
    F.ws = args.ws; F.ctl = (gu32*)(args.ws + WS_CTL);
    for (int u = F.tid; u < (LDS_BYTES - LDSCTL_OFF) / 4; u += NWAVES * 64) ((LAS unsigned*)(F.lds + LDSCTL_OFF))[u] = 0u;
    __syncthreads();
    XcdBarrier bar = xcd_barrier_post((unsigned*)(F.ctl + CW_BAR) + args.li * XCD_BAR_WORDS, (volatile LAS unsigned*)(F.lds + MISC_OFF) + 8);
    const int lo = args.ph_lo, hi = args.ph_hi;
#define IN(k) (lo <= (k) && (k) < hi && !(SKIPMASK & (1 << (k))))
#define REP(k) for (int rep_ = 0; rep_ < ((DUPMASK >> (k)) & 1) + 1; ++rep_)
#define SEAM(k) do { if (lo <= (k) && (k) + 1 < hi) xcd_barrier(bar); } while (0)
    unsigned char* ws = args.ws;
    if (IN(0)) REP(0) { p0_prologue(F, args.in[0], args.in[1], args.in[2], args.in[3], args.in[6], args.in[8], args.in[9], args.in[10], args.in[13], args.in[15]); __syncthreads(); }
    SEAM(0);
    if (IN(1)) {
        const int bx = (int)blockIdx.x, rank = bx >> 3;
        if (NCONV_PER_XCD > 0 && (rank % (32 / NCONV_PER_XCD)) == (32 / NCONV_PER_XCD) - 1) {
            moe_convert(F, (bx & 7) * NCONV_PER_XCD + rank / (32 / NCONV_PER_XCD), 8 * NCONV_PER_XCD, args.in[17], args.in[18], args.in[19]); __syncthreads(); }
        pg8::Gemm g{(const bf16*)(ws + WS_HB), (const bf16*)(ws + WS_WIN), M, NP, D};
        QueueOrder S; S.init(M, NP, bx, F.ctl + CW_Q, (volatile LAS int*)(F.lds + QSLOT_OFF));
        pg8::EpiBf16 E{(bf16*)(ws + WS_PROJ), NP};
        pg8::gemm_phase<pg8::EpiBf16, QueueOrder, true, true>(F.lds + RING_OFF, g, S, E); }
    SEAM(1);
#if ATTN_NAIVE
    if (IN(2)) REP(2) { conv_qk(F, args.in[4], args.in[5]); attn_naive(F); }
#else
    if (IN(2)) REP(2) { conv_qk(F, args.in[4], args.in[5]); attn_mfma(F); }
#endif
    SEAM(2);
#if MLSTM_NAIVE
    if (IN(3)) { if (F.vcu < 8) mlstm_naive(F, F.vcu); else attn_merge(F, 8); }
    SEAM(3);
    if (IN(4)) { mlstm_post(F, args.in[7]); }
    SEAM(4);
    SEAM(5);
#else
    if (IN(3)) REP(3) { mlstm_m1(F); attn_merge(F, 0); }
    SEAM(3);
    if (IN(4)) REP(4) { mlstm_m2(F); }
    SEAM(4);
    if (IN(5)) REP(5) { mlstm_m3(F, args.in[7]); }
    SEAM(5);
#endif
    if (IN(6)) { pg8::Gemm g{(const bf16*)(ws + WS_AH), (const bf16*)(ws + WS_WPA), M, D, 1536}; pg8::StaticOrder S; S.init(M, D, F.G, (int)blockIdx.x);
        pg8::EpiMerge E{(bf16*)(ws + WS_MERGED), D, (const bf16*)(ws + WS_PROJ) + C_GATE, NP};
        pg8::gemm_phase<pg8::EpiMerge, pg8::StaticOrder, true, true>(F.lds + RING_OFF, g, S, E); }
    SEAM(6);
#define PHASE7_BODY {  pg8::Gemm g{(const bf16*)(ws + WS_MERGED), (const bf16*)(ws + WS_WOUT), M, D, D}; pg8::StaticOrder S; S.init(M, D, F.G, (int)blockIdx.x); \
        pg8::EpiResid E{(float*)(ws + WS_TMP), D, args.in[0], (const float*)(ws + WS_STATS), args.in[1], args.in[2], ALPHA}; \
        pg8::gemm_phase<pg8::EpiResid, pg8::StaticOrder, true, true>(F.lds + RING_OFF, g, S, E);  }
    if (IN(7)) { PHASE7_BODY
#if DUP2MASK & 128
        PHASE7_BODY
#endif
    }
    SEAM(7);
    if (IN(8)) { ln1_router(F, args.in[11], args.in[12], args.in[14], args.in[16]); }
    SEAM(8);
    if (IN(9) || IN(10) || IN(11)) moe_tables(F);
    if (IN(9)) REP(9) { pg8::Gemm g{(const bf16*)(ws + WS_H1B), (const bf16*)(ws + WS_WGU), M, NE * 2 * DFF, D};
        MoeOrder S; S.init((const LAS int*)(F.lds + TS_OFF), (const LAS int*)(F.lds + CNT_OFF), (const int*)(ws + WS_TOKLIST), NT1, F.G, (int)blockIdx.x, true);
        pg8::EpiSwiGlu E{(bf16*)(ws + WS_ACT), DFF, NT1};
        pg8::gemm_phase<pg8::EpiSwiGlu, MoeOrder, true, true>(F.lds + RING_OFF, g, S, E); }
    SEAM(9);
    if (IN(10)) REP(10) { pg8::Gemm g{(const bf16*)(ws + WS_ACT), (const bf16*)(ws + WS_WD), MAXT * 256, NE * D, DFF};
        MoeOrder S; S.init((const LAS int*)(F.lds + TS_OFF), (const LAS int*)(F.lds + CNT_OFF), (const int*)(ws + WS_TOKLIST), NT2, F.G, (int)blockIdx.x, false);
        pg8::EpiBf16Grp E{(bf16*)(ws + WS_YS), D, NT2};
        pg8::gemm_phase<pg8::EpiBf16Grp, MoeOrder, true, true>(F.lds + RING_OFF, g, S, E); }
    SEAM(10);
    if (IN(11)) REP(11) { final_ln(F, args.in[20], args.in[21], args.out); }
#undef IN
#undef SEAM
#undef REP
}

#ifndef MK_PER_PHASE
#define MK_PER_PHASE 0
#endif
extern "C" void kernel_launch(void* const* d_in, const int* in_sizes, int n_in, void* d_out, int out_size, void* d_ws, size_t ws_size, hipStream_t stream) {
    static int grid = 0;
    if (grid == 0) {
        if (n_in != 22 || out_size != M * D || ws_size < WS_END) { fprintf(stderr, "kernel_launch: unexpected problem: n_in %d out %d ws %zu\n", n_in, out_size, ws_size); grid = -1; return; }
        int dev = 0, cus = 0, per_cu = 0;
        if (hipGetDevice(&dev) != hipSuccess || hipDeviceGetAttribute(&cus, hipDeviceAttributeMultiprocessorCount, dev) != hipSuccess) { grid = -1; return; }
        if (hipFuncSetAttribute((const void*)fwd_kernel, hipFuncAttributeMaxDynamicSharedMemorySize, LDS_BYTES) != hipSuccess) { fprintf(stderr, "kernel_launch: hipFuncSetAttribute failed\n"); grid = -1; return; }
        if (hipOccupancyMaxActiveBlocksPerMultiprocessor(&per_cu, (const void*)fwd_kernel, NWAVES * 64, LDS_BYTES) != hipSuccess || per_cu < 1)
            fprintf(stderr, "kernel_launch: note: occupancy query reports %d workgroups per CU\n", per_cu);
        (void)hipGetLastError();
        grid = cus - (cus % 8);
        if (grid < 16) grid = 16;
    }
    if (grid < 0) return;
    (void)hipMemsetAsync((char*)d_ws + WS_CTL, 0, CTL_ZERO_BYTES, stream);
    Args a{};
    for (int i = 0; i < 22; ++i) a.in[i] = (const float*)d_in[i];
    a.out = (float*)d_out; a.ws = (unsigned char*)d_ws; a.pad = 0;
#if MK_PER_PHASE
    for (int p = 0; p < N_PHASES; ++p) { a.ph_lo = p; a.ph_hi = p + 1; a.li = p; hipLaunchKernelGGL(fwd_kernel, dim3(grid), dim3(NWAVES * 64), LDS_BYTES, stream, a); }
#else
    a.ph_lo = 0; a.ph_hi = N_PHASES; a.li = 0;
    hipLaunchKernelGGL(fwd_kernel, dim3(grid), dim3(NWAVES * 64), LDS_BYTES, stream, a);
#endif
}
```

```cpp
#include <hip/hip_runtime.h>
#include <cstdio>
#include <cstdint>
namespace pg8 {
#define PG8_LAS __attribute__((address_space(3)))
typedef unsigned short bf16_t;
typedef short bf16x8 __attribute__((ext_vector_type(8)));
typedef float f32x4 __attribute__((ext_vector_type(4)));
typedef unsigned u32x4 __attribute__((ext_vector_type(4)));
constexpr int BM = 256, BK = 64, HALF = 128, HTB = HALF * BK * 2  , STAGE_BYTES = 8 * HTB, NXCD = 8, WGM = 8;

__host__ __device__ __forceinline__ int lds_byte(int r, int c) { const int st = (r >> 4) * 2 + (c >> 5), rr = r & 15, cc = c & 31, ob = rr * 64 + cc * 2; return st * 1024 + (ob ^ (((ob >> 9) & 1) << 5)); }
__host__ __device__ __forceinline__ void stage_rc(int b, int& R, int& C) { const int st = b / 1024, sb = b % 1024, swz = sb ^ (((sb >> 9) & 1) << 5); R = (st >> 1) * 16 + swz / 64; C = (st & 1) * 32 + (swz % 64) / 2; }
__host__ __device__ __forceinline__ int perm32(int rho) { const int n = rho >> 4, i = rho & 15; return 8 * (i >> 2) + 4 * n + (i & 3); }

struct Unit { int pm, pn, e, r0, half; };
struct Gemm { const bf16_t* A; const bf16_t* Bt; int M, N, K; };

struct StaticOrder {
    int nM, nN, nwg, G, c;
    __host__ __device__ void init(int M, int N, int G_, int c_) { nM = M / BM; nN = N / BM; nwg = nM * nN; G = G_; c = c_; }
    __host__ __device__ bool next(int i, Unit& u) const {
        const long L = (long)i * G + c; if (L >= nwg) return false;
        int wgid = (int)L; { const int q = nwg / NXCD, r = nwg % NXCD, xcd = wgid % NXCD, off = wgid / NXCD; wgid = (xcd < r ? xcd * (q + 1) : r * (q + 1) + (xcd - r) * q) + off; }
        const int nig = WGM * nN, gid = wgid / nig, fm = gid * WGM, gsz = (nM - fm) < WGM ? (nM - fm) : WGM;
        u.pm = fm + ((wgid % nig) % gsz); u.pn = (wgid % nig) / gsz; u.e = 0; u.r0 = 0; u.half = 0; return true;
    }
    __device__ __forceinline__ int arow(const Unit& u, int r) const { return u.pm * BM + r; }
    __device__ __forceinline__ void a_ready(const Unit&) const {}
    __device__ __forceinline__ void done(const Unit&) const {}
};

__device__ __forceinline__ unsigned cvt_pk_bf16(float lo, float hi) { unsigned r; asm volatile("v_cvt_pk_bf16_f32 %0, %1, %2" : "=v"(r) : "v"(lo), "v"(hi)); return r; }
__device__ __forceinline__ float bf_lo(unsigned w) { return __uint_as_float(w << 16); }
__device__ __forceinline__ float bf_hi(unsigned w) { return __uint_as_float(w & 0xffff0000u); }
__device__ __forceinline__ float sigmoidf_(float x) { return 1.0f / (1.0f + __expf(-x)); }

struct EpiBf16 {
    static constexpr bool PERM = true, AFTER_DRAIN = false; static constexpr int MID_T = -1;
    bf16_t* O; int ldc;
    __device__ __forceinline__ void operator()(const f32x4 (&acc)[2][2][4][2], const Unit& u, int wr, int wc, int fr, int fq) const {
        const int row0 = u.pm * BM + wr * 64 + fr; const int col0 = u.pn * BM + wc * 32 + 8 * fq;
#pragma unroll
        for (int ai = 0; ai < 2; ++ai)
#pragma unroll
            for (int m = 0; m < 4; ++m) { bf16_t* rowp = O + (size_t)(row0 + ai * HALF + m * 16) * ldc + col0;
#pragma unroll
                for (int bj = 0; bj < 2; ++bj) { const f32x4 v0 = acc[ai][bj][m][0], v1 = acc[ai][bj][m][1];
                    u32x4 w; w.x = cvt_pk_bf16(v0[0], v0[1]); w.y = cvt_pk_bf16(v0[2], v0[3]); w.z = cvt_pk_bf16(v1[0], v1[1]); w.w = cvt_pk_bf16(v1[2], v1[3]);
                    *(u32x4*)(rowp + bj * HALF) = w; } }
    }
};
struct EpiBf16Grp {
    static constexpr bool PERM = true, AFTER_DRAIN = false; static constexpr int MID_T = -1;
    bf16_t* O; int ldc; int ntn;
    __device__ __forceinline__ void operator()(const f32x4 (&acc)[2][2][4][2], const Unit& u, int wr, int wc, int fr, int fq) const {
        const int row0 = u.pm * BM + wr * 64 + fr; const int col0 = (u.pn % ntn) * BM + wc * 32 + 8 * fq;
#pragma unroll
        for (int ai = 0; ai < 2; ++ai)
#pragma unroll
            for (int m = 0; m < 4; ++m) { bf16_t* rowp = O + (size_t)(row0 + ai * HALF + m * 16) * ldc + col0;
#pragma unroll
                for (int bj = 0; bj < 2; ++bj) { const f32x4 v0 = acc[ai][bj][m][0], v1 = acc[ai][bj][m][1];
                    u32x4 w; w.x = cvt_pk_bf16(v0[0], v0[1]); w.y = cvt_pk_bf16(v0[2], v0[3]); w.z = cvt_pk_bf16(v1[0], v1[1]); w.w = cvt_pk_bf16(v1[2], v1[3]);
                    *(u32x4*)(rowp + bj * HALF) = w; } }
    }
};
struct EpiMerge {
    static constexpr bool PERM = true, AFTER_DRAIN = false; static constexpr int MID_T = 8;
    bf16_t* O; int ldc; const bf16_t* G; int ldg;
    __device__ __forceinline__ void mid(f32x4 (&acc)[2][2][4][2], const Unit& u, int wr, int wc, int fr, int fq) const {
        unsigned goff = (unsigned)(u.pm * BM + wr * 64 + fr) * (unsigned)ldg + (unsigned)(u.pn * BM + wc * 32 + 8 * fq);
        asm volatile("" : "+v"(goff));
        const bf16_t* gp = G + goff;
#define PG8_RATIO(av, mv) ((1.f + __expf(-fmaxf(mv, -30.f))) / (1.f + __expf(-(av))))
#define PG8_GADDR(i) (gp + (size_t)((((i) >> 3) & 1) * HALF + (((i) >> 1) & 3) * 16) * ldg + ((i) & 1) * HALF)
        u32x4 ga[4], gm[4];
#pragma unroll
        for (int i = 0; i < 4; ++i) { ga[i] = *(const u32x4*)PG8_GADDR(i); gm[i] = *(const u32x4*)(PG8_GADDR(i) + ldc); }
        asm volatile("" ::: "memory");
#pragma unroll
        for (int i = 0; i < 16; ++i) { const int ai = (i >> 3) & 1, m = (i >> 1) & 3, bj = i & 1, cb = i & 3;
            const u32x4 a = ga[cb], g = gm[cb];
            acc[ai][bj][m][0][0] *= PG8_RATIO(bf_lo(a.x), bf_lo(g.x)); acc[ai][bj][m][0][1] *= PG8_RATIO(bf_hi(a.x), bf_hi(g.x));
            acc[ai][bj][m][0][2] *= PG8_RATIO(bf_lo(a.y), bf_lo(g.y)); acc[ai][bj][m][0][3] *= PG8_RATIO(bf_hi(a.y), bf_hi(g.y));
            acc[ai][bj][m][1][0] *= PG8_RATIO(bf_lo(a.z), bf_lo(g.z)); acc[ai][bj][m][1][1] *= PG8_RATIO(bf_hi(a.z), bf_hi(g.z));
            acc[ai][bj][m][1][2] *= PG8_RATIO(bf_lo(a.w), bf_lo(g.w)); acc[ai][bj][m][1][3] *= PG8_RATIO(bf_hi(a.w), bf_hi(g.w));
            if (i + 4 < 16) { ga[cb] = *(const u32x4*)PG8_GADDR(i + 4); gm[cb] = *(const u32x4*)(PG8_GADDR(i + 4) + ldc); }
            asm volatile("" : "+v"(acc[ai][bj][m][0]), "+v"(acc[ai][bj][m][1]) :: "memory"); }
#undef PG8_RATIO
#undef PG8_GADDR
    }
    __device__ __forceinline__ void operator()(const f32x4 (&acc)[2][2][4][2], const Unit& u, int wr, int wc, int fr, int fq) const {
        const int row0 = u.pm * BM + wr * 64 + fr; const int col0 = u.pn * BM + wc * 32 + 8 * fq;
#pragma unroll
        for (int ai = 0; ai < 2; ++ai)
#pragma unroll
            for (int m = 0; m < 4; ++m) { const size_t r = (size_t)(row0 + ai * HALF + m * 16);
#pragma unroll
                for (int bj = 0; bj < 2; ++bj) { const u32x4 gm = *(const u32x4*)(G + r * ldg + ldc + col0 + bj * HALF);
                    const f32x4 v0 = acc[ai][bj][m][0], v1 = acc[ai][bj][m][1];
                    const float s0 = sigmoidf_(fmaxf(bf_lo(gm.x), -30.f)), s1 = sigmoidf_(fmaxf(bf_hi(gm.x), -30.f)), s2 = sigmoidf_(fmaxf(bf_lo(gm.y), -30.f)), s3 = sigmoidf_(fmaxf(bf_hi(gm.y), -30.f));
                    const float s4 = sigmoidf_(fmaxf(bf_lo(gm.z), -30.f)), s5 = sigmoidf_(fmaxf(bf_hi(gm.z), -30.f)), s6 = sigmoidf_(fmaxf(bf_lo(gm.w), -30.f)), s7 = sigmoidf_(fmaxf(bf_hi(gm.w), -30.f));
                    u32x4 w; w.x = cvt_pk_bf16(v0[0] * s0, v0[1] * s1); w.y = cvt_pk_bf16(v0[2] * s2, v0[3] * s3); w.z = cvt_pk_bf16(v1[0] * s4, v1[1] * s5); w.w = cvt_pk_bf16(v1[2] * s6, v1[3] * s7);
                    *(u32x4*)(O + r * ldc + col0 + bj * HALF) = w; } }
    }
};
struct EpiResid {
    static constexpr bool PERM = false, AFTER_DRAIN = false; static constexpr int MID_T = -1;
    float* P; int ldc; const float* X; const float* stats; const float* g; const float* b; float alpha;
    __device__ __forceinline__ void operator()(const f32x4 (&acc)[2][2][4][2], const Unit& u, int wr, int wc, int fr, int fq) const {
        const int row0 = u.pm * BM + wr * 64 + fr, col0 = u.pn * BM + wc * 32 + 4 * fq;
        f32x4 gv[2][2], bv[2][2];
#pragma unroll
        for (int bj = 0; bj < 2; ++bj)
#pragma unroll
            for (int n = 0; n < 2; ++n) { gv[bj][n] = *(const f32x4*)(g + col0 + bj * HALF + n * 16); bv[bj][n] = *(const f32x4*)(b + col0 + bj * HALF + n * 16); }
#pragma unroll
        for (int ai = 0; ai < 2; ++ai)
#pragma unroll
            for (int m = 0; m < 4; ++m) { const size_t r = (size_t)(row0 + ai * HALF + m * 16); const float mu = stats[2 * r], rs = stats[2 * r + 1];
#pragma unroll
                for (int bj = 0; bj < 2; ++bj)
#pragma unroll
                    for (int n = 0; n < 2; ++n) { const size_t off = r * ldc + col0 + bj * HALF + n * 16; const f32x4 xv = *(const f32x4*)(X + off);
                        *(f32x4*)(P + off) = ((xv - mu) * rs * gv[bj][n] + bv[bj][n]) * alpha + acc[ai][bj][m][n]; } }
    }
};
struct EpiSwiGlu {
    static constexpr bool PERM = true, AFTER_DRAIN = false; static constexpr int MID_T = -1;
    bf16_t* O; int ldc; int ntn;
    __device__ __forceinline__ void operator()(const f32x4 (&acc)[2][2][4][2], const Unit& u, int wr, int wc, int fr, int fq) const {
        const int row0 = u.pm * BM + wr * 64 + fr; const int col0 = (u.pn % ntn) * HALF + wc * 32 + 8 * fq;
#pragma unroll
        for (int ai = 0; ai < 2; ++ai)
#pragma unroll
            for (int m = 0; m < 4; ++m) { bf16_t* rowp = O + (size_t)(row0 + ai * HALF + m * 16) * ldc + col0;
                float o[8];
#pragma unroll
                for (int n = 0; n < 2; ++n)
#pragma unroll
                    for (int j = 0; j < 4; ++j) { const float gt = acc[ai][0][m][n][j], up = acc[ai][1][m][n][j]; o[4 * n + j] = gt * sigmoidf_(gt) * up; }
                u32x4 w; w.x = cvt_pk_bf16(o[0], o[1]); w.y = cvt_pk_bf16(o[2], o[3]); w.z = cvt_pk_bf16(o[4], o[5]); w.w = cvt_pk_bf16(o[6], o[7]);
                *(u32x4*)rowp = w; }
    }
};

struct EpiSwiGlu8 {
    static constexpr bool PERM = true, AFTER_DRAIN = false; static constexpr int MID_T = -1;
    unsigned char* O; int ldc; int ntn;
    __device__ __forceinline__ void operator()(const f32x4 (&acc)[2][2][4][2], const Unit& u, int wr, int wc, int fr, int fq) const {
        const int row0 = u.pm * BM + wr * 64 + fr; const int nt = u.pn % ntn; const int col0 = nt * HALF + wc * 32 + 8 * fq;
#pragma unroll
        for (int ai = 0; ai < 2; ++ai)
#pragma unroll
            for (int m = 0; m < 4; ++m) { unsigned char* rowp = O + (size_t)(row0 + ai * HALF + m * 16) * ldc;
                float o[8];
#pragma unroll
                for (int n = 0; n < 2; ++n)
#pragma unroll
                    for (int j = 0; j < 4; ++j) { const float gt = acc[ai][0][m][n][j], up = acc[ai][1][m][n][j]; o[4 * n + j] = gt * sigmoidf_(gt) * up; }
                int w0 = 0, w1 = 0;
                w0 = __builtin_amdgcn_cvt_pk_fp8_f32(o[0], o[1], w0, false); w0 = __builtin_amdgcn_cvt_pk_fp8_f32(o[2], o[3], w0, true);
                w1 = __builtin_amdgcn_cvt_pk_fp8_f32(o[4], o[5], w1, false); w1 = __builtin_amdgcn_cvt_pk_fp8_f32(o[6], o[7], w1, true);
                *(unsigned long long*)(rowp + col0) = (unsigned long long)(unsigned)w0 | ((unsigned long long)(unsigned)w1 << 32);
                if (nt == ntn - 1) *(unsigned long long*)(rowp + ntn * HALF + wc * 32 + 8 * fq) = 0ull; }
    }
};

typedef int i32x4 __attribute__((ext_vector_type(4)));
typedef int i32x8 __attribute__((ext_vector_type(8)));
template <class Epi, class Sched, bool ALIGN_EPI = false, bool SP2 = false, bool FP8 = false, int SCALE_A = 127, int SCALE_B = 127>
__device__ __forceinline__ void gemm_phase(PG8_LAS unsigned char* lds, const Gemm g, const Sched& S, const Epi& E) {
    const int tid = threadIdx.x, wid = __builtin_amdgcn_readfirstlane(tid >> 6), lane = tid & 63, wr = wid >> 2, wc = wid & 3, fr = lane & 15, fq = lane >> 4;
    const int K = g.K, nt = K / BK;
    int Rs[2], Cs[2]; unsigned voffB[2];
#pragma unroll
    for (int i = 0; i < 2; ++i) { int R, C; stage_rc(tid * 16 + i * 8192, R, C); const int Rb = Epi::PERM ? ((R & ~31) + perm32(R & 31)) : R;
        Rs[i] = R; Cs[i] = C; voffB[i] = (unsigned)(Rb * K + C) * 2u; }
    const size_t kstep = (size_t)(BK * 2);
    const size_t hstep = (size_t)HALF * K * 2;
    const size_t tstep = 2 * hstep;
    const unsigned ldsw = (unsigned)wid * 1024u;
    const int aoff = lds_byte(wr * 64 + fr, fq * 8), boff = lds_byte(wc * 32 + fr, fq * 8);
#define PG8_SA(b, h) (((b) * 2 + (h)) * HTB)
#define PG8_SB(b, h) ((4 + (b) * 2 + (h)) * HTB)
#define PG8_STAGE(bufoff, gbase, voff) do { _Pragma("unroll") for (int _i = 0; _i < 2; ++_i) \
        __builtin_amdgcn_global_load_lds((const unsigned*)((const char*)(gbase) + (voff)[_i]), (PG8_LAS unsigned*)(lds + (bufoff) + ldsw + _i * 8192), 16, 0, 0); } while (0)
#define PG8_LDA(dst, b, h) do { _Pragma("unroll") for (int m = 0; m < 4; ++m) _Pragma("unroll") for (int k = 0; k < 2; ++k) dst[m][k] = *(const PG8_LAS bf16x8*)(lds + PG8_SA(b, h) + aoff + m * 2048 + k * 1024); } while (0)
#define PG8_LDB(dst, b, h) do { _Pragma("unroll") for (int n = 0; n < 2; ++n) _Pragma("unroll") for (int k = 0; k < 2; ++k) dst[n][k] = *(const PG8_LAS bf16x8*)(lds + PG8_SB(b, h) + boff + n * 2048 + k * 1024); } while (0)
#define PG8_CAT(x0, x1) __builtin_shufflevector(__builtin_bit_cast(i32x4, x0), __builtin_bit_cast(i32x4, x1), 0, 1, 2, 3, 4, 5, 6, 7)
#define PG8_MMA(ai, bj, At, Bt) do { __builtin_amdgcn_s_setprio(1); if constexpr (FP8) { _Pragma("unroll") for (int m = 0; m < 4; ++m) _Pragma("unroll") for (int n = 0; n < 2; ++n) \
        { const i32x8 b8_ = PG8_CAT(Bt[n][0], Bt[n][1]), a8_ = PG8_CAT(At[m][0], At[m][1]); asm volatile("v_mfma_scale_f32_16x16x128_f8f6f4 %0, %1, %2, %0, %3, %4 op_sel_hi:[0,0,0]" : "+v"(acc[ai][bj][m][n]) : "v"(b8_), "v"(a8_), "v"(sclB), "v"(sclA)); } } else { \
        _Pragma("unroll") for (int m = 0; m < 4; ++m) _Pragma("unroll") for (int n = 0; n < 2; ++n) _Pragma("unroll") for (int k = 0; k < 2; ++k) \
        acc[ai][bj][m][n] = __builtin_amdgcn_mfma_f32_16x16x32_bf16(Bt[n][k], At[m][k], acc[ai][bj][m][n], 0, 0, 0); } __builtin_amdgcn_s_setprio(0); } while (0)
#define PG8_WAIT_V(n) asm volatile("s_waitcnt vmcnt(" #n ")" ::: "memory")
#define PG8_WAIT_L(n) asm volatile("s_waitcnt lgkmcnt(" #n ")" ::: "memory")
#define PG8_BAR __builtin_amdgcn_s_barrier()
#define PG8_SCHED __builtin_amdgcn_sched_barrier(0)
#define PG8_AOFF(dst, u) do { _Pragma("unroll") for (int _h = 0; _h < 2; ++_h) _Pragma("unroll") for (int _i = 0; _i < 2; ++_i) \
        dst[_h][_i] = ((unsigned)S.arow(u, _h * HALF + Rs[_i]) * (unsigned)K + (unsigned)Cs[_i]) * 2u; } while (0)
    Unit cur, nxt; int ui = 0;
    if (!S.next(0, cur)) return;
    const int sclA = SCALE_A, sclB = SCALE_B;
    f32x4 acc[2][2][4][2];
#pragma unroll
    for (int a = 0; a < 2; ++a)
#pragma unroll
        for (int b = 0; b < 2; ++b)
#pragma unroll
            for (int m = 0; m < 4; ++m)
#pragma unroll
                for (int n = 0; n < 2; ++n) acc[a][b][m][n] = (f32x4){0.f, 0.f, 0.f, 0.f};
    bf16x8 At[4][2], B0[2][2], B1[2][2];
    unsigned vA[2][2], nvA[2][2];
    PG8_AOFF(vA, cur);
    const char* const cA = (const char*)g.A; const char* cB = (const char*)g.Bt + (size_t)cur.pn * tstep;
    S.a_ready(cur);
    if constexpr (SP2) {
        PG8_STAGE(PG8_SB(0, 0), cB, voffB); PG8_STAGE(PG8_SB(0, 1), cB + hstep, voffB); PG8_STAGE(PG8_SA(0, 0), cA, vA[0]); PG8_STAGE(PG8_SA(0, 1), cA, vA[1]);
        if (wr == 1) PG8_BAR;
        PG8_WAIT_V(2); PG8_BAR;
        PG8_STAGE(PG8_SB(1, 0), cB + kstep, voffB); PG8_STAGE(PG8_SA(1, 0), cA + kstep, vA[0]); PG8_STAGE(PG8_SB(1, 1), cB + hstep + kstep, voffB);
        PG8_WAIT_V(6); PG8_BAR;
    } else {
        PG8_STAGE(PG8_SB(0, 0), cB, voffB); PG8_STAGE(PG8_SA(0, 0), cA, vA[0]); PG8_STAGE(PG8_SB(0, 1), cB + hstep, voffB); PG8_STAGE(PG8_SA(0, 1), cA, vA[1]);
        if (wr == 1) PG8_BAR;
        PG8_WAIT_V(4); PG8_BAR;
        PG8_STAGE(PG8_SB(1, 0), cB + kstep, voffB); PG8_STAGE(PG8_SA(1, 0), cA + kstep, vA[0]); PG8_STAGE(PG8_SB(1, 1), cB + hstep + kstep, voffB);
        PG8_WAIT_V(6); PG8_BAR;
    }
    for (;;) {
        const bool has_next = S.next(ui + 1, nxt);
        const char* nB = has_next ? (const char*)g.Bt + (size_t)nxt.pn * tstep : cB;
        if (has_next) { PG8_AOFF(nvA, nxt); } else {
#pragma unroll
            for (int h = 0; h < 2; ++h)
#pragma unroll
                for (int i = 0; i < 2; ++i) nvA[h][i] = vA[h][i]; }
        for (int t = 0; t < nt; t += 2) {
            const bool last = (t == nt - 2);
            const char* a1 = cA + (size_t)(t + 1) * kstep;
            const char* a2 = last ? cA : cA + (size_t)(t + 2) * kstep; const char* b2 = last ? nB : cB + (size_t)(t + 2) * kstep;
            const char* a3 = a2 + kstep; const char* b3 = b2 + kstep;
            unsigned w0[2], w1[2];
            w0[0] = last ? nvA[0][0] : vA[0][0]; w0[1] = last ? nvA[0][1] : vA[0][1]; w1[0] = last ? nvA[1][0] : vA[1][0]; w1[1] = last ? nvA[1][1] : vA[1][1];
            if (last && has_next) S.a_ready(nxt);
            if constexpr (Epi::MID_T >= 0) { if (t == Epi::MID_T) { PG8_SCHED; E.mid(acc, cur, wr, wc, fr, fq); PG8_SCHED; } }
            if constexpr (SP2) {
            PG8_LDB(B0, 0, 0); PG8_LDB(B1, 0, 1); PG8_SCHED; PG8_LDA(At, 0, 0); PG8_STAGE(PG8_SA(1, 1), a1, vA[1]);
            PG8_WAIT_V(8); PG8_WAIT_L(0); PG8_BAR; PG8_MMA(0, 0, At, B0); PG8_MMA(0, 1, At, B1); PG8_BAR; PG8_SCHED;
            PG8_LDA(At, 0, 1); PG8_STAGE(PG8_SB(0, 0), b2, voffB); PG8_STAGE(PG8_SB(0, 1), b2 + hstep, voffB); PG8_STAGE(PG8_SA(0, 0), a2, w0);
            PG8_WAIT_V(8); PG8_WAIT_L(0); PG8_BAR; if (!cur.half) { PG8_MMA(1, 0, At, B0); PG8_MMA(1, 1, At, B1); } PG8_BAR; PG8_SCHED;
            PG8_LDB(B0, 1, 0); PG8_LDB(B1, 1, 1); PG8_SCHED; PG8_LDA(At, 1, 0); PG8_STAGE(PG8_SA(0, 1), a2, w1);
            PG8_WAIT_V(8); PG8_WAIT_L(0); PG8_BAR; PG8_MMA(0, 0, At, B0); PG8_MMA(0, 1, At, B1); PG8_BAR; PG8_SCHED;
            PG8_LDA(At, 1, 1); PG8_STAGE(PG8_SB(1, 0), b3, voffB); PG8_STAGE(PG8_SB(1, 1), b3 + hstep, voffB); PG8_STAGE(PG8_SA(1, 0), a3, w0);
            PG8_WAIT_V(8); PG8_WAIT_L(0); PG8_BAR; if (!cur.half) { PG8_MMA(1, 0, At, B0); PG8_MMA(1, 1, At, B1); } PG8_BAR; PG8_SCHED;
            } else {
            PG8_LDB(B0, 0, 0); PG8_SCHED; PG8_LDA(At, 0, 0); PG8_STAGE(PG8_SA(1, 1), a1, vA[1]);
            PG8_WAIT_L(8); PG8_BAR; PG8_WAIT_L(0); PG8_MMA(0, 0, At, B0); PG8_BAR; PG8_SCHED;
            PG8_LDB(B1, 0, 1); PG8_STAGE(PG8_SB(0, 0), b2, voffB);
            PG8_BAR; PG8_WAIT_L(0); PG8_MMA(0, 1, At, B1); PG8_BAR;
            PG8_LDA(At, 0, 1); PG8_STAGE(PG8_SA(0, 0), a2, w0);
            PG8_BAR; PG8_WAIT_L(0); PG8_MMA(1, 0, At, B0); PG8_BAR; PG8_SCHED;
            PG8_STAGE(PG8_SB(0, 1), b2 + hstep, voffB);
            PG8_WAIT_V(6); PG8_BAR; PG8_MMA(1, 1, At, B1); PG8_BAR;
            PG8_LDB(B0, 1, 0); PG8_SCHED; PG8_LDA(At, 1, 0); PG8_STAGE(PG8_SA(0, 1), a2, w1);
            PG8_WAIT_L(8); PG8_BAR; PG8_WAIT_L(0); PG8_MMA(0, 0, At, B0); PG8_BAR; PG8_SCHED;
            PG8_LDB(B1, 1, 1); PG8_STAGE(PG8_SB(1, 0), b3, voffB);
            PG8_BAR; PG8_WAIT_L(0); PG8_MMA(0, 1, At, B1); PG8_BAR;
            PG8_LDA(At, 1, 1); PG8_STAGE(PG8_SA(1, 0), a3, w0);
            PG8_BAR; PG8_WAIT_L(0); PG8_MMA(1, 0, At, B0); PG8_BAR; PG8_SCHED;
            PG8_STAGE(PG8_SB(1, 1), b3 + hstep, voffB);
            PG8_WAIT_V(6); PG8_BAR; PG8_MMA(1, 1, At, B1); PG8_BAR;
            }
        }
        if constexpr (ALIGN_EPI) { if (wr == 0) PG8_BAR; }
        if constexpr (FP8) asm volatile("s_nop 15\n\ts_nop 15" ::: "memory");
        E(acc, cur, wr, wc, fr, fq); S.done(cur);
        if (!has_next) break;
#pragma unroll
        for (int a = 0; a < 2; ++a)
#pragma unroll
            for (int b = 0; b < 2; ++b)
#pragma unroll
                for (int m = 0; m < 4; ++m)
#pragma unroll
                    for (int n = 0; n < 2; ++n) acc[a][b][m][n] = (f32x4){0.f, 0.f, 0.f, 0.f};
        cur = nxt; cB = nB; ++ui;
#pragma unroll
        for (int h = 0; h < 2; ++h)
#pragma unroll
            for (int i = 0; i < 2; ++i) vA[h][i] = nvA[h][i];
        if constexpr (ALIGN_EPI) { if (wr == 1) PG8_BAR; }
    }
    PG8_WAIT_V(0);
    if constexpr (!ALIGN_EPI) { if (wr == 0) PG8_BAR; }
    PG8_BAR;
#undef PG8_SA
#undef PG8_SB
#undef PG8_STAGE
#undef PG8_LDA
#undef PG8_LDB
#undef PG8_MMA
#undef PG8_CAT
#undef PG8_WAIT_V
#undef PG8_WAIT_L
#undef PG8_BAR
#undef PG8_SCHED
#undef PG8_AOFF
}
}
#define GAS __attribute__((address_space(1)))
#define LAS __attribute__((address_space(3)))
typedef unsigned short bf16;
typedef unsigned v4u __attribute__((ext_vector_type(4)));
typedef float f32x4 __attribute__((ext_vector_type(4)));
typedef short bf16x8 __attribute__((ext_vector_type(8)));
typedef GAS unsigned gu32;
typedef GAS unsigned long long gu64;
#define RLX_AGENT __ATOMIC_RELAXED, __HIP_MEMORY_SCOPE_AGENT
#define LDS_WAIT() asm volatile("s_waitcnt lgkmcnt(0)" ::: "memory")
#define VM_WAIT() asm volatile("s_waitcnt vmcnt(0)" ::: "memory")
__device__ __forceinline__ unsigned long long rt() { return __builtin_amdgcn_s_memrealtime(); }
__device__ __forceinline__ unsigned f2bf(float f) { unsigned u = __builtin_bit_cast(unsigned, f); return (u + 0x7fffu + ((u >> 16) & 1u)) >> 16; }
__device__ __forceinline__ unsigned pk2(float lo, float hi) { return f2bf(lo) | (f2bf(hi) << 16); }

#define XB_TMO      128
#define XB_XCNT(j)  (256  + 64 * (j))
#define XB_XSUB(j)  (1280 + 64 * (j))
#define XB_XGEN(j)  (2304 + 64 * (j))
#define XB_TOP      3328
#define XB_TOPGEN   3392
#define XCD_BAR_WORDS 3456
#define XB_SPIN_CAP (1u << 22)

__device__ __forceinline__ unsigned xb_ld(unsigned* p)              { return __hip_atomic_load(p, __ATOMIC_RELAXED, __HIP_MEMORY_SCOPE_AGENT); }
__device__ __forceinline__ unsigned xb_add(unsigned* p, unsigned v) { return __hip_atomic_fetch_add(p, v, __ATOMIC_RELAXED, __HIP_MEMORY_SCOPE_AGENT); }
__device__ __forceinline__ unsigned xb_xcc_id() { return (unsigned)__builtin_amdgcn_s_getreg((3 << 11) | 20) & 0xFu; }
#define XB_SPIN(cond, bar) do { unsigned _sp = 0; while (cond) { __builtin_amdgcn_s_sleep(1); \
    if ((++_sp & 255u) == 0u) { if (xb_ld(&(bar)[XB_TMO])) break; if (_sp > XB_SPIN_CAP) { atomicAdd(&(bar)[XB_TMO], 1u); break; } } } } while (0)

struct XcdBarrier {
    unsigned* bar; unsigned x;
    volatile LAS unsigned* st;
};

__device__ __forceinline__ XcdBarrier xcd_barrier_post(unsigned* bar, volatile LAS unsigned* st) {
    XcdBarrier b; b.bar = bar; b.x = xb_xcc_id(); b.st = st;
    if (threadIdx.x == 0) (void)xb_add(&bar[XB_XCNT(b.x)], 1u);
    return b;
}
__device__ __forceinline__ void xcd_barrier_complete(unsigned* bar, unsigned x, unsigned& nloc, unsigned& nx) {
    const unsigned G = gridDim.x * gridDim.y * gridDim.z;
    unsigned sum, cnt, mine, sp = 0u;
    for (;;) {
        sum = 0u; cnt = 0u; mine = 0u;
#pragma unroll
        for (unsigned j = 0; j < 16; ++j) { const unsigned c = xb_ld(&bar[XB_XCNT(j)]); sum += c; cnt += (c > 0u) ? 1u : 0u; mine = (j == x) ? c : mine; }
        if (sum == G) break;
        __builtin_amdgcn_s_sleep(1);
        if ((++sp & 255u) == 0u) { if (xb_ld(&bar[XB_TMO])) break; if (sp > XB_SPIN_CAP) { atomicAdd(&bar[XB_TMO], 1u); break; } }
    }
    nloc = mine > 0u ? mine : 1u; nx = cnt > 0u ? cnt : 1u;
}

__device__ __forceinline__ void xcd_barrier(const XcdBarrier& b) {
    asm volatile("s_waitcnt vmcnt(0)" ::: "memory");
    __syncthreads();
    if (threadIdx.x == 0) {
        unsigned* bar = b.bar;
        __builtin_amdgcn_s_waitcnt(0);
        unsigned nloc = b.st[0], nx = b.st[1];
        if (nloc == 0u) { xcd_barrier_complete(bar, b.x, nloc, nx); b.st[0] = nloc; b.st[1] = nx; }
        const unsigned old = xb_add(&bar[XB_XSUB(b.x)], 1u);
        const unsigned gen = old / nloc;
        if (old + 1u == (gen + 1u) * nloc) {
            __builtin_amdgcn_fence(__ATOMIC_RELEASE, "agent");
            asm volatile("s_waitcnt vmcnt(0)" ::: "memory");
            const unsigned og = xb_add(&bar[XB_TOP], 1u);
            const unsigned tg = og / nx;
            if (og + 1u == (tg + 1u) * nx) xb_add(&bar[XB_TOPGEN], 1u);
            else XB_SPIN(xb_ld(&bar[XB_TOPGEN]) == tg, bar);
            __builtin_amdgcn_fence(__ATOMIC_ACQUIRE, "agent");
            xb_add(&bar[XB_XGEN(b.x)], 1u);
            asm volatile("s_waitcnt vmcnt(0)" ::: "memory");
        } else {
            XB_SPIN(xb_ld(&bar[XB_XGEN(b.x)]) == gen, bar);
            __builtin_amdgcn_fence(__ATOMIC_ACQUIRE, "agent");
            asm volatile("s_waitcnt vmcnt(0)" ::: "memory");
        }
    }
    __syncthreads();
}

constexpr int NWAVES = 8;
constexpr int BATCH = 2, SEQ = 4096, M = BATCH * SEQ, D = 2048;
constexpr int NPW = 11784;
constexpr int NP = 11776;
constexpr int C_AQ = 0, C_AK = 1536, C_AV = 3072, C_MQK = 4608, C_MV = 5632, C_MO = 6656, C_GATE = 7680;
constexpr int NE = 32, DFF = 1408, ECAP = 8192, MAXT = 96, NT1 = DFF / 128  , NT2 = D / 256  ;
constexpr float LN_EPS = 1e-5f, ALPHA = 1.189207115002721f, QSCALE = 0.08838834764831845f;
constexpr size_t MiB = 1u << 20;
constexpr size_t WS_CTL = 0, CTL_ZERO_BYTES = 1 * MiB;
constexpr size_t WS_WIN = 2 * MiB, WS_WPA = 48 * MiB, WS_WPM = 50 * MiB, WS_WOUT = 54 * MiB, WS_WGU = 62 * MiB, WS_WD = 414 * MiB;
constexpr size_t WS_HB = 590 * MiB, WS_STATS = 622 * MiB, WS_MIF = 622 * MiB + 512 * 1024, WS_PROJ = 623 * MiB;
constexpr size_t WS_ATTO = 807 * MiB, WS_LSE = 831 * MiB, WS_ATT = 832 * MiB, WS_QKC = 840 * MiB, WS_NUM = 856 * MiB, WS_DEN = 888 * MiB, WS_MT = 888 * MiB + 512 * 1024;
constexpr size_t WS_HM = 889 * MiB, WS_TMP = 905 * MiB, WS_MERGED = 969 * MiB, WS_H1 = 1001 * MiB, WS_H1B = 1065 * MiB, WS_TOKLIST = 1097 * MiB, WS_TOKINFO = 1098 * MiB;
constexpr size_t WS_ACT = WS_PROJ, WS_YS = 689 * MiB;
constexpr size_t WS_KVT = 1099 * MiB, WS_CPREV = 1163 * MiB, WS_MSC = 1195 * MiB;
constexpr size_t WS_WRT = 1196 * MiB;
constexpr size_t WS_AH = 1200 * MiB;
constexpr size_t WS_END = 1224 * MiB;
static_assert(WS_WIN + (size_t)NP * D * 2 <= WS_WPA && WS_WGU + (size_t)NE * 2 * DFF * D * 2 <= WS_WD && WS_WD + (size_t)NE * D * DFF * 2 <= WS_HB, "weights map");
static_assert(WS_PROJ + (size_t)M * NP * 2 <= WS_ATTO && WS_ACT + (size_t)MAXT * 256 * DFF * 2 <= WS_YS && WS_YS + (size_t)MAXT * 256 * D * 2 <= WS_ATTO, "activation map");
constexpr int CW_TMO = 0, CW_CODE = 1, CW_BAR = 4096, CW_CNT = 65536, CW_Q = 66560;
constexpr int RING_OFF = 0, RING_BYTES = 131072, LDSCTL_OFF = RING_BYTES, MISC_OFF = LDSCTL_OFF + 320, TS_OFF = LDSCTL_OFF + 512, CNT_OFF = LDSCTL_OFF + 768, GATE_OFF = LDSCTL_OFF + 1024, QSLOT_OFF = LDSCTL_OFF + 1536;
constexpr int LDS_BYTES = 147456;

struct Frame { LAS unsigned char* lds; gu32* ctl; int tid, lane, wave, vcu, G; unsigned char* ws; };

__device__ __forceinline__ float wave_sum(float v) {
#pragma unroll
    for (int o = 1; o < 64; o <<= 1) v += __shfl_xor(v, o);
    return v;
}
__device__ __forceinline__ float wave_max(float v) {
#pragma unroll
    for (int o = 1; o < 64; o <<= 1) v = fmaxf(v, __shfl_xor(v, o));
    return v;
}
__device__ __forceinline__ float bflo(unsigned w) { return __uint_as_float(w << 16); }
__device__ __forceinline__ float bfhi(unsigned w) { return __uint_as_float(w & 0xffff0000u); }
__device__ __forceinline__ float sigm(float x) { return 1.0f / (1.0f + __expf(-x)); }

typedef short s16x4 __attribute__((ext_vector_type(4)));
__device__ __forceinline__ bf16x8 frag_tr(const LAS unsigned char* img, int pitch, int k0, int n0, int lane) {
    const int i = lane & 15, g = lane >> 4;
    const LAS unsigned char* p = img + (k0 + 8 * g + (i >> 2)) * pitch + (n0 + 4 * (i & 3)) * 2;
    const s16x4 a = __builtin_amdgcn_ds_read_tr16_b64_v4i16((LAS s16x4*)p), b = __builtin_amdgcn_ds_read_tr16_b64_v4i16((LAS s16x4*)(p + 4 * pitch));
    return (bf16x8){a[0], a[1], a[2], a[3], b[0], b[1], b[2], b[3]};
}
constexpr int TR_PITCH = 144;
__device__ __forceinline__ void tr_item(const float* W, int ldw, int k0, int c0, bf16* WT, size_t drow0, int Kd, LAS unsigned char* scr, int lane, int dk = 0) {
    const int kr = lane >> 4, nc = (lane & 15) * 4;
    f32x4 v[16];
#pragma unroll
    for (int j = 0; j < 16; ++j) v[j] = *(const f32x4*)(W + (size_t)(k0 + 4 * j + kr) * ldw + c0 + nc);
#pragma unroll
    for (int j = 0; j < 16; ++j) *(LAS unsigned long long*)(scr + (4 * j + kr) * TR_PITCH + nc * 2) = (unsigned long long)pk2(v[j][0], v[j][1]) | ((unsigned long long)pk2(v[j][2], v[j][3]) << 32);
    LDS_WAIT(); asm volatile("" ::: "memory");
    const int i = lane & 15, g = lane >> 4;
#pragma unroll
    for (int kk = 0; kk < 2; ++kk)
#pragma unroll
        for (int nn = 0; nn < 4; ++nn) { const bf16x8 f = frag_tr(scr, TR_PITCH, 32 * kk, 16 * nn, lane);
            *(bf16x8*)(WT + (drow0 + 16 * nn + i) * Kd + dk + k0 + 32 * kk + 8 * g) = f; }
    LDS_WAIT(); asm volatile("" ::: "memory");
}
constexpr int I_WINA = 32 * 120, I_WINB = 32 * 64, I_WPA = 8 * 32, I_WPM = 16 * 32, I_WOUT = 32 * 32, I_EXP = NE * 32 * 22, I_DN = NE * 22 * 32;
constexpr int I_EARLY = I_WINA + I_WINB + I_WPA + I_WPM + I_WOUT, I_MOE = 2 * I_EXP + I_DN;

__device__ __forceinline__ void p0_prologue(Frame& F, const float* x, const float* lng, const float* lnb, const float* w_in, const float* if_bias, const float* wpa, const float* wpm, const float* wout,
                                            const float* wrg, const float* wre) {
    unsigned char* ws = F.ws;
    LAS unsigned char* scr = F.lds + RING_OFF + F.wave * 16384;
    const int gw = F.vcu * NWAVES + F.wave, NGW = F.G * NWAVES;
    for (int it0 = gw; it0 < I_EARLY; it0 += NGW) {
        int it = it0;
        if (it < I_WINA) { const int kb = it / 120, nb = it % 120; tr_item(w_in, NPW, 64 * kb, 64 * nb, (bf16*)(ws + WS_WIN), (size_t)64 * nb, D, scr, F.lane); continue; } it -= I_WINA;
        if (it < I_WINB) { const int kb = it / 64, nb = it % 64; tr_item(w_in, NPW, 64 * kb, 7688 + 64 * nb, (bf16*)(ws + WS_WIN), (size_t)7680 + 64 * nb, D, scr, F.lane); continue; } it -= I_WINB;
        if (it < I_WPA) { const int kb = it / 32, nb = it % 32; tr_item(wpa, D, 64 * kb, 64 * nb, (bf16*)(ws + WS_WPA), (size_t)64 * nb, 1536, scr, F.lane, 0); continue; } it -= I_WPA;
        if (it < I_WPM) { const int kb = it / 32, nb = it % 32; tr_item(wpm, D, 64 * kb, 64 * nb, (bf16*)(ws + WS_WPA), (size_t)64 * nb, 1536, scr, F.lane, 512); continue; } it -= I_WPM;
        { const int kb = it / 32, nb = it % 32; tr_item(wout, D, 64 * kb, 64 * nb, (bf16*)(ws + WS_WOUT), (size_t)64 * nb, D, scr, F.lane); }
    }
    {
        bf16* WRH = (bf16*)(ws + WS_WRT); bf16* WRL = WRH + 48 * D; const int gt = F.vcu * (NWAVES * 64) + F.tid, NT = F.G * NWAVES * 64;
        for (int idx = gt; idx < 48 * D; idx += NT) { const int e = idx / D, k = idx % D; const float w = e < 32 ? wre[(size_t)k * 32 + e] : (e < 36 ? wrg[(size_t)k * 4 + (e - 32)] : 0.f);
            const unsigned hi = f2bf(w); WRH[idx] = (bf16)hi; WRL[idx] = (bf16)f2bf(w - __uint_as_float(hi << 16)); } }
    __syncthreads();
    LAS float* wif = (LAS float*)(F.lds + RING_OFF);
    for (int k = F.tid; k < D; k += NWAVES * 64) { const f32x4 a = *(const f32x4*)(w_in + (size_t)k * NPW + 7680), b = *(const f32x4*)(w_in + (size_t)k * NPW + 7684);
        *(LAS f32x4*)(wif + k * 8) = a; *(LAS f32x4*)(wif + k * 8 + 4) = b; }
    __syncthreads();
    bf16* HB = (bf16*)(ws + WS_HB); float* STATS = (float*)(ws + WS_STATS); float* MIF = (float*)(ws + WS_MIF);
    for (int m = gw; m < M; m += NGW) {
        const f32x4* xr = (const f32x4*)(x + (size_t)m * D) + F.lane;
        f32x4 v[8]; float s = 0.f;
#pragma unroll
        for (int j = 0; j < 8; ++j) { v[j] = xr[64 * j]; s += (v[j][0] + v[j][1]) + (v[j][2] + v[j][3]); }
        const float mean = wave_sum(s) * (1.f / D); float s2 = 0.f;
#pragma unroll
        for (int j = 0; j < 8; ++j) { const f32x4 d = v[j] - mean; s2 += (d[0] * d[0] + d[1] * d[1]) + (d[2] * d[2] + d[3] * d[3]); }
        const float rstd = rsqrtf(wave_sum(s2) * (1.f / D) + LN_EPS);
        float a[8];
#pragma unroll
        for (int i = 0; i < 8; ++i) a[i] = 0.f;
        unsigned long long* o8 = (unsigned long long*)(HB + (size_t)m * D) + F.lane;
#pragma unroll
        for (int j = 0; j < 8; ++j) { const int k0 = 4 * F.lane + 256 * j; const f32x4 g4 = *(const f32x4*)(lng + k0), b4 = *(const f32x4*)(lnb + k0);
            const f32x4 hv = (v[j] - mean) * rstd * g4 + b4;
            o8[64 * j] = (unsigned long long)pk2(hv[0], hv[1]) | ((unsigned long long)pk2(hv[2], hv[3]) << 32);
#pragma unroll
            for (int c = 0; c < 4; ++c) { const f32x4 w0 = *(const LAS f32x4*)(wif + (k0 + c) * 8), w1 = *(const LAS f32x4*)(wif + (k0 + c) * 8 + 4);
                a[0] += hv[c] * w0[0]; a[1] += hv[c] * w0[1]; a[2] += hv[c] * w0[2]; a[3] += hv[c] * w0[3]; a[4] += hv[c] * w1[0]; a[5] += hv[c] * w1[1]; a[6] += hv[c] * w1[2]; a[7] += hv[c] * w1[3]; }
            asm volatile("" ::: "memory"); }
#pragma unroll
        for (int i = 0; i < 8; ++i) a[i] = wave_sum(a[i]);
        if (F.lane == 0) { STATS[2 * m] = mean; STATS[2 * m + 1] = rstd;
#pragma unroll
            for (int i = 0; i < 8; ++i) MIF[(size_t)m * 8 + i] = a[i] + if_bias[i]; }
    }
}


constexpr int WD8_PITCH = 1536, WSCALE_E8M0 = 127 - 8; constexpr float WSCALE = 256.f;
struct TrItem { const float* src; unsigned char* dst; int ldw, Kd, ztail; };
__device__ __forceinline__ TrItem moe_item(int it, unsigned char* ws, const float* wgate, const float* wup, const float* wdown) {
    TrItem t; t.ztail = 0;
    if (it < 2 * I_EXP) { const int up = it >= I_EXP ? 1 : 0; if (up) it -= I_EXP; const int e = it / 704, r = it % 704, kb = r / 22, nb = r % 22, j0 = 64 * nb;
        t.src = (up ? wup : wgate) + (size_t)e * D * DFF + (size_t)(64 * kb) * DFF + j0; t.ldw = DFF; t.Kd = D;
        t.dst = (ws + WS_WGU) + ((size_t)e * 2816 + (size_t)(j0 / 128) * 256 + (j0 % 128) + 128 * up) * D + 64 * kb; }
    else { it -= 2 * I_EXP; const int e = it / 704, r = it % 704, kb = r / 32, nb = r % 32;
        t.src = wdown + (size_t)e * DFF * D + (size_t)(64 * kb) * D + 64 * nb; t.ldw = D; t.Kd = WD8_PITCH; t.ztail = (kb == 21);
        t.dst = (ws + WS_WD) + ((size_t)e * D + 64 * nb) * WD8_PITCH + 64 * kb; }
    return t;
}
__device__ __forceinline__ void tr_load(f32x4 (&v)[16], const TrItem& t, int lane) {
    const int kr = lane >> 4, nc = (lane & 15) * 4;
#pragma unroll
    for (int j = 0; j < 16; ++j) v[j] = __builtin_nontemporal_load((const f32x4*)(t.src + (size_t)(4 * j + kr) * t.ldw + nc));
}
__device__ __forceinline__ void tr_store(const f32x4 (&v)[16], const TrItem& t, LAS unsigned char* scr, int lane) {
    const int kr = lane >> 4, nc = (lane & 15) * 4;
#pragma unroll
    for (int j = 0; j < 16; ++j) *(LAS unsigned long long*)(scr + (4 * j + kr) * TR_PITCH + nc * 2) = (unsigned long long)pk2(v[j][0] * WSCALE, v[j][1] * WSCALE) | ((unsigned long long)pk2(v[j][2] * WSCALE, v[j][3] * WSCALE) << 32);
    LDS_WAIT(); asm volatile("" ::: "memory");
    const int i = lane & 15, g = lane >> 4;
#pragma unroll
    for (int nn = 0; nn < 4; ++nn) { const LAS unsigned char* p = scr + (16 * g + (i >> 2)) * TR_PITCH + (16 * nn + 4 * (i & 3)) * 2; v4u o;
#pragma unroll
        for (int q = 0; q < 4; ++q) { union { s16x4 v; unsigned u[2]; } f; f.v = __builtin_amdgcn_ds_read_tr16_b64_v4i16((LAS s16x4*)(p + 4 * q * TR_PITCH));
            int w = 0; w = __builtin_amdgcn_cvt_pk_fp8_f32(bflo(f.u[0]), bfhi(f.u[0]), w, false); w = __builtin_amdgcn_cvt_pk_fp8_f32(bflo(f.u[1]), bfhi(f.u[1]), w, true);
            o[q] = (unsigned)w; }
        __builtin_nontemporal_store(o, (v4u*)(t.dst + (size_t)(16 * nn + i) * t.Kd + 16 * g)); }
    if (t.ztail) {
        const v4u z = (v4u){0u, 0u, 0u, 0u};
#pragma unroll
        for (int q = 0; q < 8; ++q) *(v4u*)(t.dst + (size_t)lane * t.Kd + 64 + 16 * q) = z; }
    LDS_WAIT(); asm volatile("" ::: "memory");
}
__device__ __forceinline__ void moe_convert(Frame& F, int conv, int nconv, const float* wgate, const float* wup, const float* wdown) {
    unsigned char* ws = F.ws;
    LAS unsigned char* scr = F.lds + RING_OFF + F.wave * 16384;
    const int step = nconv * NWAVES; int it = conv * NWAVES + F.wave;
    if (it >= I_MOE) return;
    f32x4 va[16], vb[16];
    TrItem ta = moe_item(it, ws, wgate, wup, wdown), tb = ta;
    tr_load(va, ta, F.lane);
    for (;;) {
        const bool hb = (it + step) < I_MOE;
        if (hb) { tb = moe_item(it + step, ws, wgate, wup, wdown); tr_load(vb, tb, F.lane); }
        tr_store(va, ta, scr, F.lane);
        if (!hb) break;
        const bool ha = (it + 2 * step) < I_MOE;
        if (ha) { ta = moe_item(it + 2 * step, ws, wgate, wup, wdown); tr_load(va, ta, F.lane); }
        tr_store(vb, tb, scr, F.lane);
        if (!ha) break;
        it += 2 * step;
    }
}
struct QueueOrder {
    int nM, nN, nwg, x; gu32* qctr; volatile LAS int* slot;
    __device__ __forceinline__ void init(int M_, int N_, int bx, gu32* q, volatile LAS int* s) { nM = M_ / 256; nN = N_ / 256; nwg = nM * nN; x = bx & 7; qctr = q; slot = s; }
    __device__ __forceinline__ bool next(int i, pg8::Unit& u) const {
        if (threadIdx.x < 64) { int off = 0; if (threadIdx.x == 0) off = (int)__hip_atomic_fetch_add(qctr + 64 * x, 1u, RLX_AGENT);
            off = __builtin_amdgcn_readfirstlane(off); if (threadIdx.x == 0) slot[i & 1] = off; asm volatile("s_waitcnt lgkmcnt(0)" ::: "memory"); }
        asm volatile("" ::: "memory"); __builtin_amdgcn_s_barrier(); asm volatile("" ::: "memory");
        const int off = slot[i & 1], q = nwg / 8;
        if (off >= q) return false;
        const int wgid = x * q + off, nig = pg8::WGM * nN, gid = wgid / nig, fm = gid * pg8::WGM, gsz = (nM - fm) < pg8::WGM ? (nM - fm) : pg8::WGM;
        u.pm = fm + ((wgid % nig) % gsz); u.pn = (wgid % nig) / gsz; u.e = 0; u.r0 = 0; u.half = 0; return true;
    }
    __device__ __forceinline__ int arow(const pg8::Unit& u, int r) const { return u.pm * 256 + r; }
    __device__ __forceinline__ void a_ready(const pg8::Unit&) const {}
    __device__ __forceinline__ void done(const pg8::Unit&) const {}
};
__device__ __forceinline__ float alibi_slope(int h) {
    switch (h) { case 0: return 0.70710678118654752f; case 1: return 0.5f; case 2: return 0.35355339059327379f; case 3: return 0.25f; case 4: return 0.17677669529663689f; case 5: return 0.125f;
        case 6: return 0.088388347648318447f; case 7: return 0.0625f; case 8: return 0.03125f; case 9: return 0.015625f; case 10: return 0.0078125f; default: return 0.00390625f; }
}
__device__ __forceinline__ void attn_naive(Frame& F) {
    const bf16* PROJ = (const bf16*)(F.ws + WS_PROJ); bf16* ATTO = (bf16*)(F.ws + WS_ATTO); float* LSE = (float*)(F.ws + WS_LSE);
    LAS float* pbuf = (LAS float*)(F.lds + RING_OFF) + F.wave * 256;
    const int gw = F.vcu * NWAVES + F.wave, NGW = F.G * NWAVES;
    for (int it = gw; it < M * 12; it += NGW) {
        const int h = it / M, m = it % M, t = m % SEQ, g = h >> 2, r = (g == 0) ? 1 : (g == 1 ? 4 : 16);
        const float slope = alibi_slope(h);
        const bf16* qp = PROJ + (size_t)m * NP + C_AQ + h * 128;
        float sc[3];
#pragma unroll
        for (int jj = 0; jj < 3; ++jj) {
            const int j = F.lane + 64 * jj; const bool valid = (j <= 128) && (t - j * r >= 0);
            float dot = 0.f;
            if (valid) { const bf16* kp = PROJ + (size_t)(m - j * r) * NP + C_AK + h * 128;
#pragma unroll 4
                for (int c = 0; c < 16; ++c) { const v4u qv = *(const v4u*)(qp + 8 * c), kv = *(const v4u*)(kp + 8 * c);
                    dot += bflo(qv.x) * bflo(kv.x) + bfhi(qv.x) * bfhi(kv.x) + bflo(qv.y) * bflo(kv.y) + bfhi(qv.y) * bfhi(kv.y) + bflo(qv.z) * bflo(kv.z) + bfhi(qv.z) * bfhi(kv.z) + bflo(qv.w) * bflo(kv.w) + bfhi(qv.w) * bfhi(kv.w); } }
            sc[jj] = valid ? dot * QSCALE - slope * (float)(j * r) : -INFINITY;
        }
        const float mx = wave_max(fmaxf(fmaxf(sc[0], sc[1]), sc[2]));
        float ps = 0.f;
#pragma unroll
        for (int jj = 0; jj < 3; ++jj) { const float p = (sc[jj] == -INFINITY) ? 0.f : __expf(sc[jj] - mx); ps += p; pbuf[F.lane + 64 * jj] = p; }
        const float l = wave_sum(ps);
        LDS_WAIT(); asm volatile("" ::: "memory");
        const int nk = ((t / r) < 128 ? (t / r) : 128) + 1;
        float o0 = 0.f, o1 = 0.f;
        const bf16* vp = PROJ + (size_t)m * NP + C_AV + h * 128 + 2 * F.lane;
        for (int j = 0; j < nk; ++j) { const float p = pbuf[j]; const unsigned w = *(const unsigned*)(vp - (size_t)j * r * NP); o0 += p * bflo(w); o1 += p * bfhi(w); }
        const float il = 1.f / l;
        *(unsigned*)(ATTO + (size_t)m * 1536 + h * 128 + 2 * F.lane) = pk2(o0 * il, o1 * il);
        if (F.lane == 0) LSE[(size_t)m * 12 + h] = mx + __logf(l);
        LDS_WAIT(); asm volatile("" ::: "memory");
    }
}
__device__ __forceinline__ void conv_qk(Frame& F, const float* conv_w, const float* conv_b) {
    const bf16* PROJ = (const bf16*)(F.ws + WS_PROJ); bf16* QKC = (bf16*)(F.ws + WS_QKC);
    const int gt = F.vcu * (NWAVES * 64) + F.tid, NT = F.G * NWAVES * 64;
    for (int idx = gt; idx < M * 128; idx += NT) {
        const int m = idx >> 7, c8 = (idx & 127) * 8, t = m % SEQ;
        float acc[8];
#pragma unroll
        for (int i = 0; i < 8; ++i) acc[i] = conv_b[c8 + i];
#pragma unroll
        for (int j = 0; j < 4; ++j) { const int tt = t - 3 + j; if (tt < 0) continue;
            const v4u w = *(const v4u*)(PROJ + (size_t)(m - 3 + j) * NP + C_MQK + c8);
            const f32x4 c0 = *(const f32x4*)(conv_w + j * 1024 + c8), c1 = *(const f32x4*)(conv_w + j * 1024 + c8 + 4);
            acc[0] += c0[0] * bflo(w.x); acc[1] += c0[1] * bfhi(w.x); acc[2] += c0[2] * bflo(w.y); acc[3] += c0[3] * bfhi(w.y);
            acc[4] += c1[0] * bflo(w.z); acc[5] += c1[1] * bfhi(w.z); acc[6] += c1[2] * bflo(w.w); acc[7] += c1[3] * bfhi(w.w); }
#pragma unroll
        for (int i = 0; i < 8; ++i) acc[i] = acc[i] * sigm(acc[i]);
        v4u o; o.x = pk2(acc[0], acc[1]); o.y = pk2(acc[2], acc[3]); o.z = pk2(acc[4], acc[5]); o.w = pk2(acc[6], acc[7]);
        *(v4u*)(QKC + (size_t)m * 1024 + c8) = o;
    }
}

__device__ __forceinline__ float log_sigmoid(float x) { return fminf(x, 0.f) - log1pf(__expf(-fabsf(x))); }
__device__ __forceinline__ void mlstm_naive(Frame& F, int bh) {
    const int b = bh >> 2, h = bh & 3;
    const bf16* PROJ = (const bf16*)(F.ws + WS_PROJ); const bf16* QKC = (const bf16*)(F.ws + WS_QKC); const float* MIF = (const float*)(F.ws + WS_MIF);
    float* NUM = (float*)(F.ws + WS_NUM); float* DEN = (float*)(F.ws + WS_DEN); float* MT = (float*)(F.ws + WS_MT);
    LAS float* qs = (LAS float*)(F.lds + RING_OFF); LAS float* ks = qs + 64 * 128; LAS bf16* vs = (LAS bf16*)(ks + 64 * 128);
    LAS float* gi = (LAS float*)(F.lds + GATE_OFF); LAS float* gf = gi + 64;
    float C[128];
#pragma unroll
    for (int d = 0; d < 128; ++d) C[d] = 0.f;
    float mst = 0.f;
    for (int c = 0; c < SEQ / 64; ++c) {
        __syncthreads();
        const size_t row0 = (size_t)b * SEQ + (size_t)c * 64;
        for (int idx = F.tid; idx < 64 * 32; idx += NWAVES * 64) { const int s = idx >> 5, c8 = idx & 31;
            const bf16* src = QKC + (row0 + s) * 1024 + (c8 < 16 ? h * 128 + c8 * 8 : 512 + h * 128 + (c8 - 16) * 8);
            const v4u w = *(const v4u*)src; const float sc = c8 < 16 ? QSCALE : 1.f;
            LAS float* dst = (c8 < 16 ? qs + s * 128 + c8 * 8 : ks + s * 128 + (c8 - 16) * 8);
            *(LAS f32x4*)dst = (f32x4){bflo(w.x) * sc, bfhi(w.x) * sc, bflo(w.y) * sc, bfhi(w.y) * sc}; *(LAS f32x4*)(dst + 4) = (f32x4){bflo(w.z) * sc, bfhi(w.z) * sc, bflo(w.w) * sc, bfhi(w.w) * sc};
            *(LAS v4u*)(vs + s * 256 + c8 * 8) = *(const v4u*)(PROJ + (row0 + s) * NP + C_MV + h * 256 + c8 * 8); }
        if (F.tid < 64) { gi[F.tid] = MIF[(row0 + F.tid) * 8 + h]; gf[F.tid] = log_sigmoid(MIF[(row0 + F.tid) * 8 + 4 + h]); }
        __syncthreads();
        if (F.tid <= 256) {
            for (int s = 0; s < 64; ++s) {
                const float lf = gf[s], ip = gi[s];
                const float mn = fmaxf(lf + mst, ip), fg = __expf(lf + mst - mn), ig = __expf(ip - mn); mst = mn;
                const float vv = (F.tid < 256) ? __uint_as_float((unsigned)vs[s * 256 + (F.tid & 255)] << 16) : 1.f;
                const float a = ig * vv; float num = 0.f;
#pragma unroll
                for (int d4 = 0; d4 < 32; ++d4) { const f32x4 kk = *(const LAS f32x4*)(ks + s * 128 + 4 * d4), qq = *(const LAS f32x4*)(qs + s * 128 + 4 * d4);
#pragma unroll
                    for (int e = 0; e < 4; ++e) { C[4 * d4 + e] = fg * C[4 * d4 + e] + a * kk[e]; num += C[4 * d4 + e] * qq[e]; } }
                if (F.tid < 256) NUM[(row0 + s) * 1024 + h * 256 + F.tid] = num; else { DEN[(row0 + s) * 4 + h] = num; MT[(row0 + s) * 4 + h] = mn; }
            }
        }
    }
}
__device__ __forceinline__ void attn_merge(Frame& F, int first_wg) {
    const bf16* ATTO = (const bf16*)(F.ws + WS_ATTO); const float* LSE = (const float*)(F.ws + WS_LSE); bf16* ATT = (bf16*)(F.ws + WS_AH);
    const int gt = (F.vcu - first_wg) * (NWAVES * 64) + F.tid, NT = (F.G - first_wg) * NWAVES * 64;
    for (int idx = gt; idx < M * 64; idx += NT) {
        const int m = idx >> 6, r = idx & 63, j = r >> 4, d8 = (r & 15) * 8;
        const float l0 = LSE[(size_t)m * 12 + j], l1 = LSE[(size_t)m * 12 + 4 + j], l2 = LSE[(size_t)m * 12 + 8 + j], mx = fmaxf(fmaxf(l0, l1), l2);
        float e0 = __expf(l0 - mx), e1 = __expf(l1 - mx), e2 = __expf(l2 - mx); const float inv = 1.f / (e0 + e1 + e2); e0 *= inv; e1 *= inv; e2 *= inv;
        const v4u a = *(const v4u*)(ATTO + (size_t)m * 1536 + j * 128 + d8), b = *(const v4u*)(ATTO + (size_t)m * 1536 + 512 + j * 128 + d8), c = *(const v4u*)(ATTO + (size_t)m * 1536 + 1024 + j * 128 + d8);
        v4u o;
        o.x = pk2(e0 * bflo(a.x) + e1 * bflo(b.x) + e2 * bflo(c.x), e0 * bfhi(a.x) + e1 * bfhi(b.x) + e2 * bfhi(c.x));
        o.y = pk2(e0 * bflo(a.y) + e1 * bflo(b.y) + e2 * bflo(c.y), e0 * bfhi(a.y) + e1 * bfhi(b.y) + e2 * bfhi(c.y));
        o.z = pk2(e0 * bflo(a.z) + e1 * bflo(b.z) + e2 * bflo(c.z), e0 * bfhi(a.z) + e1 * bfhi(b.z) + e2 * bfhi(c.z));
        o.w = pk2(e0 * bflo(a.w) + e1 * bflo(b.w) + e2 * bflo(c.w), e0 * bfhi(a.w) + e1 * bfhi(b.w) + e2 * bfhi(c.w));
        *(v4u*)(ATT + (size_t)m * 1536 + j * 128 + d8) = o;
    }
}
__device__ __forceinline__ void mlstm_post(Frame& F, const float* norm_w) {
    const bf16* PROJ = (const bf16*)(F.ws + WS_PROJ); const float* NUM = (const float*)(F.ws + WS_NUM); const float* DEN = (const float*)(F.ws + WS_DEN); const float* MT = (const float*)(F.ws + WS_MT);
    bf16* HM = (bf16*)(F.ws + WS_AH);
    const int gw = F.vcu * NWAVES + F.wave, NGW = F.G * NWAVES;
    for (int it = gw; it < M * 4; it += NGW) {
        const int m = it >> 2, h = it & 3;
        const f32x4 nv = *(const f32x4*)(NUM + (size_t)m * 1024 + h * 256 + 4 * F.lane);
        const float den = DEN[(size_t)m * 4 + h], mt = MT[(size_t)m * 4 + h];
        const float dn = 1.f / fmaxf(fabsf(den), __expf(-mt));
        const f32x4 hv = nv * dn;
        const float mean = wave_sum((hv[0] + hv[1]) + (hv[2] + hv[3])) * (1.f / 256.f);
        const f32x4 dv = hv - mean;
        const float var = wave_sum((dv[0] * dv[0] + dv[1] * dv[1]) + (dv[2] * dv[2] + dv[3] * dv[3])) * (1.f / 256.f);
        const float rs = rsqrtf(var + LN_EPS);
        const f32x4 nw = *(const f32x4*)(norm_w + h * 256 + 4 * F.lane);
        const unsigned long long ow = *(const unsigned long long*)(PROJ + (size_t)m * NP + C_MO + h * 256 + 4 * F.lane);
        const unsigned w0 = (unsigned)ow, w1 = (unsigned)(ow >> 32);
        const float y0 = dv[0] * rs * nw[0] * sigm(bflo(w0)), y1 = dv[1] * rs * nw[1] * sigm(bfhi(w0)), y2 = dv[2] * rs * nw[2] * sigm(bflo(w1)), y3 = dv[3] * rs * nw[3] * sigm(bfhi(w1));
        *(unsigned long long*)(HM + (size_t)m * 1536 + 512 + h * 256 + 4 * F.lane) = (unsigned long long)pk2(y0, y1) | ((unsigned long long)pk2(y2, y3) << 32);
    }
}

__device__ __forceinline__ bf16x8 frag_g(const bf16* base, size_t pitch, int r0, int k0, int lane) { return *(const bf16x8*)(base + (size_t)(r0 + (lane & 15)) * pitch + k0 + 8 * (lane >> 4)); }
__device__ __forceinline__ float scan_add(float v, int lane) {
#pragma unroll
    for (int o = 1; o < 64; o <<= 1) { const float t = __shfl_up(v, o); if (lane >= o) v += t; }
    return v;
}
__device__ __forceinline__ float scan_max(float v, int lane) {
#pragma unroll
    for (int o = 1; o < 64; o <<= 1) { const float t = __shfl_up(v, o); if (lane >= o) v = fmaxf(v, t); }
    return v;
}
constexpr int VIMG_PITCH = 528, KIMG_PITCH = 272, QKIMG_PITCH = 144;
constexpr int L_VIMG = 0, L_KIMG = 33792, L_WK = 51200;
constexpr int L_QKIMG = 33792, L_GS = 43008, L_MX = 43264, L_BS = 43520, L_STAT = 43776;
__device__ __forceinline__ void mlstm_m1(Frame& F) {
    const bf16* PROJ = (const bf16*)(F.ws + WS_PROJ); const bf16* QKC = (const bf16*)(F.ws + WS_QKC); const float* MIF = (const float*)(F.ws + WS_MIF);
    float* KVT = (float*)(F.ws + WS_KVT); float* MLOC = (float*)(F.ws + WS_MSC); float* BLAST = MLOC + 1024; float* NLOC = (float*)(F.ws + WS_MSC + 65536);
    LAS unsigned char* Vimg = F.lds + L_VIMG; LAS unsigned char* Kimg = F.lds + L_KIMG; LAS float* wkL = (LAS float*)(F.lds + L_WK);
    for (int item = F.vcu; item < 512; item += F.G) {
        const int bh = item >> 6, c = item & 63, b = bh >> 2, h = bh & 3; const size_t row0 = (size_t)b * SEQ + (size_t)c * 64;
        __syncthreads();
        if (F.wave == 0) { const float lf = log_sigmoid(MIF[(row0 + F.lane) * 8 + 4 + h]), ip = MIF[(row0 + F.lane) * 8 + h];
            const float bs = scan_add(lf, F.lane), bl = __shfl(bs, 63), wl = bl - bs + ip, ml = wave_max(wl);
            wkL[F.lane] = __expf(wl - ml);
            if (F.lane == 0) { MLOC[item] = ml; BLAST[item] = bl; } }
        for (int idx = F.tid; idx < 2048; idx += NWAVES * 64) { const int s = idx >> 5, c8 = idx & 31;
            *(LAS v4u*)(Vimg + s * VIMG_PITCH + c8 * 16) = *(const v4u*)(PROJ + (row0 + s) * NP + C_MV + h * 256 + c8 * 8); }
        __syncthreads();
        for (int idx = F.tid; idx < 1024; idx += NWAVES * 64) { const int s = idx >> 4, c8 = idx & 15; const float wk = wkL[s];
            const v4u w = *(const v4u*)(QKC + (row0 + s) * 1024 + 512 + h * 128 + c8 * 8); v4u o;
            o.x = pk2(bflo(w.x) * wk, bfhi(w.x) * wk); o.y = pk2(bflo(w.y) * wk, bfhi(w.y) * wk); o.z = pk2(bflo(w.z) * wk, bfhi(w.z) * wk); o.w = pk2(bflo(w.w) * wk, bfhi(w.w) * wk);
            *(LAS v4u*)(Kimg + s * KIMG_PITCH + c8 * 16) = o; }
        __syncthreads();
        if (F.tid < 128) { float a = 0.f;
#pragma unroll 8
            for (int s = 0; s < 64; ++s) a += __uint_as_float((unsigned)(*(const LAS bf16*)(Kimg + s * KIMG_PITCH + F.tid * 2)) << 16);
            NLOC[(size_t)item * 128 + F.tid] = a; }
        f32x4 acc[2][8];
#pragma unroll
        for (int r = 0; r < 2; ++r)
#pragma unroll
            for (int ct = 0; ct < 8; ++ct) acc[r][ct] = (f32x4){0.f, 0.f, 0.f, 0.f};
#pragma unroll
        for (int ks = 0; ks < 2; ++ks) {
            const bf16x8 a0 = frag_tr(Vimg, VIMG_PITCH, 32 * ks, 32 * F.wave, F.lane), a1 = frag_tr(Vimg, VIMG_PITCH, 32 * ks, 32 * F.wave + 16, F.lane);
#pragma unroll
            for (int ct = 0; ct < 8; ++ct) { const bf16x8 bb = frag_tr(Kimg, KIMG_PITCH, 32 * ks, 16 * ct, F.lane);
                acc[0][ct] = __builtin_amdgcn_mfma_f32_16x16x32_bf16(a0, bb, acc[0][ct], 0, 0, 0); acc[1][ct] = __builtin_amdgcn_mfma_f32_16x16x32_bf16(a1, bb, acc[1][ct], 0, 0, 0); } }
        const int i = F.lane & 15, g = F.lane >> 4;
#pragma unroll
        for (int r = 0; r < 2; ++r)
#pragma unroll
            for (int ct = 0; ct < 8; ++ct)
#pragma unroll
                for (int q = 0; q < 4; ++q) KVT[((size_t)item * 256 + 32 * F.wave + 16 * r + 4 * g + q) * 128 + 16 * ct + i] = acc[r][ct][q];
    }
}
__device__ __forceinline__ void mlstm_m2(Frame& F) {
    const float* KVT = (const float*)(F.ws + WS_KVT); bf16* CPREV = (bf16*)(F.ws + WS_CPREV);
    const float* MLOC = (const float*)(F.ws + WS_MSC); const float* BLAST = MLOC + 1024; float* MPREV = (float*)(F.ws + WS_MSC) + 2048;
    const float* NLOC = (const float*)(F.ws + WS_MSC + 65536); float* NPREV = (float*)(F.ws + WS_MSC + 524288);
    const int gt = F.vcu * (NWAVES * 64) + F.tid, NT = F.G * NWAVES * 64;
    for (int p = gt; p < 8 * 256 * 64; p += NT) {
        const int bh = p >> 14, rem = p & 16383, v = rem >> 6, d2 = (rem & 63) * 2;
        float c0 = 0.f, c1 = 0.f, m = 0.f;
#pragma unroll 4
        for (int c = 0; c < 64; ++c) { const int item = bh * 64 + c; const size_t off = ((size_t)item * 256 + v) * 128 + d2;
            *(unsigned*)(CPREV + off) = pk2(c0, c1);
            const float2 kv = *(const float2*)(KVT + off);
            const float ml = MLOC[item], bl = BLAST[item], mn = fmaxf(bl + m, ml), dec = __expf(bl + m - mn), sc = __expf(ml - mn); m = mn;
            c0 = dec * c0 + sc * kv.x; c1 = dec * c1 + sc * kv.y; }
    }
    if (gt < 8 * 128) { const int bh = gt >> 7, d = gt & 127; float n = 0.f, m = 0.f;
        for (int c = 0; c < 64; ++c) { const int item = bh * 64 + c;
            NPREV[(size_t)item * 128 + d] = n; if (d == 0) MPREV[item] = m;
            const float ml = MLOC[item], bl = BLAST[item], mn = fmaxf(bl + m, ml), dec = __expf(bl + m - mn), sc = __expf(ml - mn); m = mn;
            n = dec * n + sc * NLOC[(size_t)item * 128 + d]; } }
}
__device__ __forceinline__ void mlstm_m3(Frame& F, const float* norm_w) {
    const bf16* PROJ = (const bf16*)(F.ws + WS_PROJ); const bf16* QKC = (const bf16*)(F.ws + WS_QKC); const float* MIF = (const float*)(F.ws + WS_MIF);
    const bf16* CPREV = (const bf16*)(F.ws + WS_CPREV); const float* MPREV = (const float*)(F.ws + WS_MSC) + 2048; const float* NPREV = (const float*)(F.ws + WS_MSC + 524288);
    bf16* HM = (bf16*)(F.ws + WS_AH);
    LAS unsigned char* Vimg = F.lds + L_VIMG; LAS unsigned char* QKimg = F.lds + L_QKIMG;
    LAS float* gsL = (LAS float*)(F.lds + L_GS); LAS float* mxL = (LAS float*)(F.lds + L_MX); LAS float* bsL = (LAS float*)(F.lds + L_BS); LAS float* stL = (LAS float*)(F.lds + L_STAT);
    const int i = F.lane & 15, g = F.lane >> 4, rt = F.wave & 3, ch = F.wave >> 2;
    for (int item = F.vcu; item < 512; item += F.G) {
        const int bh = item >> 6, c = item & 63, b = bh >> 2, h = bh & 3; const size_t row0 = (size_t)b * SEQ + (size_t)c * 64;
        __syncthreads();
        const float mprev = MPREV[item];
        if (F.wave == 0) { const float lf = log_sigmoid(MIF[(row0 + F.lane) * 8 + 4 + h]), ip = MIF[(row0 + F.lane) * 8 + h];
            const float bs = scan_add(lf, F.lane), gv = ip - bs, pm = scan_max(gv, F.lane);
            gsL[F.lane] = gv; mxL[F.lane] = fmaxf(mprev, pm); bsL[F.lane] = bs; }
        for (int idx = F.tid; idx < 2048; idx += NWAVES * 64) { const int s = idx >> 5, c8 = idx & 31;
            *(LAS v4u*)(Vimg + s * VIMG_PITCH + c8 * 16) = *(const v4u*)(PROJ + (row0 + s) * NP + C_MV + h * 256 + c8 * 8); }
        bf16x8 qf[4];
#pragma unroll
        for (int ks = 0; ks < 4; ++ks) qf[ks] = frag_g(QKC + h * 128, 1024, (int)row0 + 16 * rt, 32 * ks, F.lane);
        __syncthreads();
#pragma unroll
        for (int cc = 0; cc < 2; ++cc) { const int ct = 2 * ch + cc; f32x4 sv = (f32x4){0.f, 0.f, 0.f, 0.f};
            if (ct <= rt) {
#pragma unroll
                for (int ks = 0; ks < 4; ++ks) { const bf16x8 kf = frag_g(QKC + 512 + h * 128, 1024, (int)row0 + 16 * ct, 32 * ks, F.lane); sv = __builtin_amdgcn_mfma_f32_16x16x32_bf16(qf[ks], kf, sv, 0, 0, 0); } }
            const int sidx = 16 * ct + i; const float gsv = gsL[sidx];
#pragma unroll
            for (int q = 0; q < 4; ++q) { const int l = 16 * rt + 4 * g + q; const float val = (sidx <= l) ? sv[q] * QSCALE * __expf(gsv - mxL[l]) : 0.f;
                *(LAS bf16*)(QKimg + l * QKIMG_PITCH + sidx * 2) = (bf16)f2bf(val); } }
        __syncthreads();
        bf16x8 pf[2];
#pragma unroll
        for (int ks = 0; ks < 2; ++ks) pf[ks] = *(const LAS bf16x8*)(QKimg + (16 * rt + i) * QKIMG_PITCH + (32 * ks + 8 * g) * 2);
        f32x4 accs = (f32x4){0.f, 0.f, 0.f, 0.f}, accn = (f32x4){0.f, 0.f, 0.f, 0.f};
        { const bf16x8 ones = (bf16x8){0x3F80, 0x3F80, 0x3F80, 0x3F80, 0x3F80, 0x3F80, 0x3F80, 0x3F80};
#pragma unroll
          for (int ks = 0; ks < 2; ++ks) accs = __builtin_amdgcn_mfma_f32_16x16x32_bf16(pf[ks], ones, accs, 0, 0, 0);
#pragma unroll
          for (int ks = 0; ks < 4; ++ks) { const float* np = NPREV + (size_t)item * 128 + 32 * ks + 8 * g; const f32x4 n0 = *(const f32x4*)np, n1 = *(const f32x4*)(np + 4);
              union { bf16x8 v; unsigned u[4]; } nf; nf.u[0] = pk2(n0[0], n0[1]); nf.u[1] = pk2(n0[2], n0[3]); nf.u[2] = pk2(n1[0], n1[1]); nf.u[3] = pk2(n1[2], n1[3]);
              accn = __builtin_amdgcn_mfma_f32_16x16x32_bf16(qf[ks], nf.v, accn, 0, 0, 0); } }
        f32x4 a1[8], a2[8];
#pragma unroll
        for (int ct = 0; ct < 8; ++ct) { a1[ct] = (f32x4){0.f, 0.f, 0.f, 0.f}; a2[ct] = (f32x4){0.f, 0.f, 0.f, 0.f}; }
        const bf16* cp = CPREV + (size_t)item * 256 * 128;
#pragma unroll
        for (int ct = 0; ct < 8; ++ct) { const int vcol = 128 * ch + 16 * ct;
#pragma unroll
            for (int ks = 0; ks < 4; ++ks) { const bf16x8 cf = frag_g(cp, 128, vcol, 32 * ks, F.lane); a1[ct] = __builtin_amdgcn_mfma_f32_16x16x32_bf16(qf[ks], cf, a1[ct], 0, 0, 0); }
#pragma unroll
            for (int ks = 0; ks < 2; ++ks) { const bf16x8 vf = frag_tr(Vimg, VIMG_PITCH, 32 * ks, vcol, F.lane); a2[ct] = __builtin_amdgcn_mfma_f32_16x16x32_bf16(pf[ks], vf, a2[ct], 0, 0, 0); } }
        float s1[4], s2[4];
#pragma unroll
        for (int q = 0; q < 4; ++q) { const int l = 16 * rt + 4 * g + q; const float mx = mxL[l], wi = __expf(mprev - mx) * QSCALE, mt = bsL[l] + mx;
            const float den = wi * accn[q] + accs[q], dn = 1.f / fmaxf(fabsf(den), __expf(-mt)); float a = 0.f, bq = 0.f;
#pragma unroll
            for (int ct = 0; ct < 8; ++ct) { const float hv = (wi * a1[ct][q] + a2[ct][q]) * dn; a1[ct][q] = hv; a += hv; bq += hv * hv; }
            a += __shfl_xor(a, 1); a += __shfl_xor(a, 2); a += __shfl_xor(a, 4); a += __shfl_xor(a, 8);
            bq += __shfl_xor(bq, 1); bq += __shfl_xor(bq, 2); bq += __shfl_xor(bq, 4); bq += __shfl_xor(bq, 8);
            s1[q] = a; s2[q] = bq;
            if (i == 0) { stL[(l * 2 + ch) * 2] = a; stL[(l * 2 + ch) * 2 + 1] = bq; } }
        __syncthreads();
#pragma unroll
        for (int q = 0; q < 4; ++q) { const int l = 16 * rt + 4 * g + q; const float sa = stL[(l * 2) * 2] + stL[(l * 2 + 1) * 2], qa = stL[(l * 2) * 2 + 1] + stL[(l * 2 + 1) * 2 + 1];
            const float mean = sa * (1.f / 256.f), var = qa * (1.f / 256.f) - mean * mean, rs = rsqrtf(fmaxf(var, 0.f) + LN_EPS);
            const size_t m = row0 + l;
#pragma unroll
            for (int ct = 0; ct < 8; ++ct) { const int v = 128 * ch + 16 * ct + i;
                const float og = __uint_as_float((unsigned)PROJ[m * NP + C_MO + h * 256 + v] << 16);
                HM[m * 1536 + 512 + h * 256 + v] = (bf16)f2bf((a1[ct][q] - mean) * rs * norm_w[h * 256 + v] * sigm(og)); } }
        (void)s1; (void)s2;
    }
}

__device__ __forceinline__ bf16x8 frag_vt(const LAS unsigned char* Vimg, int row0a, int row0b, int dcol0, int lane) {
    const int i = lane & 15, g = lane >> 4, q = i >> 2, gi = (dcol0 >> 2) + (i & 3);
    const int ra = row0a + 4 * g + q, rb = row0b + 4 * g + q;
    const s16x4 a = __builtin_amdgcn_ds_read_tr16_b64_v4i16((LAS s16x4*)(Vimg + ra * 256 + ((gi ^ ((ra & 7) << 2)) << 3)));
    const s16x4 b = __builtin_amdgcn_ds_read_tr16_b64_v4i16((LAS s16x4*)(Vimg + rb * 256 + ((gi ^ ((rb & 7) << 2)) << 3)));
    return (bf16x8){a[0], a[1], a[2], a[3], b[0], b[1], b[2], b[3]};
}
__device__ __forceinline__ void attn_mfma(Frame& F) {
    const bf16* PROJ = (const bf16*)(F.ws + WS_PROJ); bf16* ATTO = (bf16*)(F.ws + WS_ATTO); float* LSE = (float*)(F.ws + WS_LSE);
    LAS unsigned char* Vimg = F.lds + RING_OFF;
    const int i = F.lane & 15, g = F.lane >> 4, w = F.wave;
    for (int it = F.vcu; it < 768; it += F.G) {
        const int grp = it >> 8, r1 = it & 255, b = r1 >> 7, hh = (r1 >> 5) & 3, rest = r1 & 31;
        const int rd = grp == 0 ? 1 : (grp == 1 ? 4 : 16), nb = 32 / rd, p = rest / nb, n = rest % nb, h = grp * 4 + hh;
        const float sl = alibi_slope(h) * (float)rd;
        const size_t tok0 = (size_t)b * SEQ + p;
        __syncthreads();
        for (int idx = F.tid; idx < 4096; idx += NWAVES * 64) { const int ki = idx >> 4, cj = idx & 15, u = (n - 1) * 128 + ki; v4u val = (v4u){0u, 0u, 0u, 0u};
            if (u >= 0) val = *(const v4u*)(PROJ + (tok0 + (size_t)u * rd) * NP + C_AV + h * 128 + cj * 8);
            *(LAS v4u*)(Vimg + ki * 256 + ((cj ^ ((ki & 7) << 1)) << 4)) = val; }
        const int qi = 16 * w + i; const size_t qtok = tok0 + (size_t)(128 * n + qi) * rd;
        bf16x8 qf[4];
#pragma unroll
        for (int ks = 0; ks < 4; ++ks) qf[ks] = *(const bf16x8*)(PROJ + qtok * NP + C_AQ + h * 128 + 32 * ks + 8 * g);
        f32x4 sv[10];
#pragma unroll
        for (int j = 0; j < 9; ++j) { sv[j] = (f32x4){0.f, 0.f, 0.f, 0.f}; int u = (n - 1) * 128 + 16 * (w + j) + i; u = u < 0 ? 0 : u;
            const bf16* kp = PROJ + (tok0 + (size_t)u * rd) * NP + C_AK + h * 128 + 8 * g;
#pragma unroll
            for (int ks = 0; ks < 4; ++ks) { const bf16x8 kf = *(const bf16x8*)(kp + 32 * ks); sv[j] = __builtin_amdgcn_mfma_f32_16x16x32_bf16(kf, qf[ks], sv[j], 0, 0, 0); } }
        sv[9] = (f32x4){0.f, 0.f, 0.f, 0.f};
        float mx = -INFINITY;
#pragma unroll
        for (int j = 0; j < 9; ++j)
#pragma unroll
            for (int q = 0; q < 4; ++q) { const int ki = 16 * (w + j) + 4 * g + q, delta = 128 + qi - ki; const bool valid = delta >= 0 && delta <= 128 && (n > 0 || ki >= 128);
                const float s = valid ? sv[j][q] * QSCALE - sl * (float)delta : -INFINITY; sv[j][q] = s; mx = fmaxf(mx, s); }
        mx = fmaxf(mx, __shfl_xor(mx, 16)); mx = fmaxf(mx, __shfl_xor(mx, 32));
        float l = 0.f;
#pragma unroll
        for (int j = 0; j < 9; ++j)
#pragma unroll
            for (int q = 0; q < 4; ++q) { const float pv = (sv[j][q] == -INFINITY) ? 0.f : __expf(sv[j][q] - mx); sv[j][q] = pv; l += pv; }
        l += __shfl_xor(l, 16); l += __shfl_xor(l, 32);
        bf16x8 pf[5];
#pragma unroll
        for (int st = 0; st < 5; ++st) { union { bf16x8 v; unsigned u[4]; } t; t.u[0] = pk2(sv[2 * st][0], sv[2 * st][1]); t.u[1] = pk2(sv[2 * st][2], sv[2 * st][3]);
            t.u[2] = pk2(sv[2 * st + 1][0], sv[2 * st + 1][1]); t.u[3] = pk2(sv[2 * st + 1][2], sv[2 * st + 1][3]); pf[st] = t.v; }
        __syncthreads();
        f32x4 o[8];
#pragma unroll
        for (int dt = 0; dt < 8; ++dt) o[dt] = (f32x4){0.f, 0.f, 0.f, 0.f};
#pragma unroll
        for (int st = 0; st < 5; ++st) { const int T0 = w + 2 * st, T1 = (T0 + 1) > 15 ? 15 : (T0 + 1);
#pragma unroll
            for (int dt = 0; dt < 8; ++dt) { const bf16x8 vf = frag_vt(Vimg, 16 * T0, 16 * T1, 16 * dt, F.lane); o[dt] = __builtin_amdgcn_mfma_f32_16x16x32_bf16(vf, pf[st], o[dt], 0, 0, 0); } }
        const float il = 1.f / l;
#pragma unroll
        for (int dt = 0; dt < 8; ++dt)
            *(unsigned long long*)(ATTO + qtok * 1536 + h * 128 + 16 * dt + 4 * g) = (unsigned long long)pk2(o[dt][0] * il, o[dt][1] * il) | ((unsigned long long)pk2(o[dt][2] * il, o[dt][3] * il) << 32);
        if (g == 0) LSE[qtok * 12 + h] = mx + __logf(l);
    }
}
__device__ __forceinline__ void ln1_router(Frame& F, const float* g1, const float* b1, const float* brg, const float* bre) {
    const float* PRE = (const float*)(F.ws + WS_TMP); float* H1 = (float*)(F.ws + WS_H1); unsigned char* H1F8 = F.ws + WS_H1B;
    const bf16* WRH = (const bf16*)(F.ws + WS_WRT); const bf16* WRL = WRH + 48 * D;
    int* TOKLIST = (int*)(F.ws + WS_TOKLIST); int* TOKINFO = (int*)(F.ws + WS_TOKINFO);
    LAS float* part = (LAS float*)(F.lds + RING_OFF);
    const int i = F.lane & 15, g = F.lane >> 4;
    for (int R0 = 32 * F.vcu; R0 < M; R0 += 32 * F.G) {
        __syncthreads();
        for (int rr = 0; rr < 4; ++rr) { const int m = R0 + 4 * F.wave + rr;
            const f32x4* xr = (const f32x4*)(PRE + (size_t)m * D) + F.lane;
            f32x4 v[8]; float s = 0.f;
#pragma unroll
            for (int j = 0; j < 8; ++j) { v[j] = xr[64 * j]; s += (v[j][0] + v[j][1]) + (v[j][2] + v[j][3]); }
            const float mean = wave_sum(s) * (1.f / D); float s2 = 0.f;
#pragma unroll
            for (int j = 0; j < 8; ++j) { const f32x4 d = v[j] - mean; s2 += (d[0] * d[0] + d[1] * d[1]) + (d[2] * d[2] + d[3] * d[3]); }
            const float rstd = rsqrtf(wave_sum(s2) * (1.f / D) + LN_EPS);
            f32x4* h1r = (f32x4*)(H1 + (size_t)m * D) + F.lane; int* o4 = (int*)(H1F8 + (size_t)m * D) + F.lane;
#pragma unroll
            for (int j = 0; j < 8; ++j) { const int k0 = 4 * F.lane + 256 * j; const f32x4 g4 = *(const f32x4*)(g1 + k0), b4 = *(const f32x4*)(b1 + k0);
                const f32x4 hv = (v[j] - mean) * rstd * g4 + b4;
                int w = 0; w = __builtin_amdgcn_cvt_pk_fp8_f32(hv[0], hv[1], w, false); w = __builtin_amdgcn_cvt_pk_fp8_f32(hv[2], hv[3], w, true);
                h1r[64 * j] = hv; o4[64 * j] = w; } }
        VM_WAIT(); __syncthreads();
        { const int rtile = F.wave & 1, kq = F.wave >> 1; f32x4 acc[3];
#pragma unroll
          for (int ct = 0; ct < 3; ++ct) acc[ct] = (f32x4){0.f, 0.f, 0.f, 0.f};
          const float* hp = H1 + (size_t)(R0 + 16 * rtile + i) * D + 512 * kq + 8 * g;
#pragma unroll 4
          for (int ks = 0; ks < 16; ++ks) { const f32x4 x0 = *(const f32x4*)(hp + 32 * ks), x1 = *(const f32x4*)(hp + 32 * ks + 4);
              union { bf16x8 v; unsigned u[4]; } ah, al;
              ah.u[0] = pk2(x0[0], x0[1]); ah.u[1] = pk2(x0[2], x0[3]); ah.u[2] = pk2(x1[0], x1[1]); ah.u[3] = pk2(x1[2], x1[3]);
              al.u[0] = pk2(x0[0] - bflo(ah.u[0]), x0[1] - bfhi(ah.u[0])); al.u[1] = pk2(x0[2] - bflo(ah.u[1]), x0[3] - bfhi(ah.u[1]));
              al.u[2] = pk2(x1[0] - bflo(ah.u[2]), x1[1] - bfhi(ah.u[2])); al.u[3] = pk2(x1[2] - bflo(ah.u[3]), x1[3] - bfhi(ah.u[3]));
#pragma unroll
              for (int ct = 0; ct < 3; ++ct) { const size_t wo = (size_t)(16 * ct + i) * D + 512 * kq + 32 * ks + 8 * g;
                  const bf16x8 bh = *(const bf16x8*)(WRH + wo), bl = *(const bf16x8*)(WRL + wo);
                  acc[ct] = __builtin_amdgcn_mfma_f32_16x16x32_bf16(ah.v, bh, acc[ct], 0, 0, 0);
                  acc[ct] = __builtin_amdgcn_mfma_f32_16x16x32_bf16(al.v, bh, acc[ct], 0, 0, 0);
                  acc[ct] = __builtin_amdgcn_mfma_f32_16x16x32_bf16(ah.v, bl, acc[ct], 0, 0, 0); } }
#pragma unroll
          for (int ct = 0; ct < 3; ++ct)
#pragma unroll
              for (int q = 0; q < 4; ++q) part[(kq * 32 + 16 * rtile + 4 * g + q) * 48 + 16 * ct + i] = acc[ct][q]; }
        __syncthreads();
        if (F.tid < 32) { const int m = R0 + F.tid;
            float ae[32], ag[4];
#pragma unroll
            for (int e = 0; e < 32; ++e) ae[e] = ((part[(0 * 32 + F.tid) * 48 + e] + part[(1 * 32 + F.tid) * 48 + e]) + (part[(2 * 32 + F.tid) * 48 + e] + part[(3 * 32 + F.tid) * 48 + e])) + bre[e];
#pragma unroll
            for (int e = 0; e < 4; ++e) ag[e] = ((part[(0 * 32 + F.tid) * 48 + 32 + e] + part[(1 * 32 + F.tid) * 48 + 32 + e]) + (part[(2 * 32 + F.tid) * 48 + 32 + e] + part[(3 * 32 + F.tid) * 48 + 32 + e])) + brg[e];
            int grp = 0; float gm = ag[0];
#pragma unroll
            for (int e = 1; e < 4; ++e) if (ag[e] > gm) { gm = ag[e]; grp = e; }
            float gs = 0.f;
#pragma unroll
            for (int e = 0; e < 4; ++e) gs += __expf(ag[e] - gm);
            const float gwt = 1.f / gs;
            float el[8];
#pragma unroll
            for (int e = 0; e < 8; ++e) el[e] = grp == 0 ? ae[e] : (grp == 1 ? ae[8 + e] : (grp == 2 ? ae[16 + e] : ae[24 + e]));
            int i1 = 0; float v1 = el[0];
#pragma unroll
            for (int e = 1; e < 8; ++e) if (el[e] > v1) { v1 = el[e]; i1 = e; }
            int i2 = 0; float v2 = -INFINITY;
#pragma unroll
            for (int e = 0; e < 8; ++e) if (e != i1 && el[e] > v2) { v2 = el[e]; i2 = e; }
            const float ex = __expf(v2 - v1), p1 = 1.f / (1.f + ex), p2 = ex * p1;
            const int e1 = grp * 8 + i1, e2 = grp * 8 + i2;
            const int pos1 = (int)__hip_atomic_fetch_add(F.ctl + CW_CNT + 16 * e1, 1u, RLX_AGENT), pos2 = (int)__hip_atomic_fetch_add(F.ctl + CW_CNT + 16 * e2, 1u, RLX_AGENT);
            TOKLIST[e1 * ECAP + pos1] = m; TOKLIST[e2 * ECAP + pos2] = m;
            int* ti = TOKINFO + (size_t)m * 8; ti[0] = e1; ti[1] = pos1; ti[2] = e2; ti[3] = pos2; ti[4] = __float_as_int(gwt * p1); ti[5] = __float_as_int(gwt * p2);
        }
    }
}
struct MoeOrder {
    const LAS int* TS; const LAS int* CN; const int* toklist; int NT, G, c, U; bool gather;
    __device__ __forceinline__ void init(const LAS int* ts, const LAS int* cn, const int* tl, int nt, int G_, int c_, bool ga) { TS = ts; CN = cn; toklist = tl; NT = nt; G = G_; c = c_; U = ts[NE] * nt; gather = ga; }
    __device__ __forceinline__ bool next(int i, pg8::Unit& u) const {
        const int x = c & 7, r = c >> 3, W = G >> 3;
        const int lo = (int)(((long)U * x) >> 3), hi = (int)(((long)U * (x + 1)) >> 3);
        const int L = lo + r + i * W; if (L >= hi) return false;
        int e = 0;
#pragma unroll 1
        for (int k = 1; k < NE; ++k) if (L >= TS[k] * NT) e = k;
        const int ne = TS[e + 1] - TS[e], loc = L - TS[e] * NT, n_t = loc / ne, m_t = loc % ne;
        u.pm = TS[e] + m_t; u.pn = e * NT + n_t; u.e = e; u.r0 = m_t * 256; u.half = (CN[e] - m_t * 256) <= 128 ? 1 : 0; return true;
    }
    __device__ __forceinline__ int arow(const pg8::Unit& u, int r) const {
        if (!gather) return u.pm * 256 + r;
        int idx = u.r0 + r; const int cn = CN[u.e]; idx = idx < cn ? idx : cn - 1;
        return toklist[u.e * ECAP + idx];
    }
    __device__ __forceinline__ void a_ready(const pg8::Unit&) const {}
    __device__ __forceinline__ void done(const pg8::Unit&) const {}
};
__device__ __forceinline__ void moe_tables(Frame& F) {
    LAS int* TS = (LAS int*)(F.lds + TS_OFF); LAS int* CN = (LAS int*)(F.lds + CNT_OFF);
    if (F.tid < NE) CN[F.tid] = (int)__hip_atomic_load(F.ctl + CW_CNT + 16 * F.tid, RLX_AGENT);
    __syncthreads();
    if (F.tid == 0) { int acc = 0; for (int e = 0; e < NE; ++e) { TS[e] = acc; acc += (CN[e] + 255) >> 8; } TS[NE] = acc; }
    __syncthreads();
}
__device__ __forceinline__ void final_ln(Frame& F, const float* g2, const float* b2, float* out) {
    const float* H1 = (const float*)(F.ws + WS_H1); const bf16* YS = (const bf16*)(F.ws + WS_YS); const int* TOKINFO = (const int*)(F.ws + WS_TOKINFO);
    const LAS int* TS = (const LAS int*)(F.lds + TS_OFF);
    const int gw = F.vcu * NWAVES + F.wave, NGW = F.G * NWAVES;
    for (int m = gw; m < M; m += NGW) {
        const int* ti = TOKINFO + (size_t)m * 8;
        const int e1 = ti[0], p1 = ti[1], e2 = ti[2], p2 = ti[3]; const float w1 = __int_as_float(ti[4]), w2 = __int_as_float(ti[5]);
        const size_t sl1 = (size_t)TS[e1] * 256 + p1, sl2 = (size_t)TS[e2] * 256 + p2;
        const f32x4* hr = (const f32x4*)(H1 + (size_t)m * D) + F.lane;
        const unsigned long long* y1 = (const unsigned long long*)(YS + sl1 * D) + F.lane; const unsigned long long* y2 = (const unsigned long long*)(YS + sl2 * D) + F.lane;
        f32x4 v[8]; float s = 0.f;
#pragma unroll
        for (int j = 0; j < 8; ++j) { const f32x4 hv = hr[64 * j]; const unsigned long long a = y1[64 * j], b = y2[64 * j];
            const unsigned a0 = (unsigned)a, a1 = (unsigned)(a >> 32), b0 = (unsigned)b, b1 = (unsigned)(b >> 32);
            f32x4 y; y[0] = w1 * bflo(a0) + w2 * bflo(b0); y[1] = w1 * bfhi(a0) + w2 * bfhi(b0); y[2] = w1 * bflo(a1) + w2 * bflo(b1); y[3] = w1 * bfhi(a1) + w2 * bfhi(b1);
            v[j] = hv * ALPHA + y; s += (v[j][0] + v[j][1]) + (v[j][2] + v[j][3]); }
        const float mean = wave_sum(s) * (1.f / D); float s2 = 0.f;
#pragma unroll
        for (int j = 0; j < 8; ++j) { const f32x4 d = v[j] - mean; s2 += (d[0] * d[0] + d[1] * d[1]) + (d[2] * d[2] + d[3] * d[3]); }
        const float rstd = rsqrtf(wave_sum(s2) * (1.f / D) + LN_EPS);
        f32x4* orow = (f32x4*)(out + (size_t)m * D) + F.lane;
#pragma unroll
        for (int j = 0; j < 8; ++j) { const int k0 = 4 * F.lane + 256 * j; const f32x4 g4 = *(const f32x4*)(g2 + k0), b4 = *(const f32x4*)(b2 + k0);
            orow[64 * j] = (v[j] - mean) * rstd * g4 + b4; }
    }
}

#ifndef SKIPMASK
#define SKIPMASK 0
#endif
#ifndef ATTN_NAIVE
#define ATTN_NAIVE 0
#endif
#ifndef NCONV_PER_XCD
#define NCONV_PER_XCD 16
#endif
#ifndef MLSTM_NAIVE
#define MLSTM_NAIVE 0
#endif
#ifndef DUP2MASK
#define DUP2MASK 0
#endif
#ifndef DUPMASK
#define DUPMASK 0
#endif
constexpr int N_PHASES = 12;
struct Args { const float* in[22]; float* out; unsigned char* ws; int ph_lo, ph_hi, li, pad; };
__global__ void __launch_bounds__(NWAVES * 64, 2) fwd_kernel(Args args) {
    extern __shared__ __attribute__((aligned(16))) unsigned char lds[];
    Frame F;
    F.lds = (LAS unsigned char*)lds;
    F.tid = threadIdx.x; F.lane = F.tid & 63; F.wave = __builtin_amdgcn_readfirstlane(F.tid >> 6);
    F.G = gridDim.x; { const int bx = blockIdx.x; F.vcu = (F.G % 8 == 0) ? (bx % 8) * (F.G / 8) + bx / 8 : bx; }
    F.ws = args.ws; F.ctl = (gu32*)(args.ws + WS_CTL);
    for (int u = F.tid; u < (LDS_BYTES - LDSCTL_OFF) / 4; u += NWAVES * 64) ((LAS unsigned*)(F.lds + LDSCTL_OFF))[u] = 0u;
    __syncthreads();
    XcdBarrier bar = xcd_barrier_post((unsigned*)(F.ctl + CW_BAR) + args.li * XCD_BAR_WORDS, (volatile LAS unsigned*)(F.lds + MISC_OFF) + 8);
    const int lo = args.ph_lo, hi = args.ph_hi;
#define IN(k) (lo <= (k) && (k) < hi && !(SKIPMASK & (1 << (k))))
#define REP(k) for (int rep_ = 0; rep_ < ((DUPMASK >> (k)) & 1) + 1; ++rep_)
#ifndef DUPBAR
#define DUPBAR 0
#endif
#define SEAM(k) do { if (lo <= (k) && (k) + 1 < hi) { xcd_barrier(bar); if (DUPBAR) xcd_barrier(bar); } } while (0)
    unsigned char* ws = args.ws;
    if (IN(0)) REP(0) { p0_prologue(F, args.in[0], args.in[1], args.in[2], args.in[3], args.in[6], args.in[8], args.in[9], args.in[10], args.in[13], args.in[15]); __syncthreads(); }
    SEAM(0);
    if (IN(1)) {
        const int bx = (int)blockIdx.x, rank = bx >> 3;
        if (NCONV_PER_XCD > 0 && (rank % (32 / NCONV_PER_XCD)) == (32 / NCONV_PER_XCD) - 1) {
            moe_convert(F, (bx & 7) * NCONV_PER_XCD + rank / (32 / NCONV_PER_XCD), 8 * NCONV_PER_XCD, args.in[17], args.in[18], args.in[19]); __syncthreads(); }
        pg8::Gemm g{(const bf16*)(ws + WS_HB), (const bf16*)(ws + WS_WIN), M, NP, D};
        QueueOrder S; S.init(M, NP, bx, F.ctl + CW_Q, (volatile LAS int*)(F.lds + QSLOT_OFF));
        pg8::EpiBf16 E{(bf16*)(ws + WS_PROJ), NP};
        pg8::gemm_phase<pg8::EpiBf16, QueueOrder, true, true>(F.lds + RING_OFF, g, S, E);
#if DUP2MASK & 2
        { QueueOrder S2; S2.init(M, NP, bx, F.ctl + CW_Q + 1024, (volatile LAS int*)(F.lds + QSLOT_OFF)); __syncthreads();
          pg8::gemm_phase<pg8::EpiBf16, QueueOrder, true, true>(F.lds + RING_OFF, g, S2, E); }
#endif
    }
    SEAM(1);
#if ATTN_NAIVE
    if (IN(2)) REP(2) { conv_qk(F, args.in[4], args.in[5]); attn_naive(F); }
#else
    if (IN(2)) REP(2) { conv_qk(F, args.in[4], args.in[5]); attn_mfma(F); }
#endif
    SEAM(2);
#if MLSTM_NAIVE
    if (IN(3)) { if (F.vcu < 8) mlstm_naive(F, F.vcu); else attn_merge(F, 8); }
    SEAM(3);
    if (IN(4)) { mlstm_post(F, args.in[7]); }
    SEAM(4);
    SEAM(5);
#else
    if (IN(3)) REP(3) { mlstm_m1(F); attn_merge(F, 0); }
    SEAM(3);
    if (IN(4)) REP(4) { mlstm_m2(F); }
    SEAM(4);
    if (IN(5)) REP(5) { mlstm_m3(F, args.in[7]); }
    SEAM(5);
#endif
    if (IN(6)) { pg8::Gemm g{(const bf16*)(ws + WS_AH), (const bf16*)(ws + WS_WPA), M, D, 1536}; pg8::StaticOrder S; S.init(M, D, F.G, (int)blockIdx.x);
        pg8::EpiMerge E{(bf16*)(ws + WS_MERGED), D, (const bf16*)(ws + WS_PROJ) + C_GATE, NP};
        pg8::gemm_phase<pg8::EpiMerge, pg8::StaticOrder, true, true>(F.lds + RING_OFF, g, S, E); }
    SEAM(6);
#define PHASE7_BODY {  pg8::Gemm g{(const bf16*)(ws + WS_MERGED), (const bf16*)(ws + WS_WOUT), M, D, D}; pg8::StaticOrder S; S.init(M, D, F.G, (int)blockIdx.x); \
        pg8::EpiResid E{(float*)(ws + WS_TMP), D, args.in[0], (const float*)(ws + WS_STATS), args.in[1], args.in[2], ALPHA}; \
        pg8::gemm_phase<pg8::EpiResid, pg8::StaticOrder, true, true>(F.lds + RING_OFF, g, S, E);  }
    if (IN(7)) { PHASE7_BODY
#if DUP2MASK & 128
        PHASE7_BODY
#endif
    }
    SEAM(7);
    if (IN(8)) { ln1_router(F, args.in[11], args.in[12], args.in[14], args.in[16]); }
    SEAM(8);
    if (IN(9) || IN(10) || IN(11)) moe_tables(F);
    if (IN(9)) REP(9) { pg8::Gemm g{(const bf16*)(ws + WS_H1B), (const bf16*)(ws + WS_WGU), M, NE * 2 * DFF, D / 2};
        MoeOrder S; S.init((const LAS int*)(F.lds + TS_OFF), (const LAS int*)(F.lds + CNT_OFF), (const int*)(ws + WS_TOKLIST), NT1, F.G, (int)blockIdx.x, true);
        pg8::EpiSwiGlu8 E{ws + WS_ACT, WD8_PITCH, NT1};
        pg8::gemm_phase<pg8::EpiSwiGlu8, MoeOrder, true, true, true, 127, WSCALE_E8M0>(F.lds + RING_OFF, g, S, E); }
    SEAM(9);
    if (IN(10)) REP(10) { pg8::Gemm g{(const bf16*)(ws + WS_ACT), (const bf16*)(ws + WS_WD), MAXT * 256, NE * D, WD8_PITCH / 2};
        MoeOrder S; S.init((const LAS int*)(F.lds + TS_OFF), (const LAS int*)(F.lds + CNT_OFF), (const int*)(ws + WS_TOKLIST), NT2, F.G, (int)blockIdx.x, false);
        pg8::EpiBf16Grp E{(bf16*)(ws + WS_YS), D, NT2};
        pg8::gemm_phase<pg8::EpiBf16Grp, MoeOrder, true, true, true, 127, WSCALE_E8M0>(F.lds + RING_OFF, g, S, E); }
    SEAM(10);
    if (IN(11)) REP(11) { final_ln(F, args.in[20], args.in[21], args.out); }
#undef IN
#undef SEAM
#undef REP
}

#ifndef MK_PER_PHASE
#define MK_PER_PHASE 0
#endif
extern "C" void kernel_launch(void* const* d_in, const int* in_sizes, int n_in, void* d_out, int out_size, void* d_ws, size_t ws_size, hipStream_t stream) {
    static int grid = 0;
    if (grid == 0) {
        if (n_in != 22 || out_size != M * D || ws_size < WS_END) { fprintf(stderr, "kernel_launch: unexpected problem: n_in %d out %d ws %zu\n", n_in, out_size, ws_size); grid = -1; return; }
        int dev = 0, cus = 0, per_cu = 0;
        if (hipGetDevice(&dev) != hipSuccess || hipDeviceGetAttribute(&cus, hipDeviceAttributeMultiprocessorCount, dev) != hipSuccess) { grid = -1; return; }
        if (hipFuncSetAttribute((const void*)fwd_kernel, hipFuncAttributeMaxDynamicSharedMemorySize, LDS_BYTES) != hipSuccess) { fprintf(stderr, "kernel_launch: hipFuncSetAttribute failed\n"); grid = -1; return; }
        if (hipOccupancyMaxActiveBlocksPerMultiprocessor(&per_cu, (const void*)fwd_kernel, NWAVES * 64, LDS_BYTES) != hipSuccess || per_cu < 1)
            fprintf(stderr, "kernel_launch: note: occupancy query reports %d workgroups per CU\n", per_cu);
        (void)hipGetLastError();
        grid = cus - (cus % 8);
        if (grid < 16) grid = 16;
    }
    if (grid < 0) return;
    (void)hipMemsetAsync((char*)d_ws + WS_CTL, 0, CTL_ZERO_BYTES, stream);
    Args a{};
    for (int i = 0; i < 22; ++i) a.in[i] = (const float*)d_in[i];
    a.out = (float*)d_out; a.ws = (unsigned char*)d_ws; a.pad = 0;
#if MK_PER_PHASE
    for (int p = 0; p < N_PHASES; ++p) { a.ph_lo = p; a.ph_hi = p + 1; a.li = p; hipLaunchKernelGGL(fwd_kernel, dim3(grid), dim3(NWAVES * 64), LDS_BYTES, stream, a); }
#else
    a.ph_lo = 0; a.ph_hi = N_PHASES; a.li = 0;
    hipLaunchKernelGGL(fwd_kernel, dim3(grid), dim3(NWAVES * 64), LDS_BYTES, stream, a);
#endif
}
```
